# Optimizing an MI355X kernel written in HIP

```python
import math
import jax, jax.numpy as jnp
from jax import lax
import numpy as np

D_MODEL = 1024
BATCH = 4
SEQ = 4096
DEPTH = 1

HEAD_DIM = 64
N_SWA_HEADS = 8
N_SWA_KV_HEADS = 2
SWA_GROUP = N_SWA_HEADS // N_SWA_KV_HEADS
N_FOX_HEADS = 8
MIX_WIDTH = (N_SWA_HEADS + N_FOX_HEADS) * HEAD_DIM
WINDOW = 128
BLOCK = 128
N_BUCKETS = 32
MAX_DISTANCE = 128
N_KEYS = 128
N_EXPERTS = N_KEYS * N_KEYS
PEER_HEADS = 8
PEER_TOPK = 16
D_KEY = 256
D_HALF = D_KEY // 2
PEER_CHUNK = 128
EPS = 1e-6
NEG = -1e30

Q_A = N_SWA_HEADS * HEAD_DIM
KV_A = N_SWA_KV_HEADS * HEAD_DIM
QKV_B = N_FOX_HEADS * HEAD_DIM
SPLITS = [Q_A, Q_A + KV_A, Q_A + 2 * KV_A, Q_A + 2 * KV_A + QKV_B,
          Q_A + 2 * KV_A + 2 * QKV_B, Q_A + 2 * KV_A + 3 * QKV_B]
IN_WIDTH = Q_A + 2 * KV_A + 3 * QKV_B + N_FOX_HEADS

kernel_name = "hybrid_swa_sink_fox_peer"


def rms_norm(x, g):
    xf = x.astype(jnp.float32)
    y = xf * lax.rsqrt(jnp.mean(xf * xf, axis=-1, keepdims=True) + EPS)
    return (y * g.astype(jnp.float32)).astype(x.dtype)


def t5_bucket(d):
    n = jnp.maximum(d, 0)
    max_exact = N_BUCKETS // 2
    nf = jnp.maximum(n, 1).astype(jnp.float32)
    large = max_exact + (jnp.log(nf / max_exact) / math.log(MAX_DISTANCE / max_exact)
                         * (N_BUCKETS - max_exact)).astype(jnp.int32)
    large = jnp.minimum(large, N_BUCKETS - 1)
    return jnp.where(n < max_exact, n, large)


def swa_attention(q, k, v, sinks, rel_bias):
    B, S = q.shape[0], q.shape[1]
    nb = S // BLOCK
    qb = q.reshape(B, nb, BLOCK, N_SWA_KV_HEADS, SWA_GROUP, HEAD_DIM)

    def band(t):
        tp = jnp.pad(t, ((0, 0), (BLOCK, 0), (0, 0), (0, 0)))
        tb = tp.reshape(B, nb + 1, BLOCK, N_SWA_KV_HEADS, HEAD_DIM)
        return jnp.concatenate([tb[:, :-1], tb[:, 1:]], axis=2)

    kb, vb = band(k), band(v)
    logits = jnp.einsum('bnqhgd,bnchd->bnhgqc', qb, kb).astype(jnp.float32) * (HEAD_DIM ** -0.5)
    qi = jnp.arange(BLOCK)[:, None]
    ci = jnp.arange(2 * BLOCK)[None, :]
    dist = qi + BLOCK - ci
    in_band = (dist >= 0) & (dist < WINDOW)
    bias = rel_bias.astype(jnp.float32)[t5_bucket(dist)]
    bias = bias.transpose(2, 0, 1).reshape(N_SWA_KV_HEADS, SWA_GROUP, BLOCK, 2 * BLOCK)
    key_pos = jnp.arange(nb)[:, None] * BLOCK - BLOCK + ci
    valid = in_band[None] & (key_pos >= 0)[:, None, :]
    logits = jnp.where(valid[None, :, None, None], logits + bias, NEG)
    sink = jnp.broadcast_to(sinks.astype(jnp.float32).reshape(N_SWA_KV_HEADS, SWA_GROUP, 1, 1),
                            logits.shape[:-1] + (1,))
    probs = jax.nn.softmax(jnp.concatenate([logits, sink], axis=-1), axis=-1)[..., :-1]
    out = jnp.einsum('bnhgqc,bnchd->bnqhgd', probs.astype(v.dtype), vb)
    return out.reshape(B, S, N_SWA_HEADS * HEAD_DIM)


def fox_attention(q, k, v, log_f):
    B, S = q.shape[0], q.shape[1]
    nb = S // BLOCK
    F = jnp.cumsum(log_f, axis=1).transpose(0, 2, 1)
    qb = q.reshape(B, nb, BLOCK, N_FOX_HEADS, HEAD_DIM).transpose(1, 0, 2, 3, 4)
    Fq = F.reshape(B, N_FOX_HEADS, nb, BLOCK).transpose(2, 0, 1, 3)
    kpos = jnp.arange(S)

    def one_block(args):
        i, qi, fq = args
        logits = jnp.einsum('bqhd,bkhd->bhqk', qi, k).astype(jnp.float32) * (HEAD_DIM ** -0.5)
        logits = logits + fq[..., None] - F[:, :, None, :]
        qpos = i * BLOCK + jnp.arange(BLOCK)
        causal = kpos[None, :] <= qpos[:, None]
        probs = jax.nn.softmax(jnp.where(causal, logits, NEG), axis=-1)
        return jnp.einsum('bhqk,bkhd->bqhd', probs.astype(v.dtype), v)

    out = lax.map(one_block, (jnp.arange(nb), qb, Fq))
    return out.transpose(1, 0, 2, 3, 4).reshape(B, S, N_FOX_HEADS * HEAD_DIM)


def peer_ffn(x, w_query, sub_keys1, sub_keys2, expert_u, expert_v):
    B, S, D = x.shape
    xt = x.reshape((B * S) // PEER_CHUNK, PEER_CHUNK, D)

    def chunk(xc):
        qv = (xc @ w_query).reshape(PEER_CHUNK, PEER_HEADS, 2, D_HALF)
        s1 = jnp.einsum('thd,nd->thn', qv[:, :, 0], sub_keys1).astype(jnp.float32)
        s2 = jnp.einsum('thd,nd->thn', qv[:, :, 1], sub_keys2).astype(jnp.float32)
        v1, i1 = lax.top_k(s1, PEER_TOPK)
        v2, i2 = lax.top_k(s2, PEER_TOPK)
        cand_s = (v1[..., :, None] + v2[..., None, :]).reshape(PEER_CHUNK, PEER_HEADS, PEER_TOPK * PEER_TOPK)
        cand_i = (i1[..., :, None] * N_KEYS + i2[..., None, :]).reshape(PEER_CHUNK, PEER_HEADS, PEER_TOPK * PEER_TOPK)
        top_s, pos = lax.top_k(cand_s, PEER_TOPK)
        eidx = jnp.take_along_axis(cand_i, pos, axis=-1)
        g = jax.nn.softmax(top_s, axis=-1)
        pre = jnp.einsum('td,thkd->thk', xc, expert_u[eidx]).astype(jnp.float32)
        coef = (g * jax.nn.gelu(pre, approximate=False)).astype(xc.dtype)
        return jnp.einsum('thk,thkd->td', coef, expert_v[eidx])

    return lax.map(chunk, xt).reshape(B, S, D)


def setup_inputs(seed: int = 0) -> dict:
    key = jax.random.key(seed)
    ks = jax.random.split(key, 20)
    f32 = jnp.float32
    nrm = lambda k, shape, s: (jax.random.normal(k, shape, f32) * s).astype(f32)
    gain = lambda k, shape: (1.0 + 0.02 * jax.random.normal(k, shape, f32)).astype(f32)
    return {
        "x": nrm(ks[0], (BATCH, SEQ, D_MODEL), 1.0),
        "rel_bias": nrm(ks[1], (N_BUCKETS, N_SWA_HEADS), 0.5),
        "norm_mix": gain(ks[2], (DEPTH, D_MODEL)),
        "w_in": nrm(ks[3], (DEPTH, D_MODEL, IN_WIDTH), D_MODEL ** -0.5),
        "q_norm_a": gain(ks[4], (DEPTH, HEAD_DIM)),
        "k_norm_a": gain(ks[5], (DEPTH, HEAD_DIM)),
        "q_norm_b": gain(ks[6], (DEPTH, HEAD_DIM)),
        "k_norm_b": gain(ks[7], (DEPTH, HEAD_DIM)),
        "b_forget": jax.random.uniform(ks[8], (DEPTH, N_FOX_HEADS), f32, 1.0, 5.0),
        "sinks": nrm(ks[9], (DEPTH, N_SWA_HEADS), 0.5),
        "w_out": nrm(ks[10], (DEPTH, MIX_WIDTH, D_MODEL), MIX_WIDTH ** -0.5),
        "norm_ffn": gain(ks[11], (DEPTH, D_MODEL)),
        "w_query": nrm(ks[12], (DEPTH, D_MODEL, PEER_HEADS * D_KEY), D_MODEL ** -0.5),
        "sub_keys1": nrm(ks[13], (DEPTH, N_KEYS, D_HALF), D_HALF ** -0.5),
        "sub_keys2": nrm(ks[14], (DEPTH, N_KEYS, D_HALF), D_HALF ** -0.5),
        "expert_u": nrm(ks[15], (DEPTH, N_EXPERTS, D_MODEL), D_MODEL ** -0.5),
        "expert_v": nrm(ks[16], (DEPTH, N_EXPERTS, D_MODEL), (PEER_HEADS * PEER_TOPK) ** -0.5),
    }


def reference(x, rel_bias, norm_mix, w_in, q_norm_a, k_norm_a, q_norm_b, k_norm_b, b_forget,
              sinks, w_out, norm_ffn, w_query, sub_keys1, sub_keys2, expert_u, expert_v):
    B, S = x.shape[0], x.shape[1]
    for l in range(DEPTH):
        h = rms_norm(x, norm_mix[l])
        proj = h @ w_in[l]
        qa, ka, va, qb, kb, vb, fb = jnp.split(proj, SPLITS, axis=-1)
        qa = rms_norm(qa.reshape(B, S, N_SWA_HEADS, HEAD_DIM), q_norm_a[l])
        ka = rms_norm(ka.reshape(B, S, N_SWA_KV_HEADS, HEAD_DIM), k_norm_a[l])
        va = va.reshape(B, S, N_SWA_KV_HEADS, HEAD_DIM)
        qb = rms_norm(qb.reshape(B, S, N_FOX_HEADS, HEAD_DIM), q_norm_b[l])
        kb = rms_norm(kb.reshape(B, S, N_FOX_HEADS, HEAD_DIM), k_norm_b[l])
        vb = vb.reshape(B, S, N_FOX_HEADS, HEAD_DIM)
        log_f = jax.nn.log_sigmoid(fb.astype(jnp.float32) + b_forget[l].astype(jnp.float32))
        mix = jnp.concatenate([swa_attention(qa, ka, va, sinks[l], rel_bias),
                               fox_attention(qb, kb, vb, log_f)], axis=-1)
        x = x + mix @ w_out[l]
        x = x + peer_ffn(rms_norm(x, norm_ffn[l]), w_query[l], sub_keys1[l], sub_keys2[l],
                         expert_u[l], expert_v[l])
    return x
```

```cpp
#include <hip/hip_runtime.h>
#include <cstdint>
#include <cstdio>

namespace nv {
constexpr int D = 1024, BATCH = 4, SEQ = 4096, M = BATCH * SEQ, HD = 64;
constexpr int INW = 2312;
constexpr int C_QA = 0, C_KA = 512, C_VA = 640, C_QB = 768, C_KB = 1280, C_VB = 1792, C_FB = 2304;
constexpr int NKEYS = 128, PH = 8, TOPK = 16, DKEY = 256;
constexpr float EPS = 1e-6f;

__device__ __constant__ unsigned char T5B[128] = {0, 1, 2, 3, 4, 5, 6, 7, 8, 9, 10, 11, 12, 13, 14, 15, 16, 16, 16, 17, 17, 18, 18, 18, 19, 19, 19, 20, 20, 20, 20, 21, 21, 21, 21, 22, 22, 22, 22, 22, 23, 23, 23, 23, 23, 23, 24, 24, 24, 24, 24, 24, 25, 25, 25, 25, 25, 25, 25, 26, 26, 26, 26, 26, 26, 26, 26, 27, 27, 27, 27, 27, 27, 27, 27, 27, 27, 28, 28, 28, 28, 28, 28, 28, 28, 28, 28, 29, 29, 29, 29, 29, 29, 29, 29, 29, 29, 29, 29, 30, 30, 30, 30, 30, 30, 30, 30, 30, 30, 30, 30, 30, 30, 31, 31, 31, 31, 31, 31, 31, 31, 31, 31, 31, 31, 31, 31, 31};

__device__ __forceinline__ float wave_sum(float v) {
#pragma unroll
    for (int o = 1; o < 64; o <<= 1) v += __shfl_xor(v, o);
    return v;
}

__global__ void __launch_bounds__(256) k_rmsnorm(const float* __restrict__ x, const float* __restrict__ g, float* __restrict__ out) {
    const int lane = threadIdx.x & 63, row = blockIdx.x * 4 + (threadIdx.x >> 6);
    const float4* xr = (const float4*)(x + (size_t)row * D);
    float4 v[4]; float s = 0.f;
#pragma unroll
    for (int j = 0; j < 4; ++j) { v[j] = xr[lane + 64 * j]; s += v[j].x * v[j].x + v[j].y * v[j].y + v[j].z * v[j].z + v[j].w * v[j].w; }
    s = wave_sum(s);
    const float rs = rsqrtf(s * (1.f / D) + EPS);
    float4* orow = (float4*)(out + (size_t)row * D);
#pragma unroll
    for (int j = 0; j < 4; ++j) { const float4 gg = ((const float4*)g)[lane + 64 * j]; float4 o; o.x = v[j].x * rs * gg.x; o.y = v[j].y * rs * gg.y; o.z = v[j].z * rs * gg.z; o.w = v[j].w * rs * gg.w; orow[lane + 64 * j] = o; }
}

__global__ void __launch_bounds__(256) k_gemm(const float* __restrict__ A, const float* __restrict__ B, float* __restrict__ C, const float* __restrict__ R, int Mm, int N, int K) {
    __shared__ float As[16][68];
    __shared__ float Bs[16][68];
    const int tid = threadIdx.x, tx = tid & 15, ty = tid >> 4;
    const int m0 = blockIdx.y * 64, n0 = blockIdx.x * 64;
    float acc[4][4];
#pragma unroll
    for (int i = 0; i < 4; ++i)
#pragma unroll
        for (int j = 0; j < 4; ++j) acc[i][j] = 0.f;
    const int ar = tid >> 2, ak = (tid & 3) * 4;
    const int bk = tid >> 4, bn = (tid & 15) * 4;
    for (int k0 = 0; k0 < K; k0 += 16) {
        const float4 av = *(const float4*)(A + (size_t)(m0 + ar) * K + k0 + ak);
        float4 bv = make_float4(0.f, 0.f, 0.f, 0.f);
        if (n0 + bn < N) bv = *(const float4*)(B + (size_t)(k0 + bk) * N + n0 + bn);
        __syncthreads();
        As[ak + 0][ar] = av.x; As[ak + 1][ar] = av.y; As[ak + 2][ar] = av.z; As[ak + 3][ar] = av.w;
        *(float4*)&Bs[bk][bn] = bv;
        __syncthreads();
#pragma unroll
        for (int k = 0; k < 16; ++k) {
            const float4 a = *(const float4*)&As[k][ty * 4];
            const float4 b = *(const float4*)&Bs[k][tx * 4];
            const float aa[4] = {a.x, a.y, a.z, a.w}, bb[4] = {b.x, b.y, b.z, b.w};
#pragma unroll
            for (int i = 0; i < 4; ++i)
#pragma unroll
                for (int j = 0; j < 4; ++j) acc[i][j] += aa[i] * bb[j];
        }
    }
    const int col = n0 + tx * 4;
    if (col < N) {
#pragma unroll
        for (int i = 0; i < 4; ++i) {
            const size_t off = (size_t)(m0 + ty * 4 + i) * N + col;
            float4 o = make_float4(acc[i][0], acc[i][1], acc[i][2], acc[i][3]);
            if (R) { const float4 r = *(const float4*)(R + off); o.x += r.x; o.y += r.y; o.z += r.z; o.w += r.w; }
            *(float4*)(C + off) = o;
        }
    }
}

__global__ void __launch_bounds__(256) k_post_proj(float* __restrict__ proj, const float* __restrict__ gqa, const float* __restrict__ gka, const float* __restrict__ gqb, const float* __restrict__ gkb,
                                                   const float* __restrict__ bforget, float* __restrict__ logf) {
    const int lane = threadIdx.x & 63, t = blockIdx.x * 4 + (threadIdx.x >> 6);
    float* row = proj + (size_t)t * INW;
    for (int hh = 0; hh < 26; ++hh) {
        int col; const float* g;
        if (hh < 8) { col = C_QA + 64 * hh; g = gqa; } else if (hh < 10) { col = C_KA + 64 * (hh - 8); g = gka; } else if (hh < 18) { col = C_QB + 64 * (hh - 10); g = gqb; } else { col = C_KB + 64 * (hh - 18); g = gkb; }
        const float v = row[col + lane];
        const float ss = wave_sum(v * v);
        row[col + lane] = v * rsqrtf(ss * (1.f / 64.f) + EPS) * g[lane];
    }
    if (lane < 8) {
        const float z = row[C_FB + lane] + bforget[lane];
        logf[(size_t)t * 8 + lane] = fminf(z, 0.f) - log1pf(expf(-fabsf(z)));
    }
}

__global__ void __launch_bounds__(256) k_cumsum(const float* __restrict__ logf, float* __restrict__ F) {
    __shared__ float part[256];
    const int b = blockIdx.x >> 3, h = blockIdx.x & 7, tid = threadIdx.x;
    float v[16]; float s = 0.f;
#pragma unroll
    for (int i = 0; i < 16; ++i) { v[i] = logf[((size_t)b * SEQ + tid * 16 + i) * 8 + h]; s += v[i]; v[i] = s; }
    part[tid] = s;
    __syncthreads();
    if (tid == 0) { float run = 0.f; for (int i = 0; i < 256; ++i) { const float p = part[i]; part[i] = run; run += p; } }
    __syncthreads();
    const float base = part[tid];
#pragma unroll
    for (int i = 0; i < 16; ++i) F[((size_t)b * 8 + h) * SEQ + tid * 16 + i] = base + v[i];
}

template <bool FOX>
__global__ void __launch_bounds__(64) k_attn(const float* __restrict__ proj, const float* __restrict__ F, const float* __restrict__ sinks, const float* __restrict__ relb, float* __restrict__ mix) {
    const int lane = threadIdx.x;
    const int qt = blockIdx.x & 63, h = (blockIdx.x >> 6) & 7, b = blockIdx.x >> 9;
    const int q = qt * 64 + lane;
    const int qcol = FOX ? C_QB + 64 * h : C_QA + 64 * h;
    const int kcol = FOX ? C_KB + 64 * h : C_KA + 64 * (h >> 2);
    const int vcol = FOX ? C_VB + 64 * h : C_VA + 64 * (h >> 2);
    const float* base = proj + (size_t)b * SEQ * INW;
    float qr[64], o[64];
#pragma unroll
    for (int d = 0; d < 64; ++d) { qr[d] = base[(size_t)q * INW + qcol + d] * 0.125f; o[d] = 0.f; }
    float m, l, fq = 0.f;
    if (FOX) { m = -INFINITY; l = 0.f; fq = F[((size_t)b * 8 + h) * SEQ + q]; } else { m = sinks[h]; l = 1.f; }
    const int s_lo = FOX ? 0 : max(0, qt * 64 - 127), s_hi = qt * 64 + 63;
    for (int s = s_lo; s <= s_hi; ++s) {
        const float* kr = base + (size_t)s * INW + kcol;
        const float* vr = base + (size_t)s * INW + vcol;
        float dot = 0.f;
#pragma unroll
        for (int d = 0; d < 64; ++d) dot += qr[d] * kr[d];
        bool valid; float logit;
        if (FOX) { valid = (s <= q); logit = dot + fq - F[((size_t)b * 8 + h) * SEQ + s]; }
        else { const int dist = q - s; valid = (dist >= 0) && (dist < 128); logit = dot + relb[(int)T5B[dist & 127] * 8 + h]; }
        if (valid) {
            const float mn = fmaxf(m, logit);
            const float al = __expf(m - mn), p = __expf(logit - mn);
            l = l * al + p;
#pragma unroll
            for (int d = 0; d < 64; ++d) o[d] = o[d] * al + p * vr[d];
            m = mn;
        }
    }
    const float il = 1.f / l;
    float* orow = mix + ((size_t)b * SEQ + q) * D + (FOX ? 512 : 0) + 64 * h;
#pragma unroll
    for (int d = 0; d < 64; ++d) orow[d] = o[d] * il;
}

__device__ __forceinline__ void wave_argmax(float& v, int& i) {
#pragma unroll
    for (int o = 1; o < 64; o <<= 1) {
        const float v2 = __shfl_xor(v, o); const int i2 = __shfl_xor(i, o);
        if (v2 > v || (v2 == v && i2 < i)) { v = v2; i = i2; }
    }
}

__global__ void __launch_bounds__(256) k_topk(const float* __restrict__ qv, const float* __restrict__ sk1, const float* __restrict__ sk2, int* __restrict__ eidx, float* __restrict__ gate) {
    const int lane = threadIdx.x & 63, task = blockIdx.x * 4 + (threadIdx.x >> 6);
    const int t = task >> 3, h = task & 7;
    float lv[2]; int li[2];
    for (int half = 0; half < 2; ++half) {
        const float* qp = qv + (size_t)t * 2048 + h * 256 + half * 128;
        const float* sk = half ? sk2 : sk1;
        float s0 = 0.f, s1 = 0.f;
        for (int d = 0; d < 128; d += 4) {
            const float4 a = *(const float4*)(sk + (size_t)lane * 128 + d), c = *(const float4*)(sk + (size_t)(lane + 64) * 128 + d);
            s0 += qp[d] * a.x + qp[d + 1] * a.y + qp[d + 2] * a.z + qp[d + 3] * a.w;
            s1 += qp[d] * c.x + qp[d + 1] * c.y + qp[d + 2] * c.z + qp[d + 3] * c.w;
        }
        float myv = 0.f; int myi = 0;
        for (int r = 0; r < 16; ++r) {
            float bv; int bi;
            if (s0 >= s1) { bv = s0; bi = lane; } else { bv = s1; bi = lane + 64; }
            wave_argmax(bv, bi);
            if (bi == lane) s0 = -INFINITY;
            if (bi == lane + 64) s1 = -INFINITY;
            if (lane == r) { myv = bv; myi = bi; }
        }
        lv[half] = myv; li[half] = myi;
    }
    float cs[4];
#pragma unroll
    for (int c4 = 0; c4 < 4; ++c4) { const int c = lane + 64 * c4; cs[c4] = __shfl(lv[0], c >> 4) + __shfl(lv[1], c & 15); }
    float topv = 0.f; int tope = 0;
    for (int r = 0; r < 16; ++r) {
        float bv = cs[0]; int bi = lane;
#pragma unroll
        for (int c4 = 1; c4 < 4; ++c4) if (cs[c4] > bv) { bv = cs[c4]; bi = lane + 64 * c4; }
        wave_argmax(bv, bi);
#pragma unroll
        for (int c4 = 0; c4 < 4; ++c4) if (bi == lane + 64 * c4) cs[c4] = -INFINITY;
        const int e = __shfl(li[0], bi >> 4) * NKEYS + __shfl(li[1], bi & 15);
        if (lane == r) { topv = bv; tope = e; }
    }
    float mx = topv;
#pragma unroll
    for (int o = 1; o < 16; o <<= 1) mx = fmaxf(mx, __shfl_xor(mx, o));
    const float ex = __expf(topv - mx);
    float sm = ex;
#pragma unroll
    for (int o = 1; o < 16; o <<= 1) sm += __shfl_xor(sm, o);
    if (lane < 16) { eidx[(size_t)task * 16 + lane] = tope; gate[(size_t)task * 16 + lane] = ex / sm; }
}

__global__ void __launch_bounds__(256) k_gather(const float* __restrict__ h2, const float* __restrict__ x1, const int* __restrict__ eidx, const float* __restrict__ gate,
                                                const float* __restrict__ eu, const float* __restrict__ ev, float* __restrict__ out) {
    const int lane = threadIdx.x & 63, t = blockIdx.x * 4 + (threadIdx.x >> 6);
    const float4* hr = (const float4*)(h2 + (size_t)t * D);
    float4 hv[4], acc[4];
#pragma unroll
    for (int j = 0; j < 4; ++j) { hv[j] = hr[lane + 64 * j]; acc[j] = make_float4(0.f, 0.f, 0.f, 0.f); }
    for (int k = 0; k < 128; ++k) {
        const int e = eidx[(size_t)t * 128 + k]; const float g = gate[(size_t)t * 128 + k];
        const float4* ur = (const float4*)(eu + (size_t)e * D);
        float s = 0.f;
#pragma unroll
        for (int j = 0; j < 4; ++j) { const float4 u = ur[lane + 64 * j]; s += hv[j].x * u.x + hv[j].y * u.y + hv[j].z * u.z + hv[j].w * u.w; }
        s = wave_sum(s);
        const float coef = g * 0.5f * s * (1.f + erff(s * 0.70710678118654752f));
        const float4* vr = (const float4*)(ev + (size_t)e * D);
#pragma unroll
        for (int j = 0; j < 4; ++j) { const float4 v = vr[lane + 64 * j]; acc[j].x += coef * v.x; acc[j].y += coef * v.y; acc[j].z += coef * v.z; acc[j].w += coef * v.w; }
    }
    const float4* xr = (const float4*)(x1 + (size_t)t * D);
    float4* orow = (float4*)(out + (size_t)t * D);
#pragma unroll
    for (int j = 0; j < 4; ++j) { const float4 xx = xr[lane + 64 * j]; float4 o; o.x = xx.x + acc[j].x; o.y = xx.y + acc[j].y; o.z = xx.z + acc[j].z; o.w = xx.w + acc[j].w; orow[lane + 64 * j] = o; }
}
}

extern "C" void kernel_launch(void* const* d_in, const int* in_sizes, int n_in, void* d_out, int out_size, void* d_ws, size_t ws_size, hipStream_t stream) {
    using namespace nv;
    const float* x = (const float*)d_in[0]; const float* relb = (const float*)d_in[1]; const float* norm_mix = (const float*)d_in[2]; const float* w_in = (const float*)d_in[3];
    const float* gqa = (const float*)d_in[4]; const float* gka = (const float*)d_in[5]; const float* gqb = (const float*)d_in[6]; const float* gkb = (const float*)d_in[7];
    const float* bforget = (const float*)d_in[8]; const float* sinks = (const float*)d_in[9]; const float* w_out = (const float*)d_in[10]; const float* norm_ffn = (const float*)d_in[11];
    const float* w_query = (const float*)d_in[12]; const float* sk1 = (const float*)d_in[13]; const float* sk2 = (const float*)d_in[14]; const float* eu = (const float*)d_in[15]; const float* ev = (const float*)d_in[16];
    float* out = (float*)d_out;
    char* ws = (char*)d_ws;
    const size_t MiB = 1u << 20;
    float* proj = (float*)(ws);
    float* h = (float*)(ws + 152 * MiB);
    float* logf = (float*)(ws + 216 * MiB);
    float* F = (float*)(ws + 217 * MiB);
    float* mix = (float*)(ws + 152 * MiB);
    float* h2 = (float*)(ws);
    float* qv = (float*)(ws + 64 * MiB);
    int* eidx = (int*)(ws + 192 * MiB);
    float* gate = (float*)(ws + 200 * MiB);
    float* x1 = out;

    k_rmsnorm<<<M / 4, 256, 0, stream>>>(x, norm_mix, h);
    k_gemm<<<dim3((INW + 63) / 64, M / 64), 256, 0, stream>>>(h, w_in, proj, nullptr, M, INW, D);
    k_post_proj<<<M / 4, 256, 0, stream>>>(proj, gqa, gka, gqb, gkb, bforget, logf);
    k_cumsum<<<32, 256, 0, stream>>>(logf, F);
    k_attn<false><<<BATCH * 8 * 64, 64, 0, stream>>>(proj, F, sinks, relb, mix);
    k_attn<true><<<BATCH * 8 * 64, 64, 0, stream>>>(proj, F, sinks, relb, mix);
    k_gemm<<<dim3(D / 64, M / 64), 256, 0, stream>>>(mix, w_out, x1, x, M, D, D);
    k_rmsnorm<<<M / 4, 256, 0, stream>>>(x1, norm_ffn, h2);
    k_gemm<<<dim3(2048 / 64, M / 64), 256, 0, stream>>>(h2, w_query, qv, nullptr, M, 2048, D);
    k_topk<<<M * 8 / 4, 256, 0, stream>>>(qv, sk1, sk2, eidx, gate);
    k_gather<<<M / 4, 256, 0, stream>>>(h2, x1, eidx, gate, eu, ev, out);
}
```

```cpp
#include <hip/hip_runtime.h>
#include <cstdint>
#include <cstdio>
namespace pg8 {
#define PG8_LAS __attribute__((address_space(3)))
typedef unsigned short bf16_t;
typedef short bf16x8 __attribute__((ext_vector_type(8)));
typedef float f32x4 __attribute__((ext_vector_type(4)));
typedef unsigned u32x4 __attribute__((ext_vector_type(4)));
constexpr int BM = 256, BK = 64, HALF = 128, HTB = HALF * BK * 2  , STAGE_BYTES = 8 * HTB, NXCD = 8, WGM = 8;

__host__ __device__ __forceinline__ int lds_byte(int r, int c) { const int st = (r >> 4) * 2 + (c >> 5), rr = r & 15, cc = c & 31, ob = rr * 64 + cc * 2; return st * 1024 + (ob ^ (((ob >> 9) & 1) << 5)); }
__host__ __device__ __forceinline__ void stage_rc(int b, int& R, int& C) { const int st = b / 1024, sb = b % 1024, swz = sb ^ (((sb >> 9) & 1) << 5); R = (st >> 1) * 16 + swz / 64; C = (st & 1) * 32 + (swz % 64) / 2; }
__host__ __device__ __forceinline__ int perm32(int rho) { const int n = rho >> 4, i = rho & 15; return 8 * (i >> 2) + 4 * n + (i & 3); }

struct Unit { int pm, pn; };
struct Gemm { const bf16_t* A; const bf16_t* Bt; int M, N, K; };

struct StaticOrder {
    int nM, nN, nwg, G, c;
    __host__ __device__ void init(int M, int N, int G_, int c_) { nM = M / BM; nN = N / BM; nwg = nM * nN; G = G_; c = c_; }
    __host__ __device__ bool next(int i, Unit& u) const {
        const long L = (long)i * G + c; if (L >= nwg) return false;
        int wgid = (int)L; { const int q = nwg / NXCD, r = nwg % NXCD, xcd = wgid % NXCD, off = wgid / NXCD; wgid = (xcd < r ? xcd * (q + 1) : r * (q + 1) + (xcd - r) * q) + off; }
        const int nig = WGM * nN, gid = wgid / nig, fm = gid * WGM, gsz = (nM - fm) < WGM ? (nM - fm) : WGM;
        u.pm = fm + ((wgid % nig) % gsz); u.pn = (wgid % nig) / gsz; return true;
    }
    __device__ __forceinline__ void a_ready(const Unit&) const {}
    __device__ __forceinline__ void done(const Unit&) const {}
};

__device__ __forceinline__ unsigned cvt_pk_bf16(float lo, float hi) { unsigned r; asm volatile("v_cvt_pk_bf16_f32 %0, %1, %2" : "=v"(r) : "v"(lo), "v"(hi)); return r; }
typedef float f32x2 __attribute__((ext_vector_type(2)));
template <class Epi, class Sched, bool ALIGN_EPI = false, bool SP2 = false>
__device__ __forceinline__ void gemm_phase(PG8_LAS unsigned char* lds, const Gemm g, const Sched& S, const Epi& E) {
    int tid_ = threadIdx.x; asm volatile("" : "+v"(tid_));
    const int tid = tid_, wid = __builtin_amdgcn_readfirstlane(tid >> 6), lane = tid & 63, wr = wid >> 2, wc = wid & 3, fr = lane & 15, fq = lane >> 4;
    const int K = g.K, nt = K / BK;
    unsigned voffA[2], voffB[2];
#pragma unroll
    for (int i = 0; i < 2; ++i) { int R, C; stage_rc(tid * 16 + i * 8192, R, C); const int Rb = Epi::PERM ? ((R & ~31) + perm32(R & 31)) : R;
        voffA[i] = (unsigned)(R * K + C) * 2u; voffB[i] = (unsigned)(Rb * K + C) * 2u; }
    const size_t kstep = (size_t)(BK * 2);
    const size_t hstep = (size_t)HALF * K * 2;
    const size_t tstep = 2 * hstep;
    const unsigned ldsw = (unsigned)wid * 1024u;
    const int aoff = lds_byte(wr * 64 + fr, fq * 8), boff = lds_byte(wc * 32 + fr, fq * 8);
#define PG8_SA(b, h) (((b) * 2 + (h)) * HTB)
#define PG8_SB(b, h) ((4 + (b) * 2 + (h)) * HTB)
#define PG8_STAGE(bufoff, gbase, voff) do { _Pragma("unroll") for (int _i = 0; _i < 2; ++_i) \
        __builtin_amdgcn_global_load_lds((const unsigned*)((const char*)(gbase) + (voff)[_i]), (PG8_LAS unsigned*)(lds + (bufoff) + ldsw + _i * 8192), 16, 0, 0); } while (0)
#define PG8_LDA(dst, b, h) do { _Pragma("unroll") for (int m = 0; m < 4; ++m) _Pragma("unroll") for (int k = 0; k < 2; ++k) dst[m][k] = *(const PG8_LAS bf16x8*)(lds + PG8_SA(b, h) + aoff + m * 2048 + k * 1024); } while (0)
#define PG8_LDB(dst, b, h) do { _Pragma("unroll") for (int n = 0; n < 2; ++n) _Pragma("unroll") for (int k = 0; k < 2; ++k) dst[n][k] = *(const PG8_LAS bf16x8*)(lds + PG8_SB(b, h) + boff + n * 2048 + k * 1024); } while (0)
#define PG8_MMA(ai, bj, At, Bt) do { __builtin_amdgcn_s_setprio(1); _Pragma("unroll") for (int m = 0; m < 4; ++m) _Pragma("unroll") for (int n = 0; n < 2; ++n) _Pragma("unroll") for (int k = 0; k < 2; ++k) \
        acc[ai][bj][m][n] = __builtin_amdgcn_mfma_f32_16x16x32_bf16(Bt[n][k], At[m][k], acc[ai][bj][m][n], 0, 0, 0); __builtin_amdgcn_s_setprio(0); } while (0)
#define PG8_WAIT_V(n) asm volatile("s_waitcnt vmcnt(" #n ")" ::: "memory")
#define PG8_WAIT_L(n) asm volatile("s_waitcnt lgkmcnt(" #n ")" ::: "memory")
#define PG8_BAR __builtin_amdgcn_s_barrier()
#define PG8_SCHED __builtin_amdgcn_sched_barrier(0)
    Unit cur, nxt; int ui = 0;
    if (!S.next(0, cur)) return;
    f32x4 acc[2][2][4][2];
#pragma unroll
    for (int a = 0; a < 2; ++a)
#pragma unroll
        for (int b = 0; b < 2; ++b)
#pragma unroll
            for (int m = 0; m < 4; ++m)
#pragma unroll
                for (int n = 0; n < 2; ++n) acc[a][b][m][n] = (f32x4){0.f, 0.f, 0.f, 0.f};
    bf16x8 At[4][2], B0[2][2], B1[2][2];
    const char* cA = (const char*)g.A + (size_t)cur.pm * tstep; const char* cB = (const char*)g.Bt + (size_t)cur.pn * tstep;
    S.a_ready(cur);
    if constexpr (SP2) {
        PG8_STAGE(PG8_SB(0, 0), cB, voffB); PG8_STAGE(PG8_SB(0, 1), cB + hstep, voffB); PG8_STAGE(PG8_SA(0, 0), cA, voffA); PG8_STAGE(PG8_SA(0, 1), cA + hstep, voffA);
        if (wr == 1) PG8_BAR;
        PG8_WAIT_V(2); PG8_BAR;
        PG8_STAGE(PG8_SB(1, 0), cB + kstep, voffB); PG8_STAGE(PG8_SA(1, 0), cA + kstep, voffA); PG8_STAGE(PG8_SB(1, 1), cB + hstep + kstep, voffB);
        PG8_WAIT_V(6); PG8_BAR;
    } else {
        PG8_STAGE(PG8_SB(0, 0), cB, voffB); PG8_STAGE(PG8_SA(0, 0), cA, voffA); PG8_STAGE(PG8_SB(0, 1), cB + hstep, voffB); PG8_STAGE(PG8_SA(0, 1), cA + hstep, voffA);
        if (wr == 1) PG8_BAR;
        PG8_WAIT_V(4); PG8_BAR;
        PG8_STAGE(PG8_SB(1, 0), cB + kstep, voffB); PG8_STAGE(PG8_SA(1, 0), cA + kstep, voffA); PG8_STAGE(PG8_SB(1, 1), cB + hstep + kstep, voffB);
        PG8_WAIT_V(6); PG8_BAR;
    }
    for (;;) {
        const bool has_next = S.next(ui + 1, nxt);
        const char* nA = has_next ? (const char*)g.A + (size_t)nxt.pm * tstep : cA; const char* nB = has_next ? (const char*)g.Bt + (size_t)nxt.pn * tstep : cB;
        for (int t = 0; t < nt; t += 2) {
            const bool last = (t == nt - 2);
            const char* a1 = cA + (size_t)(t + 1) * kstep;
            const char* a2 = last ? nA : cA + (size_t)(t + 2) * kstep; const char* b2 = last ? nB : cB + (size_t)(t + 2) * kstep;
            const char* a3 = a2 + kstep; const char* b3 = b2 + kstep;
            if (last && has_next) S.a_ready(nxt);
            if constexpr (SP2) {
            PG8_LDB(B0, 0, 0); PG8_LDB(B1, 0, 1); PG8_SCHED; PG8_LDA(At, 0, 0); PG8_STAGE(PG8_SA(1, 1), a1 + hstep, voffA);
            PG8_WAIT_V(8); PG8_WAIT_L(0); PG8_BAR; PG8_MMA(0, 0, At, B0); PG8_MMA(0, 1, At, B1); PG8_BAR; PG8_SCHED;
            PG8_LDA(At, 0, 1); PG8_STAGE(PG8_SB(0, 0), b2, voffB); PG8_STAGE(PG8_SB(0, 1), b2 + hstep, voffB); PG8_STAGE(PG8_SA(0, 0), a2, voffA);
            PG8_WAIT_V(8); PG8_WAIT_L(0); PG8_BAR; PG8_MMA(1, 0, At, B0); PG8_MMA(1, 1, At, B1); PG8_BAR; PG8_SCHED;
            PG8_LDB(B0, 1, 0); PG8_LDB(B1, 1, 1); PG8_SCHED; PG8_LDA(At, 1, 0); PG8_STAGE(PG8_SA(0, 1), a2 + hstep, voffA);
            PG8_WAIT_V(8); PG8_WAIT_L(0); PG8_BAR; PG8_MMA(0, 0, At, B0); PG8_MMA(0, 1, At, B1); PG8_BAR; PG8_SCHED;
            PG8_LDA(At, 1, 1); PG8_STAGE(PG8_SB(1, 0), b3, voffB); PG8_STAGE(PG8_SB(1, 1), b3 + hstep, voffB); PG8_STAGE(PG8_SA(1, 0), a3, voffA);
            PG8_WAIT_V(8); PG8_WAIT_L(0); PG8_BAR; PG8_MMA(1, 0, At, B0); PG8_MMA(1, 1, At, B1); PG8_BAR; PG8_SCHED;
            } else {
            PG8_LDB(B0, 0, 0); PG8_SCHED; PG8_LDA(At, 0, 0); PG8_STAGE(PG8_SA(1, 1), a1 + hstep, voffA);
            PG8_WAIT_L(8); PG8_BAR; PG8_WAIT_L(0); PG8_MMA(0, 0, At, B0); PG8_BAR; PG8_SCHED;
            PG8_LDB(B1, 0, 1); PG8_STAGE(PG8_SB(0, 0), b2, voffB);
            PG8_BAR; PG8_WAIT_L(0); PG8_MMA(0, 1, At, B1); PG8_BAR;
            PG8_LDA(At, 0, 1); PG8_STAGE(PG8_SA(0, 0), a2, voffA);
            PG8_BAR; PG8_WAIT_L(0); PG8_MMA(1, 0, At, B0); PG8_BAR; PG8_SCHED;
            PG8_STAGE(PG8_SB(0, 1), b2 + hstep, voffB);
            PG8_WAIT_V(6); PG8_BAR; PG8_MMA(1, 1, At, B1); PG8_BAR;
            PG8_LDB(B0, 1, 0); PG8_SCHED; PG8_LDA(At, 1, 0); PG8_STAGE(PG8_SA(0, 1), a2 + hstep, voffA);
            PG8_WAIT_L(8); PG8_BAR; PG8_WAIT_L(0); PG8_MMA(0, 0, At, B0); PG8_BAR; PG8_SCHED;
            PG8_LDB(B1, 1, 1); PG8_STAGE(PG8_SB(1, 0), b3, voffB);
            PG8_BAR; PG8_WAIT_L(0); PG8_MMA(0, 1, At, B1); PG8_BAR;
            PG8_LDA(At, 1, 1); PG8_STAGE(PG8_SA(1, 0), a3, voffA);
            PG8_BAR; PG8_WAIT_L(0); PG8_MMA(1, 0, At, B0); PG8_BAR; PG8_SCHED;
            PG8_STAGE(PG8_SB(1, 1), b3 + hstep, voffB);
            PG8_WAIT_V(6); PG8_BAR; PG8_MMA(1, 1, At, B1); PG8_BAR;
            }
        }
        if constexpr (ALIGN_EPI) { if (wr == 0) PG8_BAR; }
        if constexpr (!Epi::AFTER_DRAIN) { E(acc, cur, wr, wc, fr, fq); S.done(cur); }
        if (!has_next) break;
#pragma unroll
        for (int a = 0; a < 2; ++a)
#pragma unroll
            for (int b = 0; b < 2; ++b)
#pragma unroll
                for (int m = 0; m < 4; ++m)
#pragma unroll
                    for (int n = 0; n < 2; ++n) acc[a][b][m][n] = (f32x4){0.f, 0.f, 0.f, 0.f};
        cur = nxt; cA = nA; cB = nB; ++ui;
        if constexpr (ALIGN_EPI) { if (wr == 1) PG8_BAR; }
    }
    PG8_WAIT_V(0);
    if constexpr (!ALIGN_EPI) { if (wr == 0) PG8_BAR; }
    PG8_BAR;
    if constexpr (Epi::AFTER_DRAIN) { E.fused(acc, cur, wr, wc, fr, fq, lds, wid, lane); S.done(cur); }
#undef PG8_SA
#undef PG8_SB
#undef PG8_STAGE
#undef PG8_LDA
#undef PG8_LDB
#undef PG8_MMA
#undef PG8_WAIT_V
#undef PG8_WAIT_L
#undef PG8_BAR
#undef PG8_SCHED
}
}
namespace mk {
using pg8::bf16_t; using pg8::f32x4; using pg8::u32x4; using pg8::Unit; using pg8::cvt_pk_bf16;
typedef unsigned u32x2 __attribute__((ext_vector_type(2)));
#define LAS __attribute__((address_space(3)))
constexpr int D = 1024, BATCH = 4, SEQ = 4096, M = BATCH * SEQ;
constexpr int INW = 2312, NQKV = 2304, NQ = 2048, NEXP = 16384;
constexpr float EPS = 1e-6f, LOG2E = 1.4426950408889634f, C2 = 0.125f * LOG2E;
constexpr size_t MiB = 1u << 20;
constexpr size_t WS_CTL = 0, WS_WTIN = 1 * MiB, WS_WTOUT = 6 * MiB, WS_WTQ = 8 * MiB, WS_SK = 12 * MiB, WS_LOGF = 13 * MiB, WS_F2 = 13 * MiB + 512 * 1024, WS_SSQ = 14 * MiB,
                 WS_EIDX = 16 * MiB, WS_GATE = 24 * MiB, WS_XN = 32 * MiB, WS_QA = 64 * MiB, WS_KA = 80 * MiB, WS_VA = 84 * MiB, WS_QB = 88 * MiB, WS_KB = 104 * MiB, WS_VB = 120 * MiB,
                 WS_MIX = 136 * MiB, WS_QV = 64 * MiB, WS_EU8 = 168 * MiB, WS_EV8 = 184 * MiB, WS_X1 = 192 * MiB, WS_COEF = 136 * MiB, WS_CSUM = 144 * MiB, WS_SU = 15 * MiB, WS_SV = 15 * MiB + 65536, WS_RR = 15 * MiB + 131072;

__device__ __constant__ unsigned char T5B[128] = {0, 1, 2, 3, 4, 5, 6, 7, 8, 9, 10, 11, 12, 13, 14, 15, 16, 16, 16, 17, 17, 18, 18, 18, 19, 19, 19, 20, 20, 20, 20, 21, 21, 21, 21, 22, 22, 22, 22, 22, 23, 23, 23, 23, 23, 23, 24, 24, 24, 24, 24, 24, 25, 25, 25, 25, 25, 25, 25, 26, 26, 26, 26, 26, 26, 26, 26, 27, 27, 27, 27, 27, 27, 27, 27, 27, 27, 28, 28, 28, 28, 28, 28, 28, 28, 28, 28, 29, 29, 29, 29, 29, 29, 29, 29, 29, 29, 29, 29, 30, 30, 30, 30, 30, 30, 30, 30, 30, 30, 30, 30, 30, 30, 31, 31, 31, 31, 31, 31, 31, 31, 31, 31, 31, 31, 31, 31, 31};

__device__ __forceinline__ float wave_sum(float v) {
#pragma unroll
    for (int o = 1; o < 64; o <<= 1) v += __shfl_xor(v, o);
    return v;
}
__device__ __forceinline__ float bf_lo(unsigned w) { return __uint_as_float(w << 16); }
__device__ __forceinline__ float bf_hi(unsigned w) { return __uint_as_float(w & 0xffff0000u); }

struct EpiQKV {
    static constexpr bool PERM = true, AFTER_DRAIN = false;
    bf16_t *QA, *KA, *VA, *QB, *KB, *VB; const float *gqa, *gka, *gqb, *gkb; const float* rr;
    __device__ __forceinline__ void operator()(const f32x4 (&acc)[2][2][4][2], const Unit& u, int wr, int wc, int fr, int fq) const {
        const int s = u.pn * 4 + wc;
        bf16_t* dst; int pitch; const float* g; float sc = 1.f;
        if (s < 8) { dst = QA + 64 * s; pitch = 512; g = gqa; sc = C2; }
        else if (s < 10) { dst = KA + 64 * (s - 8); pitch = 128; g = gka; }
        else if (s < 12) { dst = VA + 64 * (s - 10); pitch = 128; g = nullptr; }
        else if (s < 20) { dst = QB + 64 * (s - 12); pitch = 512; g = gqb; sc = C2; }
        else if (s < 28) { dst = KB + 64 * (s - 20); pitch = 512; g = gkb; }
        else { dst = VB + 64 * (s - 28); pitch = 512; g = nullptr; }
        f32x4 gv[2][2];
#pragma unroll
        for (int bj = 0; bj < 2; ++bj)
#pragma unroll
            for (int n = 0; n < 2; ++n) gv[bj][n] = g ? *(const f32x4*)(g + 32 * bj + 8 * fq + 4 * n) * sc : (f32x4){1.f, 1.f, 1.f, 1.f};
        const int row0 = u.pm * 256 + wr * 64 + fr;
        float rw[2][4];
#pragma unroll
        for (int ai = 0; ai < 2; ++ai)
#pragma unroll
            for (int m = 0; m < 4; ++m) rw[ai][m] = rr[row0 + ai * 128 + m * 16];
#pragma unroll
        for (int ai = 0; ai < 2; ++ai)
#pragma unroll
            for (int m = 0; m < 4; ++m) {
                float ss = 0.f;
#pragma unroll
                for (int bj = 0; bj < 2; ++bj)
#pragma unroll
                    for (int n = 0; n < 2; ++n) { const f32x4 v = acc[ai][bj][m][n]; ss += (v[0] * v[0] + v[1] * v[1]) + (v[2] * v[2] + v[3] * v[3]); }
                ss += __shfl_xor(ss, 16); ss += __shfl_xor(ss, 32);
                const float rx = rw[ai][m]; const float rs = g ? rsqrtf(ss * (rx * rx) * (1.f / 64.f) + EPS) * rx : rx;
                bf16_t* rowp = dst + (size_t)(row0 + ai * 128 + m * 16) * pitch + 8 * fq;
#pragma unroll
                for (int bj = 0; bj < 2; ++bj) {
                    const f32x4 v0 = acc[ai][bj][m][0] * rs * gv[bj][0], v1 = acc[ai][bj][m][1] * rs * gv[bj][1];
                    u32x4 w; w.x = cvt_pk_bf16(v0[0], v0[1]); w.y = cvt_pk_bf16(v0[2], v0[3]); w.z = cvt_pk_bf16(v1[0], v1[1]); w.w = cvt_pk_bf16(v1[2], v1[3]);
                    *(u32x4*)(rowp + 32 * bj) = w;
                }
            }
    }
};
struct EpiOut {
    static constexpr bool PERM = false, AFTER_DRAIN = false;
    bf16_t* ap; float* ssq;
    __device__ __forceinline__ void operator()(const f32x4 (&acc)[2][2][4][2], const Unit& u, int wr, int wc, int fr, int fq) const {
        const int col0 = u.pn * 256 + wc * 32 + 4 * fq;
        const int row0 = u.pm * 256 + wr * 64 + fr;
#pragma unroll
        for (int ai = 0; ai < 2; ++ai) {
            u32x2 xc[4][2][2];
#pragma unroll
            for (int m = 0; m < 4; ++m)
#pragma unroll
                for (int bj = 0; bj < 2; ++bj)
#pragma unroll
                    for (int n = 0; n < 2; ++n) xc[m][bj][n] = *(const u32x2*)(ap + (size_t)(row0 + ai * 128 + m * 16) * D + col0 + bj * 128 + n * 16);
            __builtin_amdgcn_sched_barrier(0);
#pragma unroll
            for (int m = 0; m < 4; ++m) {
                const int row = row0 + ai * 128 + m * 16; const size_t off = (size_t)row * D + col0; float ss = 0.f;
#pragma unroll
                for (int bj = 0; bj < 2; ++bj)
#pragma unroll
                    for (int n = 0; n < 2; ++n) {
                        const size_t o2 = off + bj * 128 + n * 16;
                        const u32x2 xw = xc[m][bj][n]; const f32x4 v = acc[ai][bj][m][n] + (f32x4){bf_lo(xw.x), bf_hi(xw.x), bf_lo(xw.y), bf_hi(xw.y)};
                        ss += (v[0] * v[0] + v[1] * v[1]) + (v[2] * v[2] + v[3] * v[3]);
                        u32x2 w; w.x = cvt_pk_bf16(v[0], v[1]); w.y = cvt_pk_bf16(v[2], v[3]);
                        *(u32x2*)(ap + o2) = w;
                    }
                ss += __shfl_xor(ss, 16); ss += __shfl_xor(ss, 32);
                if (fq == 0) ssq[(size_t)row * 16 + u.pn * 4 + wc] = ss;
            }
        }
    }
};
struct EpiQV {
    static constexpr bool PERM = true, AFTER_DRAIN = false;
    bf16_t* qv; const float* ssq;
    __device__ __forceinline__ void operator()(const f32x4 (&acc)[2][2][4][2], const Unit& u, int wr, int wc, int fr, int fq) const {
        const int row0 = u.pm * 256 + wr * 64 + fr, col0 = u.pn * 256 + wc * 32 + 8 * fq;
#pragma unroll
        for (int ai = 0; ai < 2; ++ai)
#pragma unroll
            for (int m = 0; m < 4; ++m) {
                const int row = row0 + ai * 128 + m * 16;
                const f32x4* sp = (const f32x4*)(ssq + (size_t)row * 16);
                const f32x4 s0 = sp[0], s1 = sp[1], s2 = sp[2], s3 = sp[3];
                const float tot = ((s0[0] + s0[1]) + (s0[2] + s0[3])) + ((s1[0] + s1[1]) + (s1[2] + s1[3])) + ((s2[0] + s2[1]) + (s2[2] + s2[3])) + ((s3[0] + s3[1]) + (s3[2] + s3[3]));
                const float rs = rsqrtf(tot * (1.f / D) + EPS);
                bf16_t* rowp = qv + (size_t)row * NQ + col0;
#pragma unroll
                for (int bj = 0; bj < 2; ++bj) {
                    const f32x4 v0 = acc[ai][bj][m][0] * rs, v1 = acc[ai][bj][m][1] * rs;
                    u32x4 w; w.x = cvt_pk_bf16(v0[0], v0[1]); w.y = cvt_pk_bf16(v0[2], v0[3]); w.z = cvt_pk_bf16(v1[0], v1[1]); w.w = cvt_pk_bf16(v1[2], v1[3]);
                    *(u32x4*)(rowp + 128 * bj) = w;
                }
            }
    }
};

__device__ __forceinline__ int rowmap_in(int n0) { const int s = n0 >> 6, bj = (n0 >> 5) & 1; return 256 * (s >> 2) + 128 * bj + 32 * (s & 3); }
template <bool MAPIN, bool SCALE = false  >
__device__ __forceinline__ void p0_transpose_item(const float* __restrict__ W, int ldw, int K, int nblk, bf16_t* __restrict__ WT, LAS float* scr, int item, int lane, const float* __restrict__ rsc = nullptr) {
    const int kb = item / nblk, nb = item % nblk, k0 = 64 * kb, n0 = 32 * nb;
    const int r0 = MAPIN ? rowmap_in(n0) : n0;
#pragma unroll 8
    for (int i = 0; i < 32; ++i) { const int kk = 2 * i + (lane >> 5); scr[kk * 33 + (lane & 31)] = W[(size_t)(k0 + kk) * ldw + n0 + (lane & 31)] * (SCALE ? rsc[k0 + kk] : 1.f); }
    asm volatile("s_waitcnt lgkmcnt(0)" ::: "memory");
    const int c = lane & 7;
#pragma unroll
    for (int j = 0; j < 4; ++j) { const int n = (lane >> 3) + 8 * j; const LAS float* s = scr + (8 * c) * 33 + n;
        u32x4 o; o.x = cvt_pk_bf16(s[0 * 33], s[1 * 33]); o.y = cvt_pk_bf16(s[2 * 33], s[3 * 33]); o.z = cvt_pk_bf16(s[4 * 33], s[5 * 33]); o.w = cvt_pk_bf16(s[6 * 33], s[7 * 33]);
        *(u32x4*)(WT + (size_t)(r0 + n) * K + k0 + 8 * c) = o; }
    asm volatile("s_waitcnt lgkmcnt(0)" ::: "memory");
}
__device__ __forceinline__ void p0_keyfold_item(const float* __restrict__ wq, const float* __restrict__ sk1, const float* __restrict__ sk2, const float* __restrict__ g, bf16_t* __restrict__ WT, int item, int lane) {
    typedef short bf16x8s_ __attribute__((ext_vector_type(8)));
    typedef float f32x16_ __attribute__((ext_vector_type(16)));
    const int tile = item & 3, k0 = 32 * ((item >> 2) & 31), hh2 = item >> 7, tl = lane & 31, dg = lane >> 5;
    const float* sp = ((hh2 & 1) ? sk2 : sk1) + (size_t)(32 * tile + tl) * 128 + dg * 8;
    const float* wrow = wq + (size_t)(k0 + tl) * NQ + hh2 * 128 + dg * 8;
    const float gk = g[k0 + tl];
    f32x4 a0[8], a1[8], b0[8], b1[8];
#pragma unroll
    for (int ds = 0; ds < 8; ++ds) { b0[ds] = *(const f32x4*)(wrow + ds * 16); b1[ds] = *(const f32x4*)(wrow + ds * 16 + 4); a0[ds] = *(const f32x4*)(sp + ds * 16); a1[ds] = *(const f32x4*)(sp + ds * 16 + 4); }
    f32x16_ acc;
#pragma unroll
    for (int r = 0; r < 16; ++r) acc[r] = 0.f;
#pragma unroll
    for (int ds = 0; ds < 8; ++ds) {
        const f32x4 p0 = b0[ds] * gk, p1 = b1[ds] * gk;
        const u32x4 bw = {cvt_pk_bf16(p0[0], p0[1]), cvt_pk_bf16(p0[2], p0[3]), cvt_pk_bf16(p1[0], p1[1]), cvt_pk_bf16(p1[2], p1[3])};
        const u32x4 aw = {cvt_pk_bf16(a0[ds][0], a0[ds][1]), cvt_pk_bf16(a0[ds][2], a0[ds][3]), cvt_pk_bf16(a1[ds][0], a1[ds][1]), cvt_pk_bf16(a1[ds][2], a1[ds][3])};
        acc = __builtin_amdgcn_mfma_f32_32x32x16_bf16(__builtin_bit_cast(bf16x8s_, aw), __builtin_bit_cast(bf16x8s_, bw), acc, 0, 0, 0);
    }
    const int odd = tl & 1;
#pragma unroll
    for (int r = 0; r < 16; r += 2) {
        const float own0 = acc[r], own1 = acc[r + 1];
        const float recv = __shfl_xor(odd ? own0 : own1, 1);
        const int n = 32 * tile + ((r + odd) & 3) + 8 * ((r + odd) >> 2) + 4 * dg;
        const unsigned w = odd ? cvt_pk_bf16(recv, own1) : cvt_pk_bf16(own0, recv);
        *(unsigned*)(WT + (size_t)(hh2 * 128 + n) * D + k0 + (tl & ~1)) = w;
    }
}
__device__ __forceinline__ void p0_convert(const float* __restrict__ src, bf16_t* __restrict__ dst, size_t n8, int gw, int NGW, int lane) {
    for (size_t i = (size_t)gw * 64 + lane; i < n8; i += (size_t)NGW * 64) {
        const f32x4 a = ((const f32x4*)src)[2 * i], b = ((const f32x4*)src)[2 * i + 1];
        u32x4 w; w.x = cvt_pk_bf16(a[0], a[1]); w.y = cvt_pk_bf16(a[2], a[3]); w.z = cvt_pk_bf16(b[0], b[1]); w.w = cvt_pk_bf16(b[2], b[3]);
        ((u32x4*)dst)[i] = w;
    }
}
__device__ __forceinline__ void p0_rows(const float* __restrict__ x, const float* __restrict__ g, const float* __restrict__ w_in, const float* __restrict__ bforget, bf16_t* __restrict__ XN, float* __restrict__ RR, float* __restrict__ logf, int gw, int NGW, int lane) {
    f32x4 wa[16], wb[16];
#pragma unroll
    for (int jj = 0; jj < 4; ++jj)
#pragma unroll
        for (int e = 0; e < 4; ++e) { const f32x4* wp = (const f32x4*)(w_in + (size_t)(256 * jj + 4 * lane + e) * INW + NQKV); wa[jj * 4 + e] = wp[0]; wb[jj * 4 + e] = wp[1]; }
    const float bl = bforget[lane & 7];
#pragma unroll 1
    for (int rowb = gw; rowb < M; rowb += 4 * NGW) {
        f32x4 v4[4][4];
#pragma unroll
        for (int r = 0; r < 4; ++r) { const int row = rowb + r * NGW < M ? rowb + r * NGW : rowb; const f32x4* xr = (const f32x4*)(x + (size_t)row * D);
#pragma unroll
            for (int jj = 0; jj < 4; ++jj) v4[r][jj] = __builtin_nontemporal_load(xr + lane + 64 * jj); }
#pragma unroll
        for (int r = 0; r < 4; ++r) {
            const int row = rowb + r * NGW;
            if (row < M) {
                float s = 0.f;
#pragma unroll
                for (int jj = 0; jj < 4; ++jj) { const f32x4 v = v4[r][jj]; s += (v[0] * v[0] + v[1] * v[1]) + (v[2] * v[2] + v[3] * v[3]); }
                s = wave_sum(s);
                const float rs = rsqrtf(s * (1.f / D) + EPS);
                f32x4 pa = {0.f, 0.f, 0.f, 0.f}, pb = {0.f, 0.f, 0.f, 0.f};
#pragma unroll
                for (int jj = 0; jj < 4; ++jj) {
                    const f32x4 v = v4[r][jj]; const f32x4 h = v * rs * ((const f32x4*)g)[lane + 64 * jj];
                    u32x2 w; w.x = cvt_pk_bf16(v[0], v[1]); w.y = cvt_pk_bf16(v[2], v[3]);
                    *(u32x2*)(XN + (size_t)row * D + 256 * jj + 4 * lane) = w;
#pragma unroll
                    for (int e = 0; e < 4; ++e) { pa += wa[jj * 4 + e] * h[e]; pb += wb[jj * 4 + e] * h[e]; }
                }
                float z = 0.f;
#pragma unroll
                for (int j = 0; j < 4; ++j) { const float sa = wave_sum(pa[j]), sb = wave_sum(pb[j]); if (lane == j) z = sa; if (lane == 4 + j) z = sb; }
                if (lane == 8) RR[row] = rs;
                if (lane < 8) { z += bl; logf[(size_t)row * 8 + lane] = fminf(z, 0.f) - log1pf(expf(-fabsf(z))); }
            }
        }
    }
}
__device__ __forceinline__ void p1_cumsum(int bh, LAS float* part, const float* __restrict__ logf, float* __restrict__ F2) {
    const int b = bh >> 3, h = bh & 7, tid = threadIdx.x, lane = tid & 63, wv = tid >> 6;
    float v[8]; float s = 0.f;
#pragma unroll
    for (int i = 0; i < 8; ++i) { s += logf[((size_t)b * SEQ + tid * 8 + i) * 8 + h]; v[i] = s; }
    float inc = s;
#pragma unroll
    for (int o = 1; o < 64; o <<= 1) { const float t = __shfl_up(inc, o); if (lane >= o) inc += t; }
    if (lane == 63) part[wv] = inc;
    __syncthreads();
    float base = inc - s;
    for (int w = 0; w < wv; ++w) base += part[w];
#pragma unroll
    for (int i = 0; i < 8; ++i) F2[(size_t)bh * SEQ + tid * 8 + i] = (base + v[i]) * LOG2E;
    __syncthreads();
}
__device__ __forceinline__ float wave_max(float v) {
#pragma unroll
    for (int o = 1; o < 64; o <<= 1) v = fmaxf(v, __shfl_xor(v, o));
    return v;
}
template <bool SIGNED  >
__device__ __forceinline__ void p0_quant4_rows(const float* __restrict__ T, unsigned char* __restrict__ T4, float* __restrict__ SC, int gw, int NGW, int lane) {
    for (int row = gw; row < NEXP; row += NGW) {
        const f32x4* tr = (const f32x4*)(T + (size_t)row * D + 16 * lane);
        f32x4 v[4]; float ss = 0.f;
#pragma unroll
        for (int j = 0; j < 4; ++j) { v[j] = __builtin_nontemporal_load(tr + j); ss += (v[j][0] * v[j][0] + v[j][1] * v[j][1]) + (v[j][2] * v[j][2] + v[j][3] * v[j][3]); }
        ss = wave_sum(ss);
        const float s = fmaxf(0.3352f * sqrtf(ss * (1.f / D)), 1e-30f), inv = 1.f / s;
        u32x2 w;
#pragma unroll
        for (int j2 = 0; j2 < 2; ++j2) {
            unsigned p = 0;
#pragma unroll
            for (int e = 0; e < 4; ++e) {
                const int lo = ((int)fminf(fmaxf(floorf(v[2 * j2][e] * inv), -8.f), 7.f) + (SIGNED ? 0 : 8)) & 15, hi = ((int)fminf(fmaxf(floorf(v[2 * j2 + 1][e] * inv), -8.f), 7.f) + (SIGNED ? 0 : 8)) & 15;
                p |= ((unsigned)lo | ((unsigned)hi << 4)) << (8 * e);
            }
            w[j2] = p;
        }
        *(u32x2*)(T4 + (size_t)row * 512 + 8 * lane) = w;
        if (lane == 0) SC[row] = s;
    }
}

__device__ __forceinline__ int row16_sum_i(int v) {
    v += __builtin_amdgcn_update_dpp(0, v, 0xB1, 0xf, 0xf, false);
    v += __builtin_amdgcn_update_dpp(0, v, 0x4E, 0xf, 0xf, false);
    v += __builtin_amdgcn_update_dpp(0, v, 0x141, 0xf, 0xf, false);
    v += __builtin_amdgcn_update_dpp(0, v, 0x140, 0xf, 0xf, false);
    return v;
}
typedef int i32x4 __attribute__((ext_vector_type(4)));
typedef float f32x2 __attribute__((ext_vector_type(2)));
__device__ __forceinline__ float ub(unsigned w, int k) { return (float)((w >> (8 * k)) & 0xffu); }

constexpr int GQ_DOT = 0, GQ_TOKC = 4096, GQ_PKL = 4352, GQ_UN = 5376, GQ_H2Q = GQ_UN, GQ_UIMG = GQ_UN + 8192, GQ_VIMG = GQ_UN, GQ_WAVE = 17920;
constexpr int GQ_UROW = 68, GQ_VROW = 36;
static_assert(GQ_UIMG + 16 * GQ_UROW * 4 <= GQ_WAVE && GQ_VIMG + 64 * GQ_VROW * 4 <= GQ_WAVE && 8 * GQ_WAVE <= 147440, "gather LDS");
#define GT_DPP(v, ctrl) __uint_as_float((unsigned)__builtin_amdgcn_update_dpp(0, (int)__float_as_uint(v), ctrl, 0xf, 0xf, false))
__device__ __forceinline__ float wave_max_u(float v) {
    v = fmaxf(v, GT_DPP(v, 0xB1)); v = fmaxf(v, GT_DPP(v, 0x4E)); v = fmaxf(v, GT_DPP(v, 0x141)); v = fmaxf(v, GT_DPP(v, 0x140));
    const int iv = (int)__float_as_uint(v);
    const float a = __uint_as_float((unsigned)__builtin_amdgcn_readlane(iv, 0)), b = __uint_as_float((unsigned)__builtin_amdgcn_readlane(iv, 16)), c = __uint_as_float((unsigned)__builtin_amdgcn_readlane(iv, 32)), d = __uint_as_float((unsigned)__builtin_amdgcn_readlane(iv, 48));
    return fmaxf(fmaxf(a, b), fmaxf(c, d));
}
__device__ __forceinline__ int wave_sum_iu(int v) { v = row16_sum_i(v); return (__builtin_amdgcn_readlane(v, 0) + __builtin_amdgcn_readlane(v, 16)) + (__builtin_amdgcn_readlane(v, 32) + __builtin_amdgcn_readlane(v, 48)); }

template <class Bar>
__device__ __forceinline__ void gather_chunked(const bf16_t* __restrict__ ap, const float* __restrict__ ssq, const float* __restrict__ gffn, const int* __restrict__ eidx, const float* __restrict__ gate,
                                               const unsigned char* __restrict__ EU4, const unsigned char* __restrict__ EV4, const float* __restrict__ SU, const float* __restrict__ SV,
                                               float* __restrict__ out, LAS unsigned char* wl, int tfirst, int tstep, int tstride, int ntb  , int lane, const Bar& bar) {
    const int g8 = lane >> 3, pc = lane & 7, g84 = 4 * g8;
    const unsigned pc16 = (unsigned)pc * 16u;
    LAS int* DOT = (LAS int*)(wl + GQ_DOT); LAS float* TOKC = (LAS float*)(wl + GQ_TOKC); LAS unsigned* PKL = (LAS unsigned*)(wl + GQ_PKL);
    LAS unsigned char* H2Q = wl + GQ_H2Q; LAS int* UIMG = (LAS int*)(wl + GQ_UIMG); LAS int* VIMG = (LAS int*)(wl + GQ_VIMG);
#pragma unroll 1
    for (int tb = 0; tb < ntb; ++tb) {
        const int t0 = tfirst + tb * tstep;
        int ntok = 0; if (t0 < M) { ntok = (M - t0 + tstride - 1) / tstride; ntok = ntok > 8 ? 8 : ntok; }
#pragma unroll 1
        for (int i = 0; i < ntok; ++i) {
            const int t = t0 + i * tstride;
            float rs;
            { const f32x4* sp = (const f32x4*)(ssq + (size_t)t * 16); const f32x4 a = sp[0], b = sp[1], c = sp[2], d = sp[3];
              const float tot = ((a[0] + a[1]) + (a[2] + a[3])) + ((b[0] + b[1]) + (b[2] + b[3])) + ((c[0] + c[1]) + (c[2] + c[3])) + ((d[0] + d[1]) + (d[2] + d[3]));
              rs = rsqrtf(tot * (1.f / D) + EPS); }
            const u32x4* hp = (const u32x4*)(ap + (size_t)t * D + 16 * lane); const u32x4 w0 = hp[0], w1 = hp[1];
            float h[16];
#pragma unroll
            for (int k = 0; k < 4; ++k) { h[2 * k] = bf_lo(w0[k]); h[2 * k + 1] = bf_hi(w0[k]); h[8 + 2 * k] = bf_lo(w1[k]); h[8 + 2 * k + 1] = bf_hi(w1[k]); }
#pragma unroll
            for (int k = 0; k < 4; ++k) { const f32x4 gk = ((const f32x4*)(gffn + 16 * lane))[k]; h[4 * k] *= gk[0]; h[4 * k + 1] *= gk[1]; h[4 * k + 2] *= gk[2]; h[4 * k + 3] *= gk[3]; }
            float am = 0.f;
#pragma unroll
            for (int k = 0; k < 16; ++k) am = fmaxf(am, fabsf(h[k]));
            am = wave_max_u(am);
            const float hinv = am > 0.f ? 119.f / am : 0.f;
            u32x4 qw; int hs = 0;
#pragma unroll
            for (int d = 0; d < 2; ++d) { unsigned ph = 0, pl = 0;
#pragma unroll
                for (int k = 0; k < 8; ++k) { const int col = 8 * d + ((k & 1) ? 4 + (k >> 1) : (k >> 1)); const int q = __float2int_rn(h[col] * hinv); hs += q;
                    const int hh_ = (q + 8) >> 4, hl_ = q - 16 * hh_; ph |= ((unsigned)hh_ & 15u) << (4 * k); pl |= ((unsigned)hl_ & 15u) << (4 * k); }
                qw[2 * d] = ph; qw[2 * d + 1] = pl; }
            *(LAS u32x4*)(H2Q + i * 1024 + 16 * lane) = qw;
            hs = wave_sum_iu(hs);
            if (lane == 0) { TOKC[i * 8 + 0] = am * (1.f / 119.f) * rs; TOKC[i * 8 + 1] = (float)hs; }
            DOT[i * 128 + lane] = 0; DOT[i * 128 + 64 + lane] = 0;
        }
        u32x4 r[16];
        {
            const int nit = 4 * ntok;
            int e0 = 0, e1 = 0, en0 = 0, en1 = 0;
            if (ntok > 0) { e0 = eidx[(size_t)t0 * 128 + lane]; e1 = eidx[(size_t)t0 * 128 + 64 + lane]; }
            if (nit > 1) { const int tn = t0 + (1 % ntok) * tstride; en0 = eidx[(size_t)tn * 128 + lane]; en1 = eidx[(size_t)tn * 128 + 64 + lane]; }
            if (nit > 0) {
#pragma unroll
                for (int s_ = 0; s_ < 16; ++s_) { const unsigned e = (unsigned)__builtin_amdgcn_ds_bpermute(g84 + 32 * (s_ & 7), s_ < 8 ? e0 : e1); r[s_] = *(const u32x4*)(EU4 + (e * 512u + pc16)); }
            }
#pragma unroll 1
            for (int n = 0; n < nit; ++n) {
                const int c = n / ntok, i = n - c * ntok;
                const int n1 = n + 1; const bool more = n1 < nit; const int c1 = more ? n1 / ntok : 0;
                int ef0 = 0, ef1 = 0;
                { const int n2 = n + 2; const int i2 = n2 % ntok; const int tn = t0 + i2 * tstride; ef0 = eidx[(size_t)tn * 128 + lane]; ef1 = eidx[(size_t)tn * 128 + 64 + lane]; }
                int hq[8];
                { const LAS i32x4* hp = (const LAS i32x4*)(H2Q + i * 1024 + 256 * c + 32 * pc); const i32x4 a = hp[0], b = hp[1];
                  hq[0] = a[0]; hq[1] = a[1]; hq[2] = a[2]; hq[3] = a[3]; hq[4] = b[0]; hq[5] = b[1]; hq[6] = b[2]; hq[7] = b[3]; }
                const unsigned noff = (unsigned)c1 * 128u + pc16;
                unsigned enx = (unsigned)__builtin_amdgcn_ds_bpermute(g84, en0);
#pragma unroll
                for (int s_ = 0; s_ < 16; ++s_) {
                    const unsigned ecur = enx;
                    if (s_ + 1 < 16) enx = (unsigned)__builtin_amdgcn_ds_bpermute(g84 + 32 * ((s_ + 1) & 7), (s_ + 1) < 8 ? en0 : en1);
                    int ah = 0, al = 0;
#pragma unroll
                    for (int q = 0; q < 4; ++q) { const int w = (int)r[s_][q]; ah = __builtin_amdgcn_sdot8(w, hq[2 * q], ah, false); al = __builtin_amdgcn_sdot8(w, hq[2 * q + 1], al, false); }
                    UIMG[s_ * GQ_UROW + lane] = 16 * ah + al;
                    r[s_] = *(const u32x4*)(EU4 + (ecur * 512u + noff));
                    __builtin_amdgcn_sched_barrier(0);
                }
                { const LAS int* rp = UIMG + (lane >> 3) * GQ_UROW + 8 * (lane & 7);
                  const i32x4 a0 = *(const LAS i32x4*)(rp), a1 = *(const LAS i32x4*)(rp + 4), b0 = *(const LAS i32x4*)(rp + 8 * GQ_UROW), b1 = *(const LAS i32x4*)(rp + 8 * GQ_UROW + 4);
                  DOT[i * 128 + lane] += ((a0[0] + a0[1]) + (a0[2] + a0[3])) + ((a1[0] + a1[1]) + (a1[2] + a1[3]));
                  DOT[i * 128 + 64 + lane] += ((b0[0] + b0[1]) + (b0[2] + b0[3])) + ((b1[0] + b1[1]) + (b1[2] + b1[3])); }
                en0 = ef0; en1 = ef1;
            }
        }
#pragma unroll 1
        for (int i = 0; i < ntok; ++i) {
            const int t = t0 + i * tstride;
            const int e0 = eidx[(size_t)t * 128 + lane], e1 = eidx[(size_t)t * 128 + 64 + lane];
            const float g0 = gate[(size_t)t * 128 + lane], g1 = gate[(size_t)t * 128 + 64 + lane];
            const float su0 = SU[e0], su1 = SU[e1], sv0 = SV[e0], sv1 = SV[e1];
            const float sh = TOKC[i * 8 + 0], hoff = 0.5f * TOKC[i * 8 + 1];
            const float p0 = ((float)DOT[i * 128 + lane] + hoff) * su0 * sh, p1 = ((float)DOT[i * 128 + 64 + lane] + hoff) * su1 * sh;
            const float c0 = g0 * 0.5f * p0 * (1.f + erff(p0 * 0.70710678118654752f)) * sv0, c1 = g1 * 0.5f * p1 * (1.f + erff(p1 * 0.70710678118654752f)) * sv1;
            const float cmax = wave_max_u(fmaxf(fabsf(c0), fabsf(c1)));
            const float cinv = cmax > 0.f ? 127.f / cmax : 0.f;
            const int cq0 = __float2int_rn(c0 * cinv), cq1 = __float2int_rn(c1 * cinv);
            const int csq = wave_sum_iu(cq0 + cq1);
            unsigned pk = 0;
            { const int G = (lane >> 3) & 3, gl = lane & 7;
#pragma unroll
              for (int m = 0; m < 4; ++m) { const int slot = 32 * G + gl + 8 * m; const int a = __builtin_amdgcn_ds_bpermute(4 * (slot & 63), cq0), b = __builtin_amdgcn_ds_bpermute(4 * (slot & 63), cq1);
                  pk |= ((unsigned)(G < 2 ? a : b) & 0xffu) << (8 * m); } }
            if (lane < 32) PKL[i * 32 + lane] = pk;
            if (lane == 0) { TOKC[i * 8 + 2] = cmax * (1.f / 127.f); TOKC[i * 8 + 3] = (float)csq; }
        }
        {
            const int nit = 4 * ntok;
            int e0 = 0, e1 = 0, en0 = 0, en1 = 0;
            if (ntok > 0) { e0 = eidx[(size_t)t0 * 128 + lane]; e1 = eidx[(size_t)t0 * 128 + 64 + lane]; }
            if (nit > 1) { const int tn = t0 + (1 % ntok) * tstride; en0 = eidx[(size_t)tn * 128 + lane]; en1 = eidx[(size_t)tn * 128 + 64 + lane]; }
            if (nit > 0) {
#pragma unroll
                for (int s_ = 0; s_ < 16; ++s_) { const unsigned e = (unsigned)__builtin_amdgcn_ds_bpermute(g84 + 32 * (s_ & 7), s_ < 8 ? e0 : e1); r[s_] = *(const u32x4*)(EV4 + (e * 512u + pc16)); }
            }
#pragma unroll 1
            for (int n = 0; n < nit; ++n) {
                const int c = n / ntok, i = n - c * ntok;
                const int n1 = n + 1; const bool more = n1 < nit; const int c1 = more ? n1 / ntok : 0;
                const int t = t0 + i * tstride;
                int ef0 = 0, ef1 = 0;
                { const int n2 = n + 2; const int i2 = n2 % ntok; const int tn = t0 + i2 * tstride; ef0 = eidx[(size_t)tn * 128 + lane]; ef1 = eidx[(size_t)tn * 128 + 64 + lane]; }
                const u32x2 xrw = *(const u32x2*)(ap + (size_t)t * D + 256 * c + 4 * lane); const f32x4 xres = {bf_lo(xrw.x), bf_hi(xrw.x), bf_lo(xrw.y), bf_hi(xrw.y)};
                const unsigned noff = (unsigned)c1 * 128u + pc16;
                int acc[32];
#pragma unroll
                for (int k = 0; k < 32; ++k) acc[k] = 0;
#pragma unroll
                for (int G = 0; G < 4; ++G) {
                    const int cp = (int)PKL[i * 32 + 8 * G + g8];
                    unsigned en[4];
#pragma unroll
                    for (int m = 0; m < 4; ++m) { const int s_ = 4 * G + m; en[m] = (unsigned)__builtin_amdgcn_ds_bpermute(g84 + 32 * (s_ & 7), s_ < 8 ? en0 : en1); }
#pragma unroll
                    for (int q = 0; q < 4; ++q) {
                        const unsigned x0 = r[4 * G][q], x1_ = r[4 * G + 1][q], x2 = r[4 * G + 2][q], x3 = r[4 * G + 3][q];
                        const unsigned t0_ = __builtin_amdgcn_perm(x1_, x0, 0x05010400u), t1_ = __builtin_amdgcn_perm(x1_, x0, 0x07030602u);
                        const unsigned t2_ = __builtin_amdgcn_perm(x3, x2, 0x05010400u), t3_ = __builtin_amdgcn_perm(x3, x2, 0x07030602u);
                        unsigned y[4];
                        y[0] = __builtin_amdgcn_perm(t2_, t0_, 0x05040100u); y[1] = __builtin_amdgcn_perm(t2_, t0_, 0x07060302u);
                        y[2] = __builtin_amdgcn_perm(t3_, t1_, 0x05040100u); y[3] = __builtin_amdgcn_perm(t3_, t1_, 0x07060302u);
#pragma unroll
                        for (int cI = 0; cI < 4; ++cI) {
                            acc[8 * q + cI] = __builtin_amdgcn_sdot4((int)(y[cI] & 0x0f0f0f0fu), cp, acc[8 * q + cI], false);
                            acc[8 * q + 4 + cI] = __builtin_amdgcn_sdot4((int)((y[cI] >> 4) & 0x0f0f0f0fu), cp, acc[8 * q + 4 + cI], false);
                        }
                    }
#pragma unroll
                    for (int m = 0; m < 4; ++m) r[4 * G + m] = *(const u32x4*)(EV4 + (en[m] * 512u + noff));
                    __builtin_amdgcn_sched_barrier(0);
                }
#pragma unroll
                for (int k = 0; k < 8; ++k) *(LAS i32x4*)(VIMG + lane * GQ_VROW + 4 * k) = (i32x4){acc[4 * k], acc[4 * k + 1], acc[4 * k + 2], acc[4 * k + 3]};
                i32x4 sm = {0, 0, 0, 0};
#pragma unroll
                for (int gl = 0; gl < 8; ++gl) sm += *(const LAS i32x4*)(VIMG + (8 * gl + (lane >> 3)) * GQ_VROW + 4 * (lane & 7));
                const float csc = TOKC[i * 8 + 2], off = -7.5f * csc * TOKC[i * 8 + 3];
                f32x4 o; o[0] = xres[0] + (float)sm[0] * csc + off; o[1] = xres[1] + (float)sm[1] * csc + off; o[2] = xres[2] + (float)sm[2] * csc + off; o[3] = xres[3] + (float)sm[3] * csc + off;
                *(f32x4*)(out + (size_t)t * D + 256 * c + 4 * lane) = o;
                en0 = ef0; en1 = ef1;
            }
        }
    }
}
#define CE(a, b) do { const float _h = __builtin_fmaxf(a, b), _l = __builtin_fminf(a, b); a = _h; b = _l; } while (0)
#define SORT16(K, B) do { \
    CE(K[(B)+0], K[(B)+1]); CE(K[(B)+2], K[(B)+3]); CE(K[(B)+0], K[(B)+2]); CE(K[(B)+1], K[(B)+3]); \
    CE(K[(B)+1], K[(B)+2]); CE(K[(B)+4], K[(B)+5]); CE(K[(B)+6], K[(B)+7]); CE(K[(B)+4], K[(B)+6]); \
    CE(K[(B)+5], K[(B)+7]); CE(K[(B)+5], K[(B)+6]); CE(K[(B)+0], K[(B)+4]); CE(K[(B)+2], K[(B)+6]); \
    CE(K[(B)+2], K[(B)+4]); CE(K[(B)+1], K[(B)+5]); CE(K[(B)+3], K[(B)+7]); CE(K[(B)+3], K[(B)+5]); \
    CE(K[(B)+1], K[(B)+2]); CE(K[(B)+3], K[(B)+4]); CE(K[(B)+5], K[(B)+6]); CE(K[(B)+8], K[(B)+9]); \
    CE(K[(B)+10], K[(B)+11]); CE(K[(B)+8], K[(B)+10]); CE(K[(B)+9], K[(B)+11]); CE(K[(B)+9], K[(B)+10]); \
    CE(K[(B)+12], K[(B)+13]); CE(K[(B)+14], K[(B)+15]); CE(K[(B)+12], K[(B)+14]); CE(K[(B)+13], K[(B)+15]); \
    CE(K[(B)+13], K[(B)+14]); CE(K[(B)+8], K[(B)+12]); CE(K[(B)+10], K[(B)+14]); CE(K[(B)+10], K[(B)+12]); \
    CE(K[(B)+9], K[(B)+13]); CE(K[(B)+11], K[(B)+15]); CE(K[(B)+11], K[(B)+13]); CE(K[(B)+9], K[(B)+10]); \
    CE(K[(B)+11], K[(B)+12]); CE(K[(B)+13], K[(B)+14]); CE(K[(B)+0], K[(B)+8]); CE(K[(B)+4], K[(B)+12]); \
    CE(K[(B)+4], K[(B)+8]); CE(K[(B)+2], K[(B)+10]); CE(K[(B)+6], K[(B)+14]); CE(K[(B)+6], K[(B)+10]); \
    CE(K[(B)+2], K[(B)+4]); CE(K[(B)+6], K[(B)+8]); CE(K[(B)+10], K[(B)+12]); CE(K[(B)+1], K[(B)+9]); \
    CE(K[(B)+5], K[(B)+13]); CE(K[(B)+5], K[(B)+9]); CE(K[(B)+3], K[(B)+11]); CE(K[(B)+7], K[(B)+15]); \
    CE(K[(B)+7], K[(B)+11]); CE(K[(B)+3], K[(B)+5]); CE(K[(B)+7], K[(B)+9]); CE(K[(B)+11], K[(B)+13]); \
    CE(K[(B)+1], K[(B)+2]); CE(K[(B)+3], K[(B)+4]); CE(K[(B)+5], K[(B)+6]); CE(K[(B)+7], K[(B)+8]); \
    CE(K[(B)+9], K[(B)+10]); CE(K[(B)+11], K[(B)+12]); CE(K[(B)+13], K[(B)+14]); \
} while (0)
#define BMERGE16(K, B) do { \
    CE(K[(B)+0], K[(B)+8]); CE(K[(B)+1], K[(B)+9]); CE(K[(B)+2], K[(B)+10]); CE(K[(B)+3], K[(B)+11]); \
    CE(K[(B)+4], K[(B)+12]); CE(K[(B)+5], K[(B)+13]); CE(K[(B)+6], K[(B)+14]); CE(K[(B)+7], K[(B)+15]); \
    CE(K[(B)+0], K[(B)+4]); CE(K[(B)+1], K[(B)+5]); CE(K[(B)+2], K[(B)+6]); CE(K[(B)+3], K[(B)+7]); \
    CE(K[(B)+8], K[(B)+12]); CE(K[(B)+9], K[(B)+13]); CE(K[(B)+10], K[(B)+14]); CE(K[(B)+11], K[(B)+15]); \
    CE(K[(B)+0], K[(B)+2]); CE(K[(B)+1], K[(B)+3]); CE(K[(B)+4], K[(B)+6]); CE(K[(B)+5], K[(B)+7]); \
    CE(K[(B)+8], K[(B)+10]); CE(K[(B)+9], K[(B)+11]); CE(K[(B)+12], K[(B)+14]); CE(K[(B)+13], K[(B)+15]); \
    CE(K[(B)+0], K[(B)+1]); CE(K[(B)+2], K[(B)+3]); CE(K[(B)+4], K[(B)+5]); CE(K[(B)+6], K[(B)+7]); \
    CE(K[(B)+8], K[(B)+9]); CE(K[(B)+10], K[(B)+11]); CE(K[(B)+12], K[(B)+13]); CE(K[(B)+14], K[(B)+15]); \
} while (0)
typedef short bf16x8s __attribute__((ext_vector_type(8)));
typedef float f32x16 __attribute__((ext_vector_type(16)));
constexpr int TK_LUT_OFF = 0, TK_LDS_END = TK_LUT_OFF + 8 * 8192;
__device__ __forceinline__ void top16_of_64(float (&k)[64]) {
    SORT16(k, 0); SORT16(k, 16); SORT16(k, 32); SORT16(k, 48);
#pragma unroll
    for (int i = 0; i < 16; ++i) { k[i] = __builtin_fmaxf(k[i], k[31 - i]); k[32 + i] = __builtin_fmaxf(k[32 + i], k[63 - i]); }
    BMERGE16(k, 0); BMERGE16(k, 32);
#pragma unroll
    for (int i = 0; i < 16; ++i) k[i] = __builtin_fmaxf(k[i], k[47 - i]);
    BMERGE16(k, 0);
}
__device__ __forceinline__ float ctag(float s, unsigned code) { return __uint_as_float((__float_as_uint(s) & 0xffffff00u) | code); }
__device__ __forceinline__ void topk_load(u32x4 (&w)[8], const bf16_t* __restrict__ srow  ) {
#pragma unroll
    for (int i = 0; i < 8; ++i) w[i] = ((const u32x4*)srow)[i];
}
__device__ __forceinline__ void topk_half(float (&v)[16], u32x4 (&w)[8], const bf16_t* __restrict__ nxt, unsigned hx  ) {
    float k[64];
#pragma unroll
    for (int i = 0; i < 8; ++i)
#pragma unroll
        for (int q = 0; q < 4; ++q) { const unsigned x = w[i][q]; k[8 * i + 2 * q] = __uint_as_float((x << 16) | (unsigned)(8 * i + 2 * q)); k[8 * i + 2 * q + 1] = __uint_as_float((x & 0xffff0000u) | (unsigned)(8 * i + 2 * q + 1)); }
    if (nxt) topk_load(w, nxt);
    top16_of_64(k);
    float r0[16], r1[16];
#pragma unroll
    for (int i = 0; i < 16; ++i) { const unsigned ki = __float_as_uint(k[i]) | hx; const auto rr = __builtin_amdgcn_permlane32_swap(ki, ki, false, false); r0[i] = __uint_as_float(rr[0]); r1[i] = __uint_as_float(rr[1]); }
#pragma unroll
    for (int i = 0; i < 16; ++i) v[i] = __builtin_fmaxf(r0[i], r1[15 - i]);
    BMERGE16(v, 0);
}
__device__ __forceinline__ void topk_task(int tg, int hp, const bf16_t* __restrict__ qv  , LAS unsigned* lut, int* __restrict__ eidx, float* __restrict__ gate, int lane) {
    const int tl = lane & 31, hh = lane >> 5, t = tg * 32 + tl;
    const unsigned hx = (unsigned)hh << 6;
    float v1[16], v2[16];
    {
        const bf16_t* qrow = qv + (size_t)t * NQ + (2 * hp) * 256 + 64 * hh;
        float a[16], b_[16];
        u32x4 wa[8], wb[8];
        topk_load(wa, qrow); topk_load(wb, qrow + 256);
        topk_half(a, wa, qrow + 128, hx);
        __builtin_amdgcn_sched_barrier(0);
        topk_half(b_, wb, qrow + 384, hx);
#pragma unroll
        for (int i = 0; i < 16; ++i) v1[i] = hh ? b_[i] : a[i];
        __builtin_amdgcn_sched_barrier(0);
        topk_half(a, wa, nullptr, hx);
        __builtin_amdgcn_sched_barrier(0);
        topk_half(b_, wb, nullptr, hx);
#pragma unroll
        for (int i = 0; i < 16; ++i) v2[i] = hh ? b_[i] : a[i];
        __builtin_amdgcn_sched_barrier(0);
    }
    const int h = 2 * hp + hh;
    float f1[16], f2[16];
#pragma unroll
    for (int i = 0; i < 16; ++i) {
        const unsigned b1 = __float_as_uint(v1[i]), b2 = __float_as_uint(v2[i]);
        f1[i] = __uint_as_float(b1 & 0xffffff80u); f2[i] = __uint_as_float(b2 & 0xffffff80u);
        lut[i * 64 + lane] = (b1 & 127u) << 7; lut[(16 + i) * 64 + lane] = b2 & 127u;
    }
    float cand[64];
    cand[0] = ctag(f1[0] + f2[0], 255u);
    cand[1] = ctag(f1[0] + f2[1], 254u);
    cand[2] = ctag(f1[0] + f2[2], 253u);
    cand[3] = ctag(f1[0] + f2[3], 252u);
    cand[4] = ctag(f1[0] + f2[4], 251u);
    cand[5] = ctag(f1[0] + f2[5], 250u);
    cand[6] = ctag(f1[0] + f2[6], 249u);
    cand[7] = ctag(f1[0] + f2[7], 248u);
    cand[8] = ctag(f1[0] + f2[8], 247u);
    cand[9] = ctag(f1[0] + f2[9], 246u);
    cand[10] = ctag(f1[0] + f2[10], 245u);
    cand[11] = ctag(f1[0] + f2[11], 244u);
    cand[12] = ctag(f1[0] + f2[12], 243u);
    cand[13] = ctag(f1[0] + f2[13], 242u);
    cand[14] = ctag(f1[0] + f2[14], 241u);
    cand[15] = ctag(f1[0] + f2[15], 240u);
    cand[16] = ctag(f1[1] + f2[0], 239u);
    cand[17] = ctag(f1[1] + f2[1], 238u);
    cand[18] = ctag(f1[1] + f2[2], 237u);
    cand[19] = ctag(f1[1] + f2[3], 236u);
    cand[20] = ctag(f1[1] + f2[4], 235u);
    cand[21] = ctag(f1[1] + f2[5], 234u);
    cand[22] = ctag(f1[1] + f2[6], 233u);
    cand[23] = ctag(f1[1] + f2[7], 232u);
    cand[24] = ctag(f1[2] + f2[0], 223u);
    cand[25] = ctag(f1[2] + f2[1], 222u);
    cand[26] = ctag(f1[2] + f2[2], 221u);
    cand[27] = ctag(f1[2] + f2[3], 220u);
    cand[28] = ctag(f1[2] + f2[4], 219u);
    cand[29] = ctag(f1[3] + f2[0], 207u);
    cand[30] = ctag(f1[3] + f2[1], 206u);
    cand[31] = ctag(f1[3] + f2[2], 205u);
    cand[32] = ctag(f1[3] + f2[3], 204u);
    cand[33] = ctag(f1[4] + f2[0], 191u);
    cand[34] = ctag(f1[4] + f2[1], 190u);
    cand[35] = ctag(f1[4] + f2[2], 189u);
    cand[36] = ctag(f1[5] + f2[0], 175u);
    cand[37] = ctag(f1[5] + f2[1], 174u);
    cand[38] = ctag(f1[6] + f2[0], 159u);
    cand[39] = ctag(f1[6] + f2[1], 158u);
    cand[40] = ctag(f1[7] + f2[0], 143u);
    cand[41] = ctag(f1[7] + f2[1], 142u);
    cand[42] = ctag(f1[8] + f2[0], 127u);
    cand[43] = ctag(f1[9] + f2[0], 111u);
    cand[44] = ctag(f1[10] + f2[0], 95u);
    cand[45] = ctag(f1[11] + f2[0], 79u);
    cand[46] = ctag(f1[12] + f2[0], 63u);
    cand[47] = ctag(f1[13] + f2[0], 47u);
    cand[48] = ctag(f1[14] + f2[0], 31u);
    cand[49] = ctag(f1[15] + f2[0], 15u);
#pragma unroll
    for (int c = 50; c < 64; ++c) cand[c] = -INFINITY;
    top16_of_64(cand);
    float sc[16]; unsigned ex[16];
#pragma unroll
    for (int w = 0; w < 16; ++w) {
        const unsigned b = __float_as_uint(cand[w]), code = 255u - (b & 255u);
        sc[w] = __uint_as_float(b & 0xffffff00u);
        ex[w] = lut[(code >> 4) * 64 + lane] + lut[(16 + (code & 15u)) * 64 + lane];
    }
    float sum = 0.f; const float mx = sc[0];
#pragma unroll
    for (int w = 0; w < 16; ++w) { sc[w] = __expf(sc[w] - mx); sum += sc[w]; }
    const size_t o = ((size_t)t * 8 + h) * 16;
    const float inv = 1.f / sum;
#pragma unroll
    for (int i = 0; i < 4; ++i) { u32x4 w4 = {ex[4 * i], ex[4 * i + 1], ex[4 * i + 2], ex[4 * i + 3]}; *(u32x4*)(eidx + o + 4 * i) = w4; }
#pragma unroll
    for (int i = 0; i < 4; ++i) { f32x4 g4 = {sc[4 * i] * inv, sc[4 * i + 1] * inv, sc[4 * i + 2] * inv, sc[4 * i + 3] * inv}; *(f32x4*)(gate + o + 4 * i) = g4; }
}

typedef short v4i16_t __attribute__((ext_vector_type(4)));
constexpr int AT_K = 0, AT_V = 16384, AT_FK = 32768, AT_BIAS = AT_FK + 2 * 2048, AT_END = AT_BIAS + 4096,
              AT_FL = 73728, AT_DONE = AT_FL + 16, AT_QW = AT_FL + 48;
constexpr float AT_SKIP = 24.f;
__device__ __forceinline__ int crow(int r, int hh) { return (r & 3) + 8 * (r >> 2) + 4 * hh; }

__device__ __forceinline__ float at_max3(float a, float b, float c) { float r; asm("v_max3_f32 %0, %1, %2, %3" : "=v"(r) : "v"(a), "v"(b), "v"(c)); return r; }
__device__ __forceinline__ unsigned at_bf16(float x) { return cvt_pk_bf16(x, 0.f) & 0xffffu; }
__device__ __forceinline__ unsigned at_split3(float x, unsigned& d0) { const unsigned t1 = at_bf16(x); const float r1 = x - __uint_as_float(t1 << 16); const unsigned t2 = at_bf16(r1); const float r2 = r1 - __uint_as_float(t2 << 16); d0 = t1 | (t2 << 16); return at_bf16(r2); }
__device__ __forceinline__ bf16x8s at_mfrag(float m, int hh) { unsigned d0; const unsigned t3 = at_split3(-m, d0); u32x4 w = {0x3f803f80u, 0x3f80u | (d0 << 16), (d0 >> 16) | (t3 << 16), 0u}; if (hh) w = (u32x4){0u, 0u, 0u, 0u}; return __builtin_bit_cast(bf16x8s, w); }
constexpr float AT_THR = 6.f;
template <int MODE  >
__device__ __forceinline__ void attn_step(f32x16 (&o)[2], float& mhat, float& l, const bf16x8s (&qf)[4], const LAS unsigned char* Kt, const LAS unsigned char* Vt, const LAS unsigned char* AKt, bf16x8s& mfr,
                                          const LAS float* biasrow, int qg, int kv0, int lane) {
    const int tl = lane & 31, hh = lane >> 5;
    const LAS unsigned char* kb = Kt + tl * 128; const int ksw = (tl >> 1) & 7;
    bf16x8s kf[2][4];
#pragma unroll
    for (int kvt = 0; kvt < 2; ++kvt)
#pragma unroll
        for (int ks = 0; ks < 4; ++ks) kf[kvt][ks] = *(const LAS bf16x8s*)(kb + kvt * 4096 + (((2 * ks + hh) ^ ksw) * 16));
    bf16x8s af[2];
    if (MODE < 2) {
#pragma unroll
        for (int kvt = 0; kvt < 2; ++kvt) af[kvt] = *(const LAS bf16x8s*)(AKt + (32 * kvt + tl) * 32 + hh * 16);
    } else {
        u32x4 w = {0u, 0x3f800000u, 0x3f803f80u, 0u}; if (hh) w = (u32x4){0u, 0u, 0u, 0u};
        af[0] = __builtin_bit_cast(bf16x8s, w); af[1] = af[0];
    }
    f32x16 p[2];
    const LAS unsigned char* vb = Vt + (4 * hh + ((lane & 15) >> 2)) * 64 + ((lane >> 4) & 1) * 32 + (lane & 3) * 8;
    bf16x8s vf[2][2][2];
#pragma unroll
    for (int kvt = 0; kvt < 2; ++kvt)
#pragma unroll
        for (int s = 0; s < 2; ++s)
#pragma unroll
            for (int d0 = 0; d0 < 2; ++d0) {
                const v4i16_t lo = __builtin_amdgcn_ds_read_tr16_b64_v4i16((LAS v4i16_t*)(vb + d0 * 4096 + kvt * 2048 + s * 1024));
                const v4i16_t hi = __builtin_amdgcn_ds_read_tr16_b64_v4i16((LAS v4i16_t*)(vb + d0 * 4096 + kvt * 2048 + s * 1024 + 512));
                vf[kvt][s][d0] = (bf16x8s){lo[0], lo[1], lo[2], lo[3], hi[0], hi[1], hi[2], hi[3]};
            }
    __builtin_amdgcn_sched_barrier(0);
#pragma unroll
    for (int kvt = 0; kvt < 2; ++kvt) {
        const f32x16 z = {0.f, 0.f, 0.f, 0.f, 0.f, 0.f, 0.f, 0.f, 0.f, 0.f, 0.f, 0.f, 0.f, 0.f, 0.f, 0.f};
        p[kvt] = __builtin_amdgcn_mfma_f32_32x32x16_bf16(af[kvt], mfr, z, 0, 0, 0);
#pragma unroll
        for (int ks = 0; ks < 4; ++ks) p[kvt] = __builtin_amdgcn_mfma_f32_32x32x16_bf16(kf[kvt][ks], qf[ks], p[kvt], 0, 0, 0);
    }
    if (MODE == 1) {
#pragma unroll
        for (int kvt = 0; kvt < 2; ++kvt)
#pragma unroll
            for (int r = 0; r < 16; ++r) { const int kv = kv0 + 32 * kvt + crow(r, hh); p[kvt][r] = (kv > qg) ? -INFINITY : p[kvt][r]; }
    }
    if (MODE == 2) {
        const LAS float* bp = biasrow + (191 - qg + kv0 + 4 * hh);
#pragma unroll
        for (int kvt = 0; kvt < 2; ++kvt)
#pragma unroll
            for (int r = 0; r < 16; ++r) {
                p[kvt][r] += bp[32 * kvt + crow(r, 0)];
            }
    }
    float mx = at_max3(p[0][0], p[1][0], p[0][1]), mx2 = at_max3(p[1][1], p[0][2], p[1][2]);
#pragma unroll
    for (int r = 3; r < 15; r += 2) { mx = at_max3(mx, p[0][r], p[1][r]); mx2 = at_max3(mx2, p[0][r + 1], p[1][r + 1]); }
    mx = at_max3(mx, p[0][15], p[1][15]); mx = __builtin_fmaxf(mx, mx2);
    { const auto rr = __builtin_amdgcn_permlane32_swap(__float_as_uint(mx), __float_as_uint(mx), false, false); mx = __builtin_fmaxf(__uint_as_float(rr[0]), __uint_as_float(rr[1])); }
    if (__any(mx > AT_THR)) {
        const float dl = __builtin_fmaxf(mx, 0.f), f = __builtin_amdgcn_exp2f(-dl);
        mhat += dl; l *= f; mfr = at_mfrag(mhat, hh);
#pragma unroll
        for (int kvt = 0; kvt < 2; ++kvt)
#pragma unroll
            for (int r = 0; r < 16; ++r) p[kvt][r] -= dl;
#pragma unroll
        for (int d0 = 0; d0 < 2; ++d0)
#pragma unroll
            for (int r = 0; r < 16; ++r) o[d0][r] *= f;
    }
    float sum = 0.f;
#pragma unroll
    for (int kvt = 0; kvt < 2; ++kvt)
#pragma unroll
        for (int r = 0; r < 16; ++r) { const float e = __builtin_amdgcn_exp2f(p[kvt][r]); p[kvt][r] = e; sum += e; }
    l += sum;
#pragma unroll
    for (int kvt = 0; kvt < 2; ++kvt)
#pragma unroll
        for (int s = 0; s < 2; ++s) {
            u32x4 pw;
#pragma unroll
            for (int i = 0; i < 4; ++i) pw[i] = cvt_pk_bf16(p[kvt][8 * s + 2 * i], p[kvt][8 * s + 2 * i + 1]);
            const bf16x8s pf = __builtin_bit_cast(bf16x8s, pw);
#pragma unroll
            for (int d0 = 0; d0 < 2; ++d0) o[d0] = __builtin_amdgcn_mfma_f32_32x32x16_bf16(vf[kvt][s][d0], pf, o[d0], 0, 0, 0);
        }
}

template <bool FOX>
__device__ __forceinline__ void attn_unit(LAS unsigned char* ldsl, int b, int hk, int qblk, const bf16_t* __restrict__ Q, const bf16_t* __restrict__ K, const bf16_t* __restrict__ V, int kvpitch,
                                          const float* __restrict__ F2, const float* __restrict__ sinks, bf16_t* __restrict__ MIX, int wave, int lane, unsigned serial, float sbound) {
    const int tid = threadIdx.x, tl = lane & 31, hh = lane >> 5;
    const size_t rowbase = (size_t)b * SEQ;
    int head, qw0, t_begin, t_end, wl;
    if (FOX) { head = hk; qw0 = qblk * 256 + 32 * wave; t_begin = 0; t_end = 4 * qblk + 4; wl = 4 * qblk + (wave >> 1); }
    else { head = hk * 4 + (wave >> 1); qw0 = qblk * 64 + 32 * (wave & 1); t_begin = qblk >= 2 ? qblk - 2 : 0; t_end = qblk + 1; wl = t_end; }
    const int qg = qw0 + tl;
    bf16x8s qf[4];
    { const bf16_t* qp = Q + (rowbase + qg) * 512 + head * 64 + 8 * hh;
#pragma unroll
      for (int ks = 0; ks < 4; ++ks) qf[ks] = *(const bf16x8s*)(qp + 16 * ks); }
    const float* Fr = F2 + ((size_t)b * 8 + head) * SEQ;
    float m, l;
    if (FOX) { m = 0.f; l = 0.f; } else { m = sinks[head] * LOG2E; l = hh == 0 ? 1.f : 0.f; }
    bf16x8s mfr = at_mfrag(m, hh);
    f32x16 o[2];
#pragma unroll
    for (int d0 = 0; d0 < 2; ++d0)
#pragma unroll
        for (int r = 0; r < 16; ++r) o[d0][r] = 0.f;
    const int skv = tid >> 3, sc = tid & 7;
    const bf16_t* kg = K + (rowbase + skv) * kvpitch + hk * 64 + sc * 8;
    const bf16_t* vg = V + (rowbase + skv) * kvpitch + hk * 64 + sc * 8;
    const int kwoff = skv * 128 + ((sc ^ ((skv >> 1) & 7)) * 16), vwoff = (sc >> 2) * 4096 + skv * 64 + (sc & 3) * 16;
    u32x4 kA, vA, kB, vB; float fA = 0.f, fB = 0.f;
#define AT_LOAD(t, KR, VR, FR) do { const int tt_ = (t) > t_begin ? (t) : t_begin; KR = *(const u32x4*)(kg + (size_t)tt_ * 64 * kvpitch); VR = *(const u32x4*)(vg + (size_t)tt_ * 64 * kvpitch); if (FOX) FR = Fr[tt_ * 64 + lane]; } while (0)
#define AT_WRITE(buf, KR, VR, FR) do { *(LAS u32x4*)(ldsl + AT_K + (buf) * 8192 + kwoff) = KR; *(LAS u32x4*)(ldsl + AT_V + (buf) * 8192 + vwoff) = VR; if (FOX && tid < 64) { unsigned d0_; const unsigned t3_ = at_split3(-FR, d0_); LAS u32x4* ak_ = (LAS u32x4*)(ldsl + AT_FK + (buf) * 2048 + tid * 32); ak_[0] = (u32x4){d0_, t3_ | 0x3f800000u, 0x3f803f80u, 0u}; ak_[1] = (u32x4){0u, 0u, 0u, 0u}; if (tid == 63) *(LAS float*)(ldsl + AT_FL + (buf) * 4) = -FR; } } while (0)
    AT_LOAD(t_end - 1, kA, vA, fA); AT_LOAD(t_end - 2, kB, vB, fB);
    AT_WRITE(0, kA, vA, fA);
    __syncthreads();
    const LAS float* biasrow = (const LAS float*)(ldsl + AT_BIAS) + head * 128;
#define AT_STEP(KL, VL, FL, KW, VW, FW) do { \
        const int cur = (t_end - 1 - t) & 1; \
        AT_LOAD(t - 2, KL, VL, FL); \
        const LAS unsigned char* Kt = ldsl + AT_K + cur * 8192; const LAS unsigned char* Vt = ldsl + AT_V + cur * 8192; const LAS unsigned char* Fk = ldsl + AT_FK + cur * 2048; \
        if (FOX) { \
            if (!wdone && t < wl) {     \
                const float fl_ = *(const LAS float*)(ldsl + AT_FL + cur * 4); \
                if (sbound + fl_ + wave_max_u(-m) < -AT_SKIP) { wdone = true; if (lane == 0) *(LAS unsigned*)(ldsl + AT_DONE + wave * 4) = serial; } \
            } \
            if (!wdone) { \
                if (t < wl) attn_step<0>(o, m, l, qf, Kt, Vt, Fk, mfr, biasrow, qg, t * 64, lane); \
                else if (t == wl) attn_step<1>(o, m, l, qf, Kt, Vt, Fk, mfr, biasrow, qg, t * 64, lane); \
            } \
        } else attn_step<2>(o, m, l, qf, Kt, Vt, Fk, mfr, biasrow, qg, t * 64, lane); \
        if (t > t_begin) AT_WRITE(cur ^ 1, KW, VW, FW); \
        __syncthreads(); \
        if (FOX) { const bool d_ = lane < 8 ? (*(const LAS unsigned*)(ldsl + AT_DONE + lane * 4) == serial) : true; bdone = __all(d_); }     \
    } while (0)
    bool wdone = false, bdone = false;
    for (int t = t_end - 1;;) {
        AT_STEP(kA, vA, fA, kB, vB, fB); if (bdone || --t < t_begin) break;
        AT_STEP(kB, vB, fB, kA, vA, fA); if (bdone || --t < t_begin) break;
    }
#undef AT_STEP
#undef AT_LOAD
#undef AT_WRITE
    { const auto rr = __builtin_amdgcn_permlane32_swap(__float_as_uint(l), __float_as_uint(l), false, false); l = __uint_as_float(rr[0]) + __uint_as_float(rr[1]); }
    const float inv = 1.f / l;
    bf16_t* op = MIX + (rowbase + qg) * D + (FOX ? 512 : 0) + head * 64 + 4 * hh;
#pragma unroll
    for (int d0 = 0; d0 < 2; ++d0)
#pragma unroll
        for (int j = 0; j < 4; ++j) {
            u32x2 w; w.x = cvt_pk_bf16(o[d0][4 * j] * inv, o[d0][4 * j + 1] * inv); w.y = cvt_pk_bf16(o[d0][4 * j + 2] * inv, o[d0][4 * j + 3] * inv);
            *(u32x2*)(op + 32 * d0 + 8 * j) = w;
        }
}

constexpr int AT_SWA_V = 0, AT_SWA_K = 32768, AT_SWA_BIAS = 65536;
__device__ __forceinline__ void attn_swa_unit(LAS unsigned char* ldsl, int b, int kvh, int qb, const bf16_t* __restrict__ Q, const bf16_t* __restrict__ K, const bf16_t* __restrict__ V,
                                              const float* __restrict__ sinks, bf16_t* __restrict__ MIX, int wave, int lane) {
    const int tid = threadIdx.x, tl = lane & 31, hh = lane >> 5;
    const size_t rowbase = (size_t)b * SEQ;
    const int q0 = qb * 128, tbase = 2 * qb - 2;
    const int head = kvh * 4 + (wave >> 1);
    const int skv = tid >> 3, sc = tid & 7;
    const int kwoff = skv * 128 + ((sc ^ ((skv >> 1) & 7)) * 16), vwoff = (sc >> 2) * 4096 + skv * 64 + (sc & 3) * 16;
    u32x4 kr[4], vr[4];
#pragma unroll
    for (int sl = 0; sl < 4; ++sl) { const int tt = tbase + sl < 0 ? 0 : tbase + sl; const size_t off = (rowbase + (size_t)tt * 64 + skv) * 128 + kvh * 64 + sc * 8; kr[sl] = *(const u32x4*)(K + off); vr[sl] = *(const u32x4*)(V + off); }
#pragma unroll
    for (int sl = 0; sl < 4; ++sl) { *(LAS u32x4*)(ldsl + AT_SWA_K + sl * 8192 + kwoff) = kr[sl]; *(LAS u32x4*)(ldsl + AT_SWA_V + sl * 8192 + vwoff) = vr[sl]; }
    __syncthreads();
    const LAS float* biasrow = (const LAS float*)(ldsl + AT_SWA_BIAS) + head * 256;
    const float sink2 = sinks[head] * LOG2E;
#pragma unroll 1
    for (int ps = 0; ps < 2; ++ps) {
        const int qg = q0 + 64 * ps + 32 * (wave & 1) + tl;
        bf16x8s qf[4];
        { const bf16_t* qp = Q + (rowbase + qg) * 512 + head * 64 + 8 * hh;
#pragma unroll
          for (int ks = 0; ks < 4; ++ks) qf[ks] = *(const bf16x8s*)(qp + 16 * ks); }
        float m = sink2, l = hh == 0 ? 1.f : 0.f;
        bf16x8s mfr = at_mfrag(m, hh);
        f32x16 o[2];
#pragma unroll
        for (int d0 = 0; d0 < 2; ++d0)
#pragma unroll
            for (int r = 0; r < 16; ++r) o[d0][r] = 0.f;
#pragma unroll 1
        for (int j = 2; j >= 0; --j) {
            const int sl = ps + j, t = tbase + sl;
            if (t >= 0) attn_step<2>(o, m, l, qf, ldsl + AT_SWA_K + sl * 8192, ldsl + AT_SWA_V + sl * 8192, ldsl, mfr, biasrow, qg, t * 64, lane);
        }
        { const auto rr = __builtin_amdgcn_permlane32_swap(__float_as_uint(l), __float_as_uint(l), false, false); l = __uint_as_float(rr[0]) + __uint_as_float(rr[1]); }
        const float inv = 1.f / l;
        bf16_t* op = MIX + (rowbase + qg) * D + head * 64 + 4 * hh;
#pragma unroll
        for (int d0 = 0; d0 < 2; ++d0)
#pragma unroll
            for (int jj = 0; jj < 4; ++jj) {
                u32x2 w; w.x = cvt_pk_bf16(o[d0][4 * jj] * inv, o[d0][4 * jj + 1] * inv); w.y = cvt_pk_bf16(o[d0][4 * jj + 2] * inv, o[d0][4 * jj + 3] * inv);
                *(u32x2*)(op + 32 * d0 + 8 * jj) = w;
            }
    }
    __syncthreads();
}

__device__ __forceinline__ void attn_phase(LAS unsigned char* ldsl, const bf16_t* QA, const bf16_t* KA, const bf16_t* VA, const bf16_t* QB, const bf16_t* KB, const bf16_t* VB,
                                           const float* __restrict__ F2, const float* __restrict__ sinks, const float* __restrict__ relb, const float* __restrict__ gqb, const float* __restrict__ gkb,
                                           bf16_t* MIX, unsigned* qctr  , int G, int wave, int lane) {
    for (int i = threadIdx.x; i < 8 * 256; i += 512) { const int h = i >> 8, dist = 191 - (i & 255); ((LAS float*)(ldsl + AT_SWA_BIAS))[i] = (unsigned)dist < 128u ? relb[(int)T5B[dist & 127] * 8 + h] * LOG2E : -INFINITY; }
    if (threadIdx.x < 8) *(LAS unsigned*)(ldsl + AT_DONE + threadIdx.x * 4) = 0u;
    const float sbound = 64.f * C2 * 1.02f * wave_max_u(fabsf(gqb[lane])) * wave_max_u(fabsf(gkb[lane]));
    __syncthreads();
    unsigned serial = 0;
    for (;;) {
        if (threadIdx.x == 0) *(LAS unsigned*)(ldsl + AT_QW) = __hip_atomic_fetch_add(qctr, 1u, __ATOMIC_RELAXED, __HIP_MEMORY_SCOPE_AGENT);
        __syncthreads();
        const unsigned u = *(const LAS unsigned*)(ldsl + AT_QW);
        __syncthreads();
        if (u >= 768u) break;
        if (u < 512u) { const int bh = (int)(u & 31u), qb = 15 - (int)(u >> 5); ++serial;
            attn_unit<true>(ldsl, bh >> 3, bh & 7, qb, QB, KB, VB, 512, F2, sinks, MIX, wave, lane, serial, sbound); }
        else { const int us = (int)u - 512; attn_swa_unit(ldsl, us >> 6, (us >> 5) & 1, us & 31, QA, KA, VA, sinks, MIX, wave, lane); }
    }
}
#define RLX_AGENT __ATOMIC_RELAXED, __HIP_MEMORY_SCOPE_AGENT
#define XB_TMO      128
#define XB_XCNT(j)  (256  + 64 * (j))
#define XB_XSUB(j)  (1280 + 64 * (j))
#define XB_XGEN(j)  (2304 + 64 * (j))
#define XB_TOP      3328
#define XB_TOPGEN   3392
#define XCD_BAR_WORDS 3456
#define XB_SPIN_CAP (1u << 22)

__device__ __forceinline__ unsigned xb_ld(unsigned* p)              { return __hip_atomic_load(p, __ATOMIC_RELAXED, __HIP_MEMORY_SCOPE_AGENT); }
__device__ __forceinline__ unsigned xb_add(unsigned* p, unsigned v) { return __hip_atomic_fetch_add(p, v, __ATOMIC_RELAXED, __HIP_MEMORY_SCOPE_AGENT); }
__device__ __forceinline__ unsigned xb_xcc_id() { return (unsigned)__builtin_amdgcn_s_getreg((3 << 11) | 20) & 0xFu; }
#define XB_SPIN(cond, bar) do { unsigned _sp = 0; while (cond) { __builtin_amdgcn_s_sleep(1); \
    if ((++_sp & 255u) == 0u) { if (xb_ld(&(bar)[XB_TMO])) break; if (_sp > XB_SPIN_CAP) { atomicAdd(&(bar)[XB_TMO], 1u); break; } } } } while (0)

struct XcdBarrier {
    unsigned* bar; unsigned x;
    volatile LAS unsigned* st;
};

__device__ __forceinline__ XcdBarrier xcd_barrier_post(unsigned* bar, volatile LAS unsigned* st) {
    XcdBarrier b; b.bar = bar; b.x = xb_xcc_id(); b.st = st;
    if (threadIdx.x == 0) (void)xb_add(&bar[XB_XCNT(b.x)], 1u);
    return b;
}
__device__ __forceinline__ void xcd_barrier_complete(unsigned* bar, unsigned x, unsigned& nloc, unsigned& nx) {
    const unsigned G = gridDim.x * gridDim.y * gridDim.z;
    unsigned sum, cnt, mine, sp = 0u;
    for (;;) {
        sum = 0u; cnt = 0u; mine = 0u;
#pragma unroll
        for (unsigned j = 0; j < 16; ++j) { const unsigned c = xb_ld(&bar[XB_XCNT(j)]); sum += c; cnt += (c > 0u) ? 1u : 0u; mine = (j == x) ? c : mine; }
        if (sum == G) break;
        __builtin_amdgcn_s_sleep(1);
        if ((++sp & 255u) == 0u) { if (xb_ld(&bar[XB_TMO])) break; if (sp > XB_SPIN_CAP) { atomicAdd(&bar[XB_TMO], 1u); break; } }
    }
    nloc = mine > 0u ? mine : 1u; nx = cnt > 0u ? cnt : 1u;
}

__device__ __forceinline__ void xcd_barrier(const XcdBarrier& b) {
    asm volatile("s_waitcnt vmcnt(0)" ::: "memory");
    __syncthreads();
    if (threadIdx.x == 0) {
        unsigned* bar = b.bar;
        __builtin_amdgcn_s_waitcnt(0);
        unsigned nloc = b.st[0], nx = b.st[1];
        if (nloc == 0u) { xcd_barrier_complete(bar, b.x, nloc, nx); b.st[0] = nloc; b.st[1] = nx; }
        const unsigned old = xb_add(&bar[XB_XSUB(b.x)], 1u);
        const unsigned gen = old / nloc;
        if (old + 1u == (gen + 1u) * nloc) {
            __builtin_amdgcn_fence(__ATOMIC_RELEASE, "agent");
            asm volatile("s_waitcnt vmcnt(0)" ::: "memory");
            const unsigned og = xb_add(&bar[XB_TOP], 1u);
            const unsigned tg = og / nx;
            if (og + 1u == (tg + 1u) * nx) xb_add(&bar[XB_TOPGEN], 1u);
            else XB_SPIN(xb_ld(&bar[XB_TOPGEN]) == tg, bar);
            __builtin_amdgcn_fence(__ATOMIC_ACQUIRE, "agent");
            xb_add(&bar[XB_XGEN(b.x)], 1u);
            asm volatile("s_waitcnt vmcnt(0)" ::: "memory");
        } else {
            XB_SPIN(xb_ld(&bar[XB_XGEN(b.x)]) == gen, bar);
            __builtin_amdgcn_fence(__ATOMIC_ACQUIRE, "agent");
            asm volatile("s_waitcnt vmcnt(0)" ::: "memory");
        }
    }
    __syncthreads();
}
constexpr int LDS_BYTES = 147456;
struct Params { const float* in[17]; float* out; unsigned char* ws; };

__global__ void __launch_bounds__(512, 2) mega(Params p) {
    extern __shared__ __attribute__((aligned(16))) unsigned char lds[];
    const float* x = p.in[0]; const float* relb = p.in[1]; const float* norm_mix = p.in[2]; const float* w_in = p.in[3];
    const float* gqa = p.in[4]; const float* gka = p.in[5]; const float* gqb = p.in[6]; const float* gkb = p.in[7];
    const float* bforget = p.in[8]; const float* sinks = p.in[9]; const float* w_out = p.in[10]; const float* norm_ffn = p.in[11];
    const float* w_query = p.in[12]; const float* sk1 = p.in[13]; const float* sk2 = p.in[14]; const float* eu = p.in[15]; const float* ev = p.in[16];
    float* out = p.out; unsigned char* ws = p.ws;
    bf16_t* WTIN = (bf16_t*)(ws + WS_WTIN); bf16_t* WTOUT = (bf16_t*)(ws + WS_WTOUT); bf16_t* WTQ = (bf16_t*)(ws + WS_WTQ);
    float* LOGF = (float*)(ws + WS_LOGF); float* F2 = (float*)(ws + WS_F2); float* SSQ = (float*)(ws + WS_SSQ);
    int* EIDX = (int*)(ws + WS_EIDX); float* GATE = (float*)(ws + WS_GATE);
    bf16_t* XN = (bf16_t*)(ws + WS_XN); bf16_t* AP = XN;
    bf16_t* QA = (bf16_t*)(ws + WS_QA); bf16_t* KA = (bf16_t*)(ws + WS_KA); bf16_t* VA = (bf16_t*)(ws + WS_VA);
    bf16_t* QB = (bf16_t*)(ws + WS_QB); bf16_t* KB = (bf16_t*)(ws + WS_KB); bf16_t* VB = (bf16_t*)(ws + WS_VB);
    bf16_t* MIX = (bf16_t*)(ws + WS_MIX); bf16_t* QV = (bf16_t*)(ws + WS_QV);

    unsigned char* EU8 = ws + WS_EU8; unsigned char* EV8 = ws + WS_EV8; float* SU = (float*)(ws + WS_SU); float* SV = (float*)(ws + WS_SV); float* RR = (float*)(ws + WS_RR);
    const int tid = threadIdx.x, lane = tid & 63, wave = __builtin_amdgcn_readfirstlane(tid >> 6);
    const int G = gridDim.x, gw = blockIdx.x * 8 + wave, NGW = G * 8;
    LAS unsigned char* ldsl = (LAS unsigned char*)lds;
    if (tid < 4) ((LAS unsigned*)(ldsl + LDS_BYTES - 16))[tid] = 0u;
    __syncthreads();
    const XcdBarrier xbar = xcd_barrier_post((unsigned*)(ws + WS_CTL), (volatile LAS unsigned*)(ldsl + LDS_BYTES - 16));

    {
        LAS float* scr = (LAS float*)(ldsl + wave * 16384);
        constexpr int I_IN = 16 * (NQKV / 32), I_OUT = 16 * (D / 32), I_Q = 16 * 32 * 4;
        for (int it = gw; it < I_IN + I_OUT + I_Q; it += NGW) {
            int r = it;
            if (r < I_Q) { p0_keyfold_item(w_query, sk1, sk2, norm_ffn, WTQ, r, lane); continue; } r -= I_Q;
            if (r < I_IN) { p0_transpose_item<true, true>(w_in, INW, D, NQKV / 32, WTIN, scr, r, lane, norm_mix); continue; } r -= I_IN;
            p0_transpose_item<false>(w_out, D, D, D / 32, WTOUT, scr, r, lane);
        }
        p0_rows(x, norm_mix, w_in, bforget, XN, RR, LOGF, gw, NGW, lane);
    }
    xcd_barrier(xbar);
    {
        { const int cb = G >= 128 ? (int)blockIdx.x - (G - 32) : (int)blockIdx.x;
          if (cb >= 0 && cb < 32) p1_cumsum(cb, (LAS float*)ldsl, LOGF, F2); }
        pg8::Gemm g{XN, WTIN, M, NQKV, D}; pg8::StaticOrder S; S.init(M, NQKV, G, (int)blockIdx.x);
        EpiQKV E{QA, KA, VA, QB, KB, VB, gqa, gka, gqb, gkb, RR};
        pg8::gemm_phase<EpiQKV, pg8::StaticOrder, true, true>(ldsl, g, S, E);
        { const int nfull = (M / 256) * (NQKV / 256) - 2 * G;
          if (nfull > 0 && nfull < G) { if ((int)blockIdx.x >= nfull) { const int qw = ((int)blockIdx.x - nfull) * 8 + wave, NQW = (G - nfull) * 8; p0_quant4_rows<true>(eu, EU8, SU, qw, NQW, lane); p0_quant4_rows<false>(ev, EV8, SV, qw, NQW, lane); } }
          else { p0_quant4_rows<true>(eu, EU8, SU, gw, NGW, lane); p0_quant4_rows<false>(ev, EV8, SV, gw, NGW, lane); } }
    }
    xcd_barrier(xbar);
    attn_phase(ldsl, QA, KA, VA, QB, KB, VB, F2, sinks, relb, gqb, gkb, MIX, (unsigned*)(ws + WS_CTL) + 3584, G, wave, lane);
    xcd_barrier(xbar);
    {
        pg8::Gemm g{MIX, WTOUT, M, D, D}; pg8::StaticOrder S; S.init(M, D, G, (int)blockIdx.x);
        EpiOut E{AP, SSQ};
        pg8::gemm_phase<EpiOut, pg8::StaticOrder, true, true>(ldsl, g, S, E);
    }
    xcd_barrier(xbar);
    {
        pg8::Gemm g{AP, WTQ, M, NQ, D}; pg8::StaticOrder S; S.init(M, NQ, G, (int)blockIdx.x);
        EpiQV E{QV, SSQ};
        pg8::gemm_phase<EpiQV, pg8::StaticOrder, true, true>(ldsl, g, S, E);
    }
    xcd_barrier(xbar);
    {
        LAS unsigned* lut = (LAS unsigned*)(ldsl + TK_LUT_OFF + wave * 8192);
        for (int task = gw; task < (M / 32) * 4; task += NGW) topk_task(task >> 2, task & 3, QV, lut, EIDX, GATE, lane);
    }
    const bool p6local = NGW == (M / 32) * 4 && NGW * 8 == M;
    if (p6local) { __builtin_amdgcn_fence(__ATOMIC_RELEASE, "workgroup"); __syncthreads(); __builtin_amdgcn_fence(__ATOMIC_ACQUIRE, "workgroup"); }
    else xcd_barrier(xbar);
    { auto gbar = [&]() { xcd_barrier(xbar); };
      const int tfirst = p6local ? 64 * (int)blockIdx.x + 8 * wave : gw, tstep = 8 * NGW, tstride = p6local ? 1 : NGW, ntb = p6local ? 1 : (M + 8 * NGW - 1) / (8 * NGW);
      gather_chunked(AP, SSQ, norm_ffn, EIDX, GATE, EU8, EV8, SU, SV, out, ldsl + wave * GQ_WAVE, tfirst, tstep, tstride, ntb, lane, gbar); }
}
}

extern "C" void kernel_launch(void* const* d_in, const int* in_sizes, int n_in, void* d_out, int out_size, void* d_ws, size_t ws_size, hipStream_t stream) {
    static int grid_blocks = 0;
    if (!grid_blocks) {
        int dev = 0, cus = 0, per_cu = 0;
        (void)hipGetDevice(&dev);
        (void)hipDeviceGetAttribute(&cus, hipDeviceAttributeMultiprocessorCount, dev);
        (void)hipFuncSetAttribute((const void*)mk::mega, hipFuncAttributeMaxDynamicSharedMemorySize, mk::LDS_BYTES);
        (void)hipOccupancyMaxActiveBlocksPerMultiprocessor(&per_cu, (const void*)mk::mega, 512, (size_t)mk::LDS_BYTES);
        if (per_cu < 1) fprintf(stderr, "occupancy query says %d blocks/CU\n", per_cu);
        grid_blocks = cus;
    }
    (void)hipMemsetAsync(d_ws, 0, 16384, stream);
    mk::Params p{};
    for (int i = 0; i < 17; ++i) p.in[i] = (const float*)d_in[i];
    p.out = (float*)d_out; p.ws = (unsigned char*)d_ws;
    void* args[] = {&p};
    hipError_t e = hipLaunchCooperativeKernel((void*)mk::mega, dim3(grid_blocks), dim3(512), args, (size_t)mk::LDS_BYTES, stream);
    if (e != hipSuccess) fprintf(stderr, "cooperative launch failed: %s (grid %d)\n", hipGetErrorString(e), grid_blocks);
}
```

```cpp
#include <hip/hip_runtime.h>
#include <cstdint>
#include <cstdio>
namespace pg8 {
#define PG8_LAS __attribute__((address_space(3)))
typedef unsigned short bf16_t;
typedef short bf16x8 __attribute__((ext_vector_type(8)));
typedef float f32x4 __attribute__((ext_vector_type(4)));
typedef unsigned u32x4 __attribute__((ext_vector_type(4)));
constexpr int BM = 256, BK = 64, HALF = 128, HTB = HALF * BK * 2  , STAGE_BYTES = 8 * HTB, NXCD = 8, WGM = 8;

__host__ __device__ __forceinline__ int lds_byte(int r, int c) { const int st = (r >> 4) * 2 + (c >> 5), rr = r & 15, cc = c & 31, ob = rr * 64 + cc * 2; return st * 1024 + (ob ^ (((ob >> 9) & 1) << 5)); }
__host__ __device__ __forceinline__ void stage_rc(int b, int& R, int& C) { const int st = b / 1024, sb = b % 1024, swz = sb ^ (((sb >> 9) & 1) << 5); R = (st >> 1) * 16 + swz / 64; C = (st & 1) * 32 + (swz % 64) / 2; }
__host__ __device__ __forceinline__ int perm32(int rho) { const int n = rho >> 4, i = rho & 15; return 8 * (i >> 2) + 4 * n + (i & 3); }

struct Unit { int pm, pn; };
struct Gemm { const bf16_t* A; const bf16_t* Bt; int M, N, K; };

struct StaticOrder {
    int nM, nN, nwg, G, c;
    __host__ __device__ void init(int M, int N, int G_, int c_) { nM = M / BM; nN = N / BM; nwg = nM * nN; G = G_; c = c_; }
    __host__ __device__ bool next(int i, Unit& u) const {
        const long L = (long)i * G + c; if (L >= nwg) return false;
        int wgid = (int)L; { const int q = nwg / NXCD, r = nwg % NXCD, xcd = wgid % NXCD, off = wgid / NXCD; wgid = (xcd < r ? xcd * (q + 1) : r * (q + 1) + (xcd - r) * q) + off; }
        const int nig = WGM * nN, gid = wgid / nig, fm = gid * WGM, gsz = (nM - fm) < WGM ? (nM - fm) : WGM;
        u.pm = fm + ((wgid % nig) % gsz); u.pn = (wgid % nig) / gsz; return true;
    }
    __device__ __forceinline__ void a_ready(const Unit&) const {}
    __device__ __forceinline__ void done(const Unit&) const {}
};

__device__ __forceinline__ unsigned cvt_pk_bf16(float lo, float hi) { unsigned r; asm volatile("v_cvt_pk_bf16_f32 %0, %1, %2" : "=v"(r) : "v"(lo), "v"(hi)); return r; }
typedef float f32x2 __attribute__((ext_vector_type(2)));
template <class Epi, class Sched, bool ALIGN_EPI = false, bool SP2 = false>
__device__ __forceinline__ void gemm_phase(PG8_LAS unsigned char* lds, const Gemm g, const Sched& S, const Epi& E) {
    int tid_ = threadIdx.x; asm volatile("" : "+v"(tid_));
    const int tid = tid_, wid = __builtin_amdgcn_readfirstlane(tid >> 6), lane = tid & 63, wr = wid >> 2, wc = wid & 3, fr = lane & 15, fq = lane >> 4;
    const int K = g.K, nt = K / BK;
    unsigned voffA[2], voffB[2];
#pragma unroll
    for (int i = 0; i < 2; ++i) { int R, C; stage_rc(tid * 16 + i * 8192, R, C); const int Rb = Epi::PERM ? ((R & ~31) + perm32(R & 31)) : R;
        voffA[i] = (unsigned)(R * K + C) * 2u; voffB[i] = (unsigned)(Rb * K + C) * 2u; }
    const size_t kstep = (size_t)(BK * 2);
    const size_t hstep = (size_t)HALF * K * 2;
    const size_t tstep = 2 * hstep;
    const unsigned ldsw = (unsigned)wid * 1024u;
    const int aoff = lds_byte(wr * 64 + fr, fq * 8), boff = lds_byte(wc * 32 + fr, fq * 8);
#define PG8_SA(b, h) (((b) * 2 + (h)) * HTB)
#define PG8_SB(b, h) ((4 + (b) * 2 + (h)) * HTB)
#define PG8_STAGE(bufoff, gbase, voff) do { _Pragma("unroll") for (int _i = 0; _i < 2; ++_i) \
        __builtin_amdgcn_global_load_lds((const unsigned*)((const char*)(gbase) + (voff)[_i]), (PG8_LAS unsigned*)(lds + (bufoff) + ldsw + _i * 8192), 16, 0, 0); } while (0)
#define PG8_LDA(dst, b, h) do { _Pragma("unroll") for (int m = 0; m < 4; ++m) _Pragma("unroll") for (int k = 0; k < 2; ++k) dst[m][k] = *(const PG8_LAS bf16x8*)(lds + PG8_SA(b, h) + aoff + m * 2048 + k * 1024); } while (0)
#define PG8_LDB(dst, b, h) do { _Pragma("unroll") for (int n = 0; n < 2; ++n) _Pragma("unroll") for (int k = 0; k < 2; ++k) dst[n][k] = *(const PG8_LAS bf16x8*)(lds + PG8_SB(b, h) + boff + n * 2048 + k * 1024); } while (0)
#define PG8_MMA(ai, bj, At, Bt) do { __builtin_amdgcn_s_setprio(1); _Pragma("unroll") for (int m = 0; m < 4; ++m) _Pragma("unroll") for (int n = 0; n < 2; ++n) _Pragma("unroll") for (int k = 0; k < 2; ++k) \
        acc[ai][bj][m][n] = __builtin_amdgcn_mfma_f32_16x16x32_bf16(Bt[n][k], At[m][k], acc[ai][bj][m][n], 0, 0, 0); __builtin_amdgcn_s_setprio(0); } while (0)
#define PG8_WAIT_V(n) asm volatile("s_waitcnt vmcnt(" #n ")" ::: "memory")
#define PG8_WAIT_L(n) asm volatile("s_waitcnt lgkmcnt(" #n ")" ::: "memory")
#define PG8_BAR __builtin_amdgcn_s_barrier()
#define PG8_SCHED __builtin_amdgcn_sched_barrier(0)
    Unit cur, nxt; int ui = 0;
    if (!S.next(0, cur)) return;
    f32x4 acc[2][2][4][2];
#pragma unroll
    for (int a = 0; a < 2; ++a)
#pragma unroll
        for (int b = 0; b < 2; ++b)
#pragma unroll
            for (int m = 0; m < 4; ++m)
#pragma unroll
                for (int n = 0; n < 2; ++n) acc[a][b][m][n] = (f32x4){0.f, 0.f, 0.f, 0.f};
    bf16x8 At[4][2], B0[2][2], B1[2][2];
    const char* cA = (const char*)g.A + (size_t)cur.pm * tstep; const char* cB = (const char*)g.Bt + (size_t)cur.pn * tstep;
    S.a_ready(cur);
    if constexpr (SP2) {
        PG8_STAGE(PG8_SB(0, 0), cB, voffB); PG8_STAGE(PG8_SB(0, 1), cB + hstep, voffB); PG8_STAGE(PG8_SA(0, 0), cA, voffA); PG8_STAGE(PG8_SA(0, 1), cA + hstep, voffA);
        if (wr == 1) PG8_BAR;
        PG8_WAIT_V(2); PG8_BAR;
        PG8_STAGE(PG8_SB(1, 0), cB + kstep, voffB); PG8_STAGE(PG8_SA(1, 0), cA + kstep, voffA); PG8_STAGE(PG8_SB(1, 1), cB + hstep + kstep, voffB);
        PG8_WAIT_V(6); PG8_BAR;
    } else {
        PG8_STAGE(PG8_SB(0, 0), cB, voffB); PG8_STAGE(PG8_SA(0, 0), cA, voffA); PG8_STAGE(PG8_SB(0, 1), cB + hstep, voffB); PG8_STAGE(PG8_SA(0, 1), cA + hstep, voffA);
        if (wr == 1) PG8_BAR;
        PG8_WAIT_V(4); PG8_BAR;
        PG8_STAGE(PG8_SB(1, 0), cB + kstep, voffB); PG8_STAGE(PG8_SA(1, 0), cA + kstep, voffA); PG8_STAGE(PG8_SB(1, 1), cB + hstep + kstep, voffB);
        PG8_WAIT_V(6); PG8_BAR;
    }
    for (;;) {
        const bool has_next = S.next(ui + 1, nxt);
        const char* nA = has_next ? (const char*)g.A + (size_t)nxt.pm * tstep : cA; const char* nB = has_next ? (const char*)g.Bt + (size_t)nxt.pn * tstep : cB;
        for (int t = 0; t < nt; t += 2) {
            const bool last = (t == nt - 2);
            const char* a1 = cA + (size_t)(t + 1) * kstep;
            const char* a2 = last ? nA : cA + (size_t)(t + 2) * kstep; const char* b2 = last ? nB : cB + (size_t)(t + 2) * kstep;
            const char* a3 = a2 + kstep; const char* b3 = b2 + kstep;
            if (last && has_next) S.a_ready(nxt);
            if constexpr (SP2) {
            PG8_LDB(B0, 0, 0); PG8_LDB(B1, 0, 1); PG8_SCHED; PG8_LDA(At, 0, 0); PG8_STAGE(PG8_SA(1, 1), a1 + hstep, voffA);
            PG8_WAIT_V(8); PG8_WAIT_L(0); PG8_BAR; PG8_MMA(0, 0, At, B0); PG8_MMA(0, 1, At, B1); PG8_BAR; PG8_SCHED;
            PG8_LDA(At, 0, 1); PG8_STAGE(PG8_SB(0, 0), b2, voffB); PG8_STAGE(PG8_SB(0, 1), b2 + hstep, voffB); PG8_STAGE(PG8_SA(0, 0), a2, voffA);
            PG8_WAIT_V(8); PG8_WAIT_L(0); PG8_BAR; PG8_MMA(1, 0, At, B0); PG8_MMA(1, 1, At, B1); PG8_BAR; PG8_SCHED;
            PG8_LDB(B0, 1, 0); PG8_LDB(B1, 1, 1); PG8_SCHED; PG8_LDA(At, 1, 0); PG8_STAGE(PG8_SA(0, 1), a2 + hstep, voffA);
            PG8_WAIT_V(8); PG8_WAIT_L(0); PG8_BAR; PG8_MMA(0, 0, At, B0); PG8_MMA(0, 1, At, B1); PG8_BAR; PG8_SCHED;
            PG8_LDA(At, 1, 1); PG8_STAGE(PG8_SB(1, 0), b3, voffB); PG8_STAGE(PG8_SB(1, 1), b3 + hstep, voffB); PG8_STAGE(PG8_SA(1, 0), a3, voffA);
            PG8_WAIT_V(8); PG8_WAIT_L(0); PG8_BAR; PG8_MMA(1, 0, At, B0); PG8_MMA(1, 1, At, B1); PG8_BAR; PG8_SCHED;
            } else {
            PG8_LDB(B0, 0, 0); PG8_SCHED; PG8_LDA(At, 0, 0); PG8_STAGE(PG8_SA(1, 1), a1 + hstep, voffA);
            PG8_WAIT_L(8); PG8_BAR; PG8_WAIT_L(0); PG8_MMA(0, 0, At, B0); PG8_BAR; PG8_SCHED;
            PG8_LDB(B1, 0, 1); PG8_STAGE(PG8_SB(0, 0), b2, voffB);
            PG8_BAR; PG8_WAIT_L(0); PG8_MMA(0, 1, At, B1); PG8_BAR;
            PG8_LDA(At, 0, 1); PG8_STAGE(PG8_SA(0, 0), a2, voffA);
            PG8_BAR; PG8_WAIT_L(0); PG8_MMA(1, 0, At, B0); PG8_BAR; PG8_SCHED;
            PG8_STAGE(PG8_SB(0, 1), b2 + hstep, voffB);
            PG8_WAIT_V(6); PG8_BAR; PG8_MMA(1, 1, At, B1); PG8_BAR;
            PG8_LDB(B0, 1, 0); PG8_SCHED; PG8_LDA(At, 1, 0); PG8_STAGE(PG8_SA(0, 1), a2 + hstep, voffA);
            PG8_WAIT_L(8); PG8_BAR; PG8_WAIT_L(0); PG8_MMA(0, 0, At, B0); PG8_BAR; PG8_SCHED;
            PG8_LDB(B1, 1, 1); PG8_STAGE(PG8_SB(1, 0), b3, voffB);
            PG8_BAR; PG8_WAIT_L(0); PG8_MMA(0, 1, At, B1); PG8_BAR;
            PG8_LDA(At, 1, 1); PG8_STAGE(PG8_SA(1, 0), a3, voffA);
            PG8_BAR; PG8_WAIT_L(0); PG8_MMA(1, 0, At, B0); PG8_BAR; PG8_SCHED;
            PG8_STAGE(PG8_SB(1, 1), b3 + hstep, voffB);
            PG8_WAIT_V(6); PG8_BAR; PG8_MMA(1, 1, At, B1); PG8_BAR;
            }
        }
        if constexpr (ALIGN_EPI) { if (wr == 0) PG8_BAR; }
        if constexpr (!Epi::AFTER_DRAIN) { E(acc, cur, wr, wc, fr, fq); S.done(cur); }
        if (!has_next) break;
#pragma unroll
        for (int a = 0; a < 2; ++a)
#pragma unroll
            for (int b = 0; b < 2; ++b)
#pragma unroll
                for (int m = 0; m < 4; ++m)
#pragma unroll
                    for (int n = 0; n < 2; ++n) acc[a][b][m][n] = (f32x4){0.f, 0.f, 0.f, 0.f};
        cur = nxt; cA = nA; cB = nB; ++ui;
        if constexpr (ALIGN_EPI) { if (wr == 1) PG8_BAR; }
    }
    PG8_WAIT_V(0);
    if constexpr (!ALIGN_EPI) { if (wr == 0) PG8_BAR; }
    PG8_BAR;
    if constexpr (Epi::AFTER_DRAIN) { E.fused(acc, cur, wr, wc, fr, fq, lds, wid, lane); S.done(cur); }
#undef PG8_SA
#undef PG8_SB
#undef PG8_STAGE
#undef PG8_LDA
#undef PG8_LDB
#undef PG8_MMA
#undef PG8_WAIT_V
#undef PG8_WAIT_L
#undef PG8_BAR
#undef PG8_SCHED
}
}
namespace mk {
using pg8::bf16_t; using pg8::f32x4; using pg8::u32x4; using pg8::Unit; using pg8::cvt_pk_bf16;
typedef unsigned u32x2 __attribute__((ext_vector_type(2)));
#define LAS __attribute__((address_space(3)))
constexpr int D = 1024, BATCH = 4, SEQ = 4096, M = BATCH * SEQ;
constexpr int INW = 2312, NQKV = 2304, NQ = 2048, NEXP = 16384;
constexpr float EPS = 1e-6f, LOG2E = 1.4426950408889634f, C2 = 0.125f * LOG2E;
constexpr size_t MiB = 1u << 20;
constexpr size_t WS_CTL = 0, WS_WTIN = 1 * MiB, WS_WTOUT = 6 * MiB, WS_WTQ = 8 * MiB, WS_SK = 12 * MiB, WS_LOGF = 13 * MiB, WS_F2 = 13 * MiB + 512 * 1024, WS_SSQ = 14 * MiB,
                 WS_EIDX = 16 * MiB, WS_GATE = 24 * MiB, WS_XN = 32 * MiB, WS_QA = 64 * MiB, WS_KA = 80 * MiB, WS_VA = 84 * MiB, WS_QB = 88 * MiB, WS_KB = 104 * MiB, WS_VB = 120 * MiB,
                 WS_MIX = 136 * MiB, WS_QV = 64 * MiB, WS_EU8 = 168 * MiB, WS_EV8 = 184 * MiB, WS_X1 = 192 * MiB, WS_COEF = 136 * MiB, WS_CSUM = 144 * MiB, WS_SU = 15 * MiB, WS_SV = 15 * MiB + 65536, WS_RR = 15 * MiB + 131072;

__device__ __constant__ unsigned char T5B[128] = {0, 1, 2, 3, 4, 5, 6, 7, 8, 9, 10, 11, 12, 13, 14, 15, 16, 16, 16, 17, 17, 18, 18, 18, 19, 19, 19, 20, 20, 20, 20, 21, 21, 21, 21, 22, 22, 22, 22, 22, 23, 23, 23, 23, 23, 23, 24, 24, 24, 24, 24, 24, 25, 25, 25, 25, 25, 25, 25, 26, 26, 26, 26, 26, 26, 26, 26, 27, 27, 27, 27, 27, 27, 27, 27, 27, 27, 28, 28, 28, 28, 28, 28, 28, 28, 28, 28, 29, 29, 29, 29, 29, 29, 29, 29, 29, 29, 29, 29, 30, 30, 30, 30, 30, 30, 30, 30, 30, 30, 30, 30, 30, 30, 31, 31, 31, 31, 31, 31, 31, 31, 31, 31, 31, 31, 31, 31, 31};

__device__ __forceinline__ float wave_sum(float v) {
#pragma unroll
    for (int o = 1; o < 64; o <<= 1) v += __shfl_xor(v, o);
    return v;
}
__device__ __forceinline__ float bf_lo(unsigned w) { return __uint_as_float(w << 16); }
__device__ __forceinline__ float bf_hi(unsigned w) { return __uint_as_float(w & 0xffff0000u); }

struct EpiQKV {
    static constexpr bool PERM = true, AFTER_DRAIN = false;
    bf16_t *QA, *KA, *VA, *QB, *KB, *VB; const float *gqa, *gka, *gqb, *gkb; const float* rr;
    __device__ __forceinline__ void operator()(const f32x4 (&acc)[2][2][4][2], const Unit& u, int wr, int wc, int fr, int fq) const {
        const int s = u.pn * 4 + wc;
        bf16_t* dst; int pitch; const float* g; float sc = 1.f;
        if (s < 8) { dst = QA + 64 * s; pitch = 512; g = gqa; sc = C2; }
        else if (s < 10) { dst = KA + 64 * (s - 8); pitch = 128; g = gka; }
        else if (s < 12) { dst = VA + 64 * (s - 10); pitch = 128; g = nullptr; }
        else if (s < 20) { dst = QB + 64 * (s - 12); pitch = 512; g = gqb; sc = C2; }
        else if (s < 28) { dst = KB + 64 * (s - 20); pitch = 512; g = gkb; }
        else { dst = VB + 64 * (s - 28); pitch = 512; g = nullptr; }
        f32x4 gv[2][2];
#pragma unroll
        for (int bj = 0; bj < 2; ++bj)
#pragma unroll
            for (int n = 0; n < 2; ++n) gv[bj][n] = g ? *(const f32x4*)(g + 32 * bj + 8 * fq + 4 * n) * sc : (f32x4){1.f, 1.f, 1.f, 1.f};
        const int row0 = u.pm * 256 + wr * 64 + fr;
        float rw[2][4];
#pragma unroll
        for (int ai = 0; ai < 2; ++ai)
#pragma unroll
            for (int m = 0; m < 4; ++m) rw[ai][m] = rr[row0 + ai * 128 + m * 16];
#pragma unroll
        for (int ai = 0; ai < 2; ++ai)
#pragma unroll
            for (int m = 0; m < 4; ++m) {
                float ss = 0.f;
#pragma unroll
                for (int bj = 0; bj < 2; ++bj)
#pragma unroll
                    for (int n = 0; n < 2; ++n) { const f32x4 v = acc[ai][bj][m][n]; ss += (v[0] * v[0] + v[1] * v[1]) + (v[2] * v[2] + v[3] * v[3]); }
                ss += __shfl_xor(ss, 16); ss += __shfl_xor(ss, 32);
                const float rx = rw[ai][m]; const float rs = g ? rsqrtf(ss * (rx * rx) * (1.f / 64.f) + EPS) * rx : rx;
                bf16_t* rowp = dst + (size_t)(row0 + ai * 128 + m * 16) * pitch + 8 * fq;
#pragma unroll
                for (int bj = 0; bj < 2; ++bj) {
                    const f32x4 v0 = acc[ai][bj][m][0] * rs * gv[bj][0], v1 = acc[ai][bj][m][1] * rs * gv[bj][1];
                    u32x4 w; w.x = cvt_pk_bf16(v0[0], v0[1]); w.y = cvt_pk_bf16(v0[2], v0[3]); w.z = cvt_pk_bf16(v1[0], v1[1]); w.w = cvt_pk_bf16(v1[2], v1[3]);
                    *(u32x4*)(rowp + 32 * bj) = w;
                }
            }
    }
};
struct EpiOut {
    static constexpr bool PERM = false, AFTER_DRAIN = false;
    bf16_t* ap; float* ssq;
    __device__ __forceinline__ void operator()(const f32x4 (&acc)[2][2][4][2], const Unit& u, int wr, int wc, int fr, int fq) const {
        const int col0 = u.pn * 256 + wc * 32 + 4 * fq;
        const int row0 = u.pm * 256 + wr * 64 + fr;
#pragma unroll
        for (int ai = 0; ai < 2; ++ai) {
            u32x2 xc[4][2][2];
#pragma unroll
            for (int m = 0; m < 4; ++m)
#pragma unroll
                for (int bj = 0; bj < 2; ++bj)
#pragma unroll
                    for (int n = 0; n < 2; ++n) xc[m][bj][n] = *(const u32x2*)(ap + (size_t)(row0 + ai * 128 + m * 16) * D + col0 + bj * 128 + n * 16);
            __builtin_amdgcn_sched_barrier(0);
#pragma unroll
            for (int m = 0; m < 4; ++m) {
                const int row = row0 + ai * 128 + m * 16; const size_t off = (size_t)row * D + col0; float ss = 0.f;
#pragma unroll
                for (int bj = 0; bj < 2; ++bj)
#pragma unroll
                    for (int n = 0; n < 2; ++n) {
                        const size_t o2 = off + bj * 128 + n * 16;
                        const u32x2 xw = xc[m][bj][n]; const f32x4 v = acc[ai][bj][m][n] + (f32x4){bf_lo(xw.x), bf_hi(xw.x), bf_lo(xw.y), bf_hi(xw.y)};
                        ss += (v[0] * v[0] + v[1] * v[1]) + (v[2] * v[2] + v[3] * v[3]);
                        u32x2 w; w.x = cvt_pk_bf16(v[0], v[1]); w.y = cvt_pk_bf16(v[2], v[3]);
                        *(u32x2*)(ap + o2) = w;
                    }
                ss += __shfl_xor(ss, 16); ss += __shfl_xor(ss, 32);
                if (fq == 0) ssq[(size_t)row * 16 + u.pn * 4 + wc] = ss;
            }
        }
    }
};
struct EpiQV {
    static constexpr bool PERM = true, AFTER_DRAIN = false;
    bf16_t* qv; const float* ssq;
    __device__ __forceinline__ void operator()(const f32x4 (&acc)[2][2][4][2], const Unit& u, int wr, int wc, int fr, int fq) const {
        const int row0 = u.pm * 256 + wr * 64 + fr, col0 = u.pn * 256 + wc * 32 + 8 * fq;
#pragma unroll
        for (int ai = 0; ai < 2; ++ai)
#pragma unroll
            for (int m = 0; m < 4; ++m) {
                const int row = row0 + ai * 128 + m * 16;
                const f32x4* sp = (const f32x4*)(ssq + (size_t)row * 16);
                const f32x4 s0 = sp[0], s1 = sp[1], s2 = sp[2], s3 = sp[3];
                const float tot = ((s0[0] + s0[1]) + (s0[2] + s0[3])) + ((s1[0] + s1[1]) + (s1[2] + s1[3])) + ((s2[0] + s2[1]) + (s2[2] + s2[3])) + ((s3[0] + s3[1]) + (s3[2] + s3[3]));
                const float rs = rsqrtf(tot * (1.f / D) + EPS);
                bf16_t* rowp = qv + (size_t)row * NQ + col0;
#pragma unroll
                for (int bj = 0; bj < 2; ++bj) {
                    const f32x4 v0 = acc[ai][bj][m][0] * rs, v1 = acc[ai][bj][m][1] * rs;
                    u32x4 w; w.x = cvt_pk_bf16(v0[0], v0[1]); w.y = cvt_pk_bf16(v0[2], v0[3]); w.z = cvt_pk_bf16(v1[0], v1[1]); w.w = cvt_pk_bf16(v1[2], v1[3]);
                    *(u32x4*)(rowp + 128 * bj) = w;
                }
            }
    }
};

__device__ __forceinline__ int rowmap_in(int n0) { const int s = n0 >> 6, bj = (n0 >> 5) & 1; return 256 * (s >> 2) + 128 * bj + 32 * (s & 3); }
template <bool MAPIN, bool SCALE = false  >
__device__ __forceinline__ void p0_transpose_item(const float* __restrict__ W, int ldw, int K, int nblk, bf16_t* __restrict__ WT, LAS float* scr, int item, int lane, const float* __restrict__ rsc = nullptr) {
    const int kb = item / nblk, nb = item % nblk, k0 = 64 * kb, n0 = 32 * nb;
    const int r0 = MAPIN ? rowmap_in(n0) : n0;
#pragma unroll 8
    for (int i = 0; i < 32; ++i) { const int kk = 2 * i + (lane >> 5); scr[kk * 33 + (lane & 31)] = W[(size_t)(k0 + kk) * ldw + n0 + (lane & 31)] * (SCALE ? rsc[k0 + kk] : 1.f); }
    asm volatile("s_waitcnt lgkmcnt(0)" ::: "memory");
    const int c = lane & 7;
#pragma unroll
    for (int j = 0; j < 4; ++j) { const int n = (lane >> 3) + 8 * j; const LAS float* s = scr + (8 * c) * 33 + n;
        u32x4 o; o.x = cvt_pk_bf16(s[0 * 33], s[1 * 33]); o.y = cvt_pk_bf16(s[2 * 33], s[3 * 33]); o.z = cvt_pk_bf16(s[4 * 33], s[5 * 33]); o.w = cvt_pk_bf16(s[6 * 33], s[7 * 33]);
        *(u32x4*)(WT + (size_t)(r0 + n) * K + k0 + 8 * c) = o; }
    asm volatile("s_waitcnt lgkmcnt(0)" ::: "memory");
}
__device__ __forceinline__ void p0_keyfold_item(const float* __restrict__ wq, const float* __restrict__ sk1, const float* __restrict__ sk2, const float* __restrict__ g, bf16_t* __restrict__ WT, int item, int lane) {
    typedef short bf16x8s_ __attribute__((ext_vector_type(8)));
    typedef float f32x16_ __attribute__((ext_vector_type(16)));
    const int tile = item & 3, k0 = 32 * ((item >> 2) & 31), hh2 = item >> 7, tl = lane & 31, dg = lane >> 5;
    const float* sp = ((hh2 & 1) ? sk2 : sk1) + (size_t)(32 * tile + tl) * 128 + dg * 8;
    const float* wrow = wq + (size_t)(k0 + tl) * NQ + hh2 * 128 + dg * 8;
    const float gk = g[k0 + tl];
    f32x4 a0[8], a1[8], b0[8], b1[8];
#pragma unroll
    for (int ds = 0; ds < 8; ++ds) { b0[ds] = *(const f32x4*)(wrow + ds * 16); b1[ds] = *(const f32x4*)(wrow + ds * 16 + 4); a0[ds] = *(const f32x4*)(sp + ds * 16); a1[ds] = *(const f32x4*)(sp + ds * 16 + 4); }
    f32x16_ acc;
#pragma unroll
    for (int r = 0; r < 16; ++r) acc[r] = 0.f;
#pragma unroll
    for (int ds = 0; ds < 8; ++ds) {
        const f32x4 p0 = b0[ds] * gk, p1 = b1[ds] * gk;
        const u32x4 bw = {cvt_pk_bf16(p0[0], p0[1]), cvt_pk_bf16(p0[2], p0[3]), cvt_pk_bf16(p1[0], p1[1]), cvt_pk_bf16(p1[2], p1[3])};
        const u32x4 aw = {cvt_pk_bf16(a0[ds][0], a0[ds][1]), cvt_pk_bf16(a0[ds][2], a0[ds][3]), cvt_pk_bf16(a1[ds][0], a1[ds][1]), cvt_pk_bf16(a1[ds][2], a1[ds][3])};
        acc = __builtin_amdgcn_mfma_f32_32x32x16_bf16(__builtin_bit_cast(bf16x8s_, aw), __builtin_bit_cast(bf16x8s_, bw), acc, 0, 0, 0);
    }
    const int odd = tl & 1;
#pragma unroll
    for (int r = 0; r < 16; r += 2) {
        const float own0 = acc[r], own1 = acc[r + 1];
        const float recv = __shfl_xor(odd ? own0 : own1, 1);
        const int n = 32 * tile + ((r + odd) & 3) + 8 * ((r + odd) >> 2) + 4 * dg;
        const unsigned w = odd ? cvt_pk_bf16(recv, own1) : cvt_pk_bf16(own0, recv);
        *(unsigned*)(WT + (size_t)(hh2 * 128 + n) * D + k0 + (tl & ~1)) = w;
    }
}
__device__ __forceinline__ void p0_convert(const float* __restrict__ src, bf16_t* __restrict__ dst, size_t n8, int gw, int NGW, int lane) {
    for (size_t i = (size_t)gw * 64 + lane; i < n8; i += (size_t)NGW * 64) {
        const f32x4 a = ((const f32x4*)src)[2 * i], b = ((const f32x4*)src)[2 * i + 1];
        u32x4 w; w.x = cvt_pk_bf16(a[0], a[1]); w.y = cvt_pk_bf16(a[2], a[3]); w.z = cvt_pk_bf16(b[0], b[1]); w.w = cvt_pk_bf16(b[2], b[3]);
        ((u32x4*)dst)[i] = w;
    }
}
__device__ __forceinline__ void p0_rows(const float* __restrict__ x, const float* __restrict__ g, const float* __restrict__ w_in, const float* __restrict__ bforget, bf16_t* __restrict__ XN, float* __restrict__ RR, float* __restrict__ logf, int gw, int NGW, int lane) {
    f32x4 wa[16], wb[16];
#pragma unroll
    for (int jj = 0; jj < 4; ++jj)
#pragma unroll
        for (int e = 0; e < 4; ++e) { const f32x4* wp = (const f32x4*)(w_in + (size_t)(256 * jj + 4 * lane + e) * INW + NQKV); wa[jj * 4 + e] = wp[0]; wb[jj * 4 + e] = wp[1]; }
    const float bl = bforget[lane & 7];
#pragma unroll 1
    for (int rowb = gw; rowb < M; rowb += 4 * NGW) {
        f32x4 v4[4][4];
#pragma unroll
        for (int r = 0; r < 4; ++r) { const int row = rowb + r * NGW < M ? rowb + r * NGW : rowb; const f32x4* xr = (const f32x4*)(x + (size_t)row * D);
#pragma unroll
            for (int jj = 0; jj < 4; ++jj) v4[r][jj] = __builtin_nontemporal_load(xr + lane + 64 * jj); }
#pragma unroll
        for (int r = 0; r < 4; ++r) {
            const int row = rowb + r * NGW;
            if (row < M) {
                float s = 0.f;
#pragma unroll
                for (int jj = 0; jj < 4; ++jj) { const f32x4 v = v4[r][jj]; s += (v[0] * v[0] + v[1] * v[1]) + (v[2] * v[2] + v[3] * v[3]); }
                s = wave_sum(s);
                const float rs = rsqrtf(s * (1.f / D) + EPS);
                f32x4 pa = {0.f, 0.f, 0.f, 0.f}, pb = {0.f, 0.f, 0.f, 0.f};
#pragma unroll
                for (int jj = 0; jj < 4; ++jj) {
                    const f32x4 v = v4[r][jj]; const f32x4 h = v * rs * ((const f32x4*)g)[lane + 64 * jj];
                    u32x2 w; w.x = cvt_pk_bf16(v[0], v[1]); w.y = cvt_pk_bf16(v[2], v[3]);
                    *(u32x2*)(XN + (size_t)row * D + 256 * jj + 4 * lane) = w;
#pragma unroll
                    for (int e = 0; e < 4; ++e) { pa += wa[jj * 4 + e] * h[e]; pb += wb[jj * 4 + e] * h[e]; }
                }
                float z = 0.f;
#pragma unroll
                for (int j = 0; j < 4; ++j) { const float sa = wave_sum(pa[j]), sb = wave_sum(pb[j]); if (lane == j) z = sa; if (lane == 4 + j) z = sb; }
                if (lane == 8) RR[row] = rs;
                if (lane < 8) { z += bl; logf[(size_t)row * 8 + lane] = fminf(z, 0.f) - log1pf(expf(-fabsf(z))); }
            }
        }
    }
}
__device__ __forceinline__ void p1_cumsum(int bh, LAS float* part, const float* __restrict__ logf, float* __restrict__ F2) {
    const int b = bh >> 3, h = bh & 7, tid = threadIdx.x, lane = tid & 63, wv = tid >> 6;
    float v[8]; float s = 0.f;
#pragma unroll
    for (int i = 0; i < 8; ++i) { s += logf[((size_t)b * SEQ + tid * 8 + i) * 8 + h]; v[i] = s; }
    float inc = s;
#pragma unroll
    for (int o = 1; o < 64; o <<= 1) { const float t = __shfl_up(inc, o); if (lane >= o) inc += t; }
    if (lane == 63) part[wv] = inc;
    __syncthreads();
    float base = inc - s;
    for (int w = 0; w < wv; ++w) base += part[w];
#pragma unroll
    for (int i = 0; i < 8; ++i) F2[(size_t)bh * SEQ + tid * 8 + i] = (base + v[i]) * LOG2E;
    __syncthreads();
}
__device__ __forceinline__ float wave_max(float v) {
#pragma unroll
    for (int o = 1; o < 64; o <<= 1) v = fmaxf(v, __shfl_xor(v, o));
    return v;
}
template <bool SIGNED  >
__device__ __forceinline__ void p0_quant4_rows(const float* __restrict__ T, unsigned char* __restrict__ T4, float* __restrict__ SC, int gw, int NGW, int lane) {
    for (int row = gw; row < NEXP; row += NGW) {
        const f32x4* tr = (const f32x4*)(T + (size_t)row * D + 16 * lane);
        f32x4 v[4]; float ss = 0.f;
#pragma unroll
        for (int j = 0; j < 4; ++j) { v[j] = __builtin_nontemporal_load(tr + j); ss += (v[j][0] * v[j][0] + v[j][1] * v[j][1]) + (v[j][2] * v[j][2] + v[j][3] * v[j][3]); }
        ss = wave_sum(ss);
        const float s = fmaxf(0.3352f * sqrtf(ss * (1.f / D)), 1e-30f), inv = 1.f / s;
        u32x2 w;
#pragma unroll
        for (int j2 = 0; j2 < 2; ++j2) {
            unsigned p = 0;
#pragma unroll
            for (int e = 0; e < 4; ++e) {
                const int lo = ((int)fminf(fmaxf(floorf(v[2 * j2][e] * inv), -8.f), 7.f) + (SIGNED ? 0 : 8)) & 15, hi = ((int)fminf(fmaxf(floorf(v[2 * j2 + 1][e] * inv), -8.f), 7.f) + (SIGNED ? 0 : 8)) & 15;
                p |= ((unsigned)lo | ((unsigned)hi << 4)) << (8 * e);
            }
            w[j2] = p;
        }
        *(u32x2*)(T4 + (size_t)row * 512 + 8 * lane) = w;
        if (lane == 0) SC[row] = s;
    }
}

__device__ __forceinline__ int row16_sum_i(int v) {
    v += __builtin_amdgcn_update_dpp(0, v, 0xB1, 0xf, 0xf, false);
    v += __builtin_amdgcn_update_dpp(0, v, 0x4E, 0xf, 0xf, false);
    v += __builtin_amdgcn_update_dpp(0, v, 0x141, 0xf, 0xf, false);
    v += __builtin_amdgcn_update_dpp(0, v, 0x140, 0xf, 0xf, false);
    return v;
}
typedef int i32x4 __attribute__((ext_vector_type(4)));
typedef float f32x2 __attribute__((ext_vector_type(2)));
__device__ __forceinline__ float ub(unsigned w, int k) { return (float)((w >> (8 * k)) & 0xffu); }

constexpr int GQ_DOT = 0, GQ_TOKC = 4096, GQ_PKL = 4352, GQ_UN = 5376, GQ_H2Q = GQ_UN, GQ_UIMG = GQ_UN + 8192, GQ_VIMG = GQ_UN, GQ_WAVE = 17920;
constexpr int GQ_UROW = 68, GQ_VROW = 36;
static_assert(GQ_UIMG + 16 * GQ_UROW * 4 <= GQ_WAVE && GQ_VIMG + 64 * GQ_VROW * 4 <= GQ_WAVE && 8 * GQ_WAVE <= 147440, "gather LDS");
#define GT_DPP(v, ctrl) __uint_as_float((unsigned)__builtin_amdgcn_update_dpp(0, (int)__float_as_uint(v), ctrl, 0xf, 0xf, false))
__device__ __forceinline__ float wave_max_u(float v) {
    v = fmaxf(v, GT_DPP(v, 0xB1)); v = fmaxf(v, GT_DPP(v, 0x4E)); v = fmaxf(v, GT_DPP(v, 0x141)); v = fmaxf(v, GT_DPP(v, 0x140));
    const int iv = (int)__float_as_uint(v);
    const float a = __uint_as_float((unsigned)__builtin_amdgcn_readlane(iv, 0)), b = __uint_as_float((unsigned)__builtin_amdgcn_readlane(iv, 16)), c = __uint_as_float((unsigned)__builtin_amdgcn_readlane(iv, 32)), d = __uint_as_float((unsigned)__builtin_amdgcn_readlane(iv, 48));
    return fmaxf(fmaxf(a, b), fmaxf(c, d));
}
__device__ __forceinline__ int wave_sum_iu(int v) { v = row16_sum_i(v); return (__builtin_amdgcn_readlane(v, 0) + __builtin_amdgcn_readlane(v, 16)) + (__builtin_amdgcn_readlane(v, 32) + __builtin_amdgcn_readlane(v, 48)); }

template <class Bar>
__device__ __forceinline__ void gather_chunked(const bf16_t* __restrict__ ap, const float* __restrict__ ssq, const float* __restrict__ gffn, const int* __restrict__ eidx, const float* __restrict__ gate,
                                               const unsigned char* __restrict__ EU4, const unsigned char* __restrict__ EV4, const float* __restrict__ SU, const float* __restrict__ SV,
                                               float* __restrict__ out, LAS unsigned char* wl, int tfirst, int tstep, int tstride, int ntb  , int lane, const Bar& bar) {
    const int g8 = lane >> 3, pc = lane & 7, g84 = 4 * g8;
    const unsigned pc16 = (unsigned)pc * 16u;
    LAS int* DOT = (LAS int*)(wl + GQ_DOT); LAS float* TOKC = (LAS float*)(wl + GQ_TOKC); LAS unsigned* PKL = (LAS unsigned*)(wl + GQ_PKL);
    LAS unsigned char* H2Q = wl + GQ_H2Q; LAS int* UIMG = (LAS int*)(wl + GQ_UIMG); LAS int* VIMG = (LAS int*)(wl + GQ_VIMG);
#pragma unroll 1
    for (int tb = 0; tb < ntb; ++tb) {
        const int t0 = tfirst + tb * tstep;
        int ntok = 0; if (t0 < M) { ntok = (M - t0 + tstride - 1) / tstride; ntok = ntok > 8 ? 8 : ntok; }
#pragma unroll 1
        for (int i = 0; i < ntok; ++i) {
            const int t = t0 + i * tstride;
            float rs;
            { const f32x4* sp = (const f32x4*)(ssq + (size_t)t * 16); const f32x4 a = sp[0], b = sp[1], c = sp[2], d = sp[3];
              const float tot = ((a[0] + a[1]) + (a[2] + a[3])) + ((b[0] + b[1]) + (b[2] + b[3])) + ((c[0] + c[1]) + (c[2] + c[3])) + ((d[0] + d[1]) + (d[2] + d[3]));
              rs = rsqrtf(tot * (1.f / D) + EPS); }
            const u32x4* hp = (const u32x4*)(ap + (size_t)t * D + 16 * lane); const u32x4 w0 = hp[0], w1 = hp[1];
            float h[16];
#pragma unroll
            for (int k = 0; k < 4; ++k) { h[2 * k] = bf_lo(w0[k]); h[2 * k + 1] = bf_hi(w0[k]); h[8 + 2 * k] = bf_lo(w1[k]); h[8 + 2 * k + 1] = bf_hi(w1[k]); }
#pragma unroll
            for (int k = 0; k < 4; ++k) { const f32x4 gk = ((const f32x4*)(gffn + 16 * lane))[k]; h[4 * k] *= gk[0]; h[4 * k + 1] *= gk[1]; h[4 * k + 2] *= gk[2]; h[4 * k + 3] *= gk[3]; }
            float am = 0.f;
#pragma unroll
            for (int k = 0; k < 16; ++k) am = fmaxf(am, fabsf(h[k]));
            am = wave_max_u(am);
            const float hinv = am > 0.f ? 119.f / am : 0.f;
            u32x4 qw; int hs = 0;
#pragma unroll
            for (int d = 0; d < 2; ++d) { unsigned ph = 0, pl = 0;
#pragma unroll
                for (int k = 0; k < 8; ++k) { const int col = 8 * d + ((k & 1) ? 4 + (k >> 1) : (k >> 1)); const int q = __float2int_rn(h[col] * hinv); hs += q;
                    const int hh_ = (q + 8) >> 4, hl_ = q - 16 * hh_; ph |= ((unsigned)hh_ & 15u) << (4 * k); pl |= ((unsigned)hl_ & 15u) << (4 * k); }
                qw[2 * d] = ph; qw[2 * d + 1] = pl; }
            *(LAS u32x4*)(H2Q + i * 1024 + 16 * lane) = qw;
            hs = wave_sum_iu(hs);
            if (lane == 0) { TOKC[i * 8 + 0] = am * (1.f / 119.f) * rs; TOKC[i * 8 + 1] = (float)hs; }
            DOT[i * 128 + lane] = 0; DOT[i * 128 + 64 + lane] = 0;
        }
        u32x4 r[16];
        {
            const int nit = 4 * ntok;
            int e0 = 0, e1 = 0, en0 = 0, en1 = 0;
            if (ntok > 0) { e0 = eidx[(size_t)t0 * 128 + lane]; e1 = eidx[(size_t)t0 * 128 + 64 + lane]; }
            if (nit > 1) { const int tn = t0 + (1 % ntok) * tstride; en0 = eidx[(size_t)tn * 128 + lane]; en1 = eidx[(size_t)tn * 128 + 64 + lane]; }
            if (nit > 0) {
#pragma unroll
                for (int s_ = 0; s_ < 16; ++s_) { const unsigned e = (unsigned)__builtin_amdgcn_ds_bpermute(g84 + 32 * (s_ & 7), s_ < 8 ? e0 : e1); r[s_] = *(const u32x4*)(EU4 + (e * 512u + pc16)); }
            }
#pragma unroll 1
            for (int n = 0; n < nit; ++n) {
                const int c = n / ntok, i = n - c * ntok;
                const int n1 = n + 1; const bool more = n1 < nit; const int c1 = more ? n1 / ntok : 0;
                int ef0 = 0, ef1 = 0;
                { const int n2 = n + 2; const int i2 = n2 % ntok; const int tn = t0 + i2 * tstride; ef0 = eidx[(size_t)tn * 128 + lane]; ef1 = eidx[(size_t)tn * 128 + 64 + lane]; }
                int hq[8];
                { const LAS i32x4* hp = (const LAS i32x4*)(H2Q + i * 1024 + 256 * c + 32 * pc); const i32x4 a = hp[0], b = hp[1];
                  hq[0] = a[0]; hq[1] = a[1]; hq[2] = a[2]; hq[3] = a[3]; hq[4] = b[0]; hq[5] = b[1]; hq[6] = b[2]; hq[7] = b[3]; }
                const unsigned noff = (unsigned)c1 * 128u + pc16;
                unsigned enx = (unsigned)__builtin_amdgcn_ds_bpermute(g84, en0);
#pragma unroll
                for (int s_ = 0; s_ < 16; ++s_) {
                    const unsigned ecur = enx;
                    if (s_ + 1 < 16) enx = (unsigned)__builtin_amdgcn_ds_bpermute(g84 + 32 * ((s_ + 1) & 7), (s_ + 1) < 8 ? en0 : en1);
                    int ah = 0, al = 0;
#pragma unroll
                    for (int q = 0; q < 4; ++q) { const int w = (int)r[s_][q]; ah = __builtin_amdgcn_sdot8(w, hq[2 * q], ah, false); al = __builtin_amdgcn_sdot8(w, hq[2 * q + 1], al, false); }
                    UIMG[s_ * GQ_UROW + lane] = 16 * ah + al;
                    r[s_] = *(const u32x4*)(EU4 + (ecur * 512u + noff));
                    __builtin_amdgcn_sched_barrier(0);
                }
                { const LAS int* rp = UIMG + (lane >> 3) * GQ_UROW + 8 * (lane & 7);
                  const i32x4 a0 = *(const LAS i32x4*)(rp), a1 = *(const LAS i32x4*)(rp + 4), b0 = *(const LAS i32x4*)(rp + 8 * GQ_UROW), b1 = *(const LAS i32x4*)(rp + 8 * GQ_UROW + 4);
                  DOT[i * 128 + lane] += ((a0[0] + a0[1]) + (a0[2] + a0[3])) + ((a1[0] + a1[1]) + (a1[2] + a1[3]));
                  DOT[i * 128 + 64 + lane] += ((b0[0] + b0[1]) + (b0[2] + b0[3])) + ((b1[0] + b1[1]) + (b1[2] + b1[3])); }
                en0 = ef0; en1 = ef1;
            }
        }
#pragma unroll 1
        for (int i = 0; i < ntok; ++i) {
            const int t = t0 + i * tstride;
            const int e0 = eidx[(size_t)t * 128 + lane], e1 = eidx[(size_t)t * 128 + 64 + lane];
            const float g0 = gate[(size_t)t * 128 + lane], g1 = gate[(size_t)t * 128 + 64 + lane];
            const float su0 = SU[e0], su1 = SU[e1], sv0 = SV[e0], sv1 = SV[e1];
            const float sh = TOKC[i * 8 + 0], hoff = 0.5f * TOKC[i * 8 + 1];
            const float p0 = ((float)DOT[i * 128 + lane] + hoff) * su0 * sh, p1 = ((float)DOT[i * 128 + 64 + lane] + hoff) * su1 * sh;
            const float c0 = g0 * 0.5f * p0 * (1.f + erff(p0 * 0.70710678118654752f)) * sv0, c1 = g1 * 0.5f * p1 * (1.f + erff(p1 * 0.70710678118654752f)) * sv1;
            const float cmax = wave_max_u(fmaxf(fabsf(c0), fabsf(c1)));
            const float cinv = cmax > 0.f ? 127.f / cmax : 0.f;
            const int cq0 = __float2int_rn(c0 * cinv), cq1 = __float2int_rn(c1 * cinv);
            const int csq = wave_sum_iu(cq0 + cq1);
            unsigned pk = 0;
            { const int G = (lane >> 3) & 3, gl = lane & 7;
#pragma unroll
              for (int m = 0; m < 4; ++m) { const int slot = 32 * G + gl + 8 * m; const int a = __builtin_amdgcn_ds_bpermute(4 * (slot & 63), cq0), b = __builtin_amdgcn_ds_bpermute(4 * (slot & 63), cq1);
                  pk |= ((unsigned)(G < 2 ? a : b) & 0xffu) << (8 * m); } }
            if (lane < 32) PKL[i * 32 + lane] = pk;
            if (lane == 0) { TOKC[i * 8 + 2] = cmax * (1.f / 127.f); TOKC[i * 8 + 3] = (float)csq; }
        }
        {
            const int nit = 4 * ntok;
            int e0 = 0, e1 = 0, en0 = 0, en1 = 0;
            if (ntok > 0) { e0 = eidx[(size_t)t0 * 128 + lane]; e1 = eidx[(size_t)t0 * 128 + 64 + lane]; }
            if (nit > 1) { const int tn = t0 + (1 % ntok) * tstride; en0 = eidx[(size_t)tn * 128 + lane]; en1 = eidx[(size_t)tn * 128 + 64 + lane]; }
            if (nit > 0) {
#pragma unroll
                for (int s_ = 0; s_ < 16; ++s_) { const unsigned e = (unsigned)__builtin_amdgcn_ds_bpermute(g84 + 32 * (s_ & 7), s_ < 8 ? e0 : e1); r[s_] = *(const u32x4*)(EV4 + (e * 512u + pc16)); }
            }
#pragma unroll 1
            for (int n = 0; n < nit; ++n) {
                const int c = n / ntok, i = n - c * ntok;
                const int n1 = n + 1; const bool more = n1 < nit; const int c1 = more ? n1 / ntok : 0;
                const int t = t0 + i * tstride;
                int ef0 = 0, ef1 = 0;
                { const int n2 = n + 2; const int i2 = n2 % ntok; const int tn = t0 + i2 * tstride; ef0 = eidx[(size_t)tn * 128 + lane]; ef1 = eidx[(size_t)tn * 128 + 64 + lane]; }
                const u32x2 xrw = *(const u32x2*)(ap + (size_t)t * D + 256 * c + 4 * lane); const f32x4 xres = {bf_lo(xrw.x), bf_hi(xrw.x), bf_lo(xrw.y), bf_hi(xrw.y)};
                const unsigned noff = (unsigned)c1 * 128u + pc16;
                int acc[32];
#pragma unroll
                for (int k = 0; k < 32; ++k) acc[k] = 0;
#pragma unroll
                for (int G = 0; G < 4; ++G) {
                    const int cp = (int)PKL[i * 32 + 8 * G + g8];
                    unsigned en[4];
#pragma unroll
                    for (int m = 0; m < 4; ++m) { const int s_ = 4 * G + m; en[m] = (unsigned)__builtin_amdgcn_ds_bpermute(g84 + 32 * (s_ & 7), s_ < 8 ? en0 : en1); }
#pragma unroll
                    for (int q = 0; q < 4; ++q) {
                        const unsigned x0 = r[4 * G][q], x1_ = r[4 * G + 1][q], x2 = r[4 * G + 2][q], x3 = r[4 * G + 3][q];
                        const unsigned t0_ = __builtin_amdgcn_perm(x1_, x0, 0x05010400u), t1_ = __builtin_amdgcn_perm(x1_, x0, 0x07030602u);
                        const unsigned t2_ = __builtin_amdgcn_perm(x3, x2, 0x05010400u), t3_ = __builtin_amdgcn_perm(x3, x2, 0x07030602u);
                        unsigned y[4];
                        y[0] = __builtin_amdgcn_perm(t2_, t0_, 0x05040100u); y[1] = __builtin_amdgcn_perm(t2_, t0_, 0x07060302u);
                        y[2] = __builtin_amdgcn_perm(t3_, t1_, 0x05040100u); y[3] = __builtin_amdgcn_perm(t3_, t1_, 0x07060302u);
#pragma unroll
                        for (int cI = 0; cI < 4; ++cI) {
                            acc[8 * q + cI] = __builtin_amdgcn_sdot4((int)(y[cI] & 0x0f0f0f0fu), cp, acc[8 * q + cI], false);
                            acc[8 * q + 4 + cI] = __builtin_amdgcn_sdot4((int)((y[cI] >> 4) & 0x0f0f0f0fu), cp, acc[8 * q + 4 + cI], false);
                        }
                    }
#pragma unroll
                    for (int m = 0; m < 4; ++m) r[4 * G + m] = *(const u32x4*)(EV4 + (en[m] * 512u + noff));
                    __builtin_amdgcn_sched_barrier(0);
                }
#pragma unroll
                for (int k = 0; k < 8; ++k) *(LAS i32x4*)(VIMG + lane * GQ_VROW + 4 * k) = (i32x4){acc[4 * k], acc[4 * k + 1], acc[4 * k + 2], acc[4 * k + 3]};
                i32x4 sm = {0, 0, 0, 0};
#pragma unroll
                for (int gl = 0; gl < 8; ++gl) sm += *(const LAS i32x4*)(VIMG + (8 * gl + (lane >> 3)) * GQ_VROW + 4 * (lane & 7));
                const float csc = TOKC[i * 8 + 2], off = -7.5f * csc * TOKC[i * 8 + 3];
                f32x4 o; o[0] = xres[0] + (float)sm[0] * csc + off; o[1] = xres[1] + (float)sm[1] * csc + off; o[2] = xres[2] + (float)sm[2] * csc + off; o[3] = xres[3] + (float)sm[3] * csc + off;
                *(f32x4*)(out + (size_t)t * D + 256 * c + 4 * lane) = o;
                en0 = ef0; en1 = ef1;
            }
        }
    }
}
#define CE(a, b) do { const float _h = __builtin_fmaxf(a, b), _l = __builtin_fminf(a, b); a = _h; b = _l; } while (0)
#define SORT16(K, B) do { \
    CE(K[(B)+0], K[(B)+1]); CE(K[(B)+2], K[(B)+3]); CE(K[(B)+0], K[(B)+2]); CE(K[(B)+1], K[(B)+3]); \
    CE(K[(B)+1], K[(B)+2]); CE(K[(B)+4], K[(B)+5]); CE(K[(B)+6], K[(B)+7]); CE(K[(B)+4], K[(B)+6]); \
    CE(K[(B)+5], K[(B)+7]); CE(K[(B)+5], K[(B)+6]); CE(K[(B)+0], K[(B)+4]); CE(K[(B)+2], K[(B)+6]); \
    CE(K[(B)+2], K[(B)+4]); CE(K[(B)+1], K[(B)+5]); CE(K[(B)+3], K[(B)+7]); CE(K[(B)+3], K[(B)+5]); \
    CE(K[(B)+1], K[(B)+2]); CE(K[(B)+3], K[(B)+4]); CE(K[(B)+5], K[(B)+6]); CE(K[(B)+8], K[(B)+9]); \
    CE(K[(B)+10], K[(B)+11]); CE(K[(B)+8], K[(B)+10]); CE(K[(B)+9], K[(B)+11]); CE(K[(B)+9], K[(B)+10]); \
    CE(K[(B)+12], K[(B)+13]); CE(K[(B)+14], K[(B)+15]); CE(K[(B)+12], K[(B)+14]); CE(K[(B)+13], K[(B)+15]); \
    CE(K[(B)+13], K[(B)+14]); CE(K[(B)+8], K[(B)+12]); CE(K[(B)+10], K[(B)+14]); CE(K[(B)+10], K[(B)+12]); \
    CE(K[(B)+9], K[(B)+13]); CE(K[(B)+11], K[(B)+15]); CE(K[(B)+11], K[(B)+13]); CE(K[(B)+9], K[(B)+10]); \
    CE(K[(B)+11], K[(B)+12]); CE(K[(B)+13], K[(B)+14]); CE(K[(B)+0], K[(B)+8]); CE(K[(B)+4], K[(B)+12]); \
    CE(K[(B)+4], K[(B)+8]); CE(K[(B)+2], K[(B)+10]); CE(K[(B)+6], K[(B)+14]); CE(K[(B)+6], K[(B)+10]); \
    CE(K[(B)+2], K[(B)+4]); CE(K[(B)+6], K[(B)+8]); CE(K[(B)+10], K[(B)+12]); CE(K[(B)+1], K[(B)+9]); \
    CE(K[(B)+5], K[(B)+13]); CE(K[(B)+5], K[(B)+9]); CE(K[(B)+3], K[(B)+11]); CE(K[(B)+7], K[(B)+15]); \
    CE(K[(B)+7], K[(B)+11]); CE(K[(B)+3], K[(B)+5]); CE(K[(B)+7], K[(B)+9]); CE(K[(B)+11], K[(B)+13]); \
    CE(K[(B)+1], K[(B)+2]); CE(K[(B)+3], K[(B)+4]); CE(K[(B)+5], K[(B)+6]); CE(K[(B)+7], K[(B)+8]); \
    CE(K[(B)+9], K[(B)+10]); CE(K[(B)+11], K[(B)+12]); CE(K[(B)+13], K[(B)+14]); \
} while (0)
#define BMERGE16(K, B) do { \
    CE(K[(B)+0], K[(B)+8]); CE(K[(B)+1], K[(B)+9]); CE(K[(B)+2], K[(B)+10]); CE(K[(B)+3], K[(B)+11]); \
    CE(K[(B)+4], K[(B)+12]); CE(K[(B)+5], K[(B)+13]); CE(K[(B)+6], K[(B)+14]); CE(K[(B)+7], K[(B)+15]); \
    CE(K[(B)+0], K[(B)+4]); CE(K[(B)+1], K[(B)+5]); CE(K[(B)+2], K[(B)+6]); CE(K[(B)+3], K[(B)+7]); \
    CE(K[(B)+8], K[(B)+12]); CE(K[(B)+9], K[(B)+13]); CE(K[(B)+10], K[(B)+14]); CE(K[(B)+11], K[(B)+15]); \
    CE(K[(B)+0], K[(B)+2]); CE(K[(B)+1], K[(B)+3]); CE(K[(B)+4], K[(B)+6]); CE(K[(B)+5], K[(B)+7]); \
    CE(K[(B)+8], K[(B)+10]); CE(K[(B)+9], K[(B)+11]); CE(K[(B)+12], K[(B)+14]); CE(K[(B)+13], K[(B)+15]); \
    CE(K[(B)+0], K[(B)+1]); CE(K[(B)+2], K[(B)+3]); CE(K[(B)+4], K[(B)+5]); CE(K[(B)+6], K[(B)+7]); \
    CE(K[(B)+8], K[(B)+9]); CE(K[(B)+10], K[(B)+11]); CE(K[(B)+12], K[(B)+13]); CE(K[(B)+14], K[(B)+15]); \
} while (0)
typedef short bf16x8s __attribute__((ext_vector_type(8)));
typedef float f32x16 __attribute__((ext_vector_type(16)));
constexpr int TK_LUT_OFF = 0, TK_LDS_END = TK_LUT_OFF + 8 * 8192;
__device__ __forceinline__ void top16_of_64(float (&k)[64]) {
    SORT16(k, 0); SORT16(k, 16); SORT16(k, 32); SORT16(k, 48);
#pragma unroll
    for (int i = 0; i < 16; ++i) { k[i] = __builtin_fmaxf(k[i], k[31 - i]); k[32 + i] = __builtin_fmaxf(k[32 + i], k[63 - i]); }
    BMERGE16(k, 0); BMERGE16(k, 32);
#pragma unroll
    for (int i = 0; i < 16; ++i) k[i] = __builtin_fmaxf(k[i], k[47 - i]);
    BMERGE16(k, 0);
}
__device__ __forceinline__ float ctag(float s, unsigned code) { return __uint_as_float((__float_as_uint(s) & 0xffffff00u) | code); }
__device__ __forceinline__ void topk_load(u32x4 (&w)[8], const bf16_t* __restrict__ srow  ) {
#pragma unroll
    for (int i = 0; i < 8; ++i) w[i] = ((const u32x4*)srow)[i];
}
__device__ __forceinline__ void topk_half(float (&v)[16], u32x4 (&w)[8], const bf16_t* __restrict__ nxt, unsigned hx  ) {
    float k[64];
#pragma unroll
    for (int i = 0; i < 8; ++i)
#pragma unroll
        for (int q = 0; q < 4; ++q) { const unsigned x = w[i][q]; k[8 * i + 2 * q] = __uint_as_float((x << 16) | (unsigned)(8 * i + 2 * q)); k[8 * i + 2 * q + 1] = __uint_as_float((x & 0xffff0000u) | (unsigned)(8 * i + 2 * q + 1)); }
    if (nxt) topk_load(w, nxt);
    top16_of_64(k);
    float r0[16], r1[16];
#pragma unroll
    for (int i = 0; i < 16; ++i) { const unsigned ki = __float_as_uint(k[i]) | hx; const auto rr = __builtin_amdgcn_permlane32_swap(ki, ki, false, false); r0[i] = __uint_as_float(rr[0]); r1[i] = __uint_as_float(rr[1]); }
#pragma unroll
    for (int i = 0; i < 16; ++i) v[i] = __builtin_fmaxf(r0[i], r1[15 - i]);
    BMERGE16(v, 0);
}
__device__ __forceinline__ void topk_task(int tg, int hp, const bf16_t* __restrict__ qv  , LAS unsigned* lut, int* __restrict__ eidx, float* __restrict__ gate, int lane) {
    const int tl = lane & 31, hh = lane >> 5, t = tg * 32 + tl;
    const unsigned hx = (unsigned)hh << 6;
    float v1[16], v2[16];
    {
        const bf16_t* qrow = qv + (size_t)t * NQ + (2 * hp) * 256 + 64 * hh;
        float a[16], b_[16];
        u32x4 wa[8], wb[8];
        topk_load(wa, qrow); topk_load(wb, qrow + 256);
        topk_half(a, wa, qrow + 128, hx);
        __builtin_amdgcn_sched_barrier(0);
        topk_half(b_, wb, qrow + 384, hx);
#pragma unroll
        for (int i = 0; i < 16; ++i) v1[i] = hh ? b_[i] : a[i];
        __builtin_amdgcn_sched_barrier(0);
        topk_half(a, wa, nullptr, hx);
        __builtin_amdgcn_sched_barrier(0);
        topk_half(b_, wb, nullptr, hx);
#pragma unroll
        for (int i = 0; i < 16; ++i) v2[i] = hh ? b_[i] : a[i];
        __builtin_amdgcn_sched_barrier(0);
    }
    const int h = 2 * hp + hh;
    float f1[16], f2[16];
#pragma unroll
    for (int i = 0; i < 16; ++i) {
        const unsigned b1 = __float_as_uint(v1[i]), b2 = __float_as_uint(v2[i]);
        f1[i] = __uint_as_float(b1 & 0xffffff80u); f2[i] = __uint_as_float(b2 & 0xffffff80u);
        lut[i * 64 + lane] = (b1 & 127u) << 7; lut[(16 + i) * 64 + lane] = b2 & 127u;
    }
    float cand[64];
    cand[0] = ctag(f1[0] + f2[0], 255u);
    cand[1] = ctag(f1[0] + f2[1], 254u);
    cand[2] = ctag(f1[0] + f2[2], 253u);
    cand[3] = ctag(f1[0] + f2[3], 252u);
    cand[4] = ctag(f1[0] + f2[4], 251u);
    cand[5] = ctag(f1[0] + f2[5], 250u);
    cand[6] = ctag(f1[0] + f2[6], 249u);
    cand[7] = ctag(f1[0] + f2[7], 248u);
    cand[8] = ctag(f1[0] + f2[8], 247u);
    cand[9] = ctag(f1[0] + f2[9], 246u);
    cand[10] = ctag(f1[0] + f2[10], 245u);
    cand[11] = ctag(f1[0] + f2[11], 244u);
    cand[12] = ctag(f1[0] + f2[12], 243u);
    cand[13] = ctag(f1[0] + f2[13], 242u);
    cand[14] = ctag(f1[0] + f2[14], 241u);
    cand[15] = ctag(f1[0] + f2[15], 240u);
    cand[16] = ctag(f1[1] + f2[0], 239u);
    cand[17] = ctag(f1[1] + f2[1], 238u);
    cand[18] = ctag(f1[1] + f2[2], 237u);
    cand[19] = ctag(f1[1] + f2[3], 236u);
    cand[20] = ctag(f1[1] + f2[4], 235u);
    cand[21] = ctag(f1[1] + f2[5], 234u);
    cand[22] = ctag(f1[1] + f2[6], 233u);
    cand[23] = ctag(f1[1] + f2[7], 232u);
    cand[24] = ctag(f1[2] + f2[0], 223u);
    cand[25] = ctag(f1[2] + f2[1], 222u);
    cand[26] = ctag(f1[2] + f2[2], 221u);
    cand[27] = ctag(f1[2] + f2[3], 220u);
    cand[28] = ctag(f1[2] + f2[4], 219u);
    cand[29] = ctag(f1[3] + f2[0], 207u);
    cand[30] = ctag(f1[3] + f2[1], 206u);
    cand[31] = ctag(f1[3] + f2[2], 205u);
    cand[32] = ctag(f1[3] + f2[3], 204u);
    cand[33] = ctag(f1[4] + f2[0], 191u);
    cand[34] = ctag(f1[4] + f2[1], 190u);
    cand[35] = ctag(f1[4] + f2[2], 189u);
    cand[36] = ctag(f1[5] + f2[0], 175u);
    cand[37] = ctag(f1[5] + f2[1], 174u);
    cand[38] = ctag(f1[6] + f2[0], 159u);
    cand[39] = ctag(f1[6] + f2[1], 158u);
    cand[40] = ctag(f1[7] + f2[0], 143u);
    cand[41] = ctag(f1[7] + f2[1], 142u);
    cand[42] = ctag(f1[8] + f2[0], 127u);
    cand[43] = ctag(f1[9] + f2[0], 111u);
    cand[44] = ctag(f1[10] + f2[0], 95u);
    cand[45] = ctag(f1[11] + f2[0], 79u);
    cand[46] = ctag(f1[12] + f2[0], 63u);
    cand[47] = ctag(f1[13] + f2[0], 47u);
    cand[48] = ctag(f1[14] + f2[0], 31u);
    cand[49] = ctag(f1[15] + f2[0], 15u);
#pragma unroll
    for (int c = 50; c < 64; ++c) cand[c] = -INFINITY;
    top16_of_64(cand);
    float sc[16]; unsigned ex[16];
#pragma unroll
    for (int w = 0; w < 16; ++w) {
        const unsigned b = __float_as_uint(cand[w]), code = 255u - (b & 255u);
        sc[w] = __uint_as_float(b & 0xffffff00u);
        ex[w] = lut[(code >> 4) * 64 + lane] + lut[(16 + (code & 15u)) * 64 + lane];
    }
    float sum = 0.f; const float mx = sc[0];
#pragma unroll
    for (int w = 0; w < 16; ++w) { sc[w] = __expf(sc[w] - mx); sum += sc[w]; }
    const size_t o = ((size_t)t * 8 + h) * 16;
    const float inv = 1.f / sum;
#pragma unroll
    for (int i = 0; i < 4; ++i) { u32x4 w4 = {ex[4 * i], ex[4 * i + 1], ex[4 * i + 2], ex[4 * i + 3]}; *(u32x4*)(eidx + o + 4 * i) = w4; }
#pragma unroll
    for (int i = 0; i < 4; ++i) { f32x4 g4 = {sc[4 * i] * inv, sc[4 * i + 1] * inv, sc[4 * i + 2] * inv, sc[4 * i + 3] * inv}; *(f32x4*)(gate + o + 4 * i) = g4; }
}

typedef short v4i16_t __attribute__((ext_vector_type(4)));
constexpr int AT_K = 0, AT_V = 16384, AT_FK = 32768, AT_BIAS = AT_FK + 2 * 2048, AT_END = AT_BIAS + 4096,
              AT_FL = 73728, AT_DONE = AT_FL + 16, AT_QW = AT_FL + 48;
constexpr float AT_SKIP = 24.f;
__device__ __forceinline__ int crow(int r, int hh) { return (r & 3) + 8 * (r >> 2) + 4 * hh; }

__device__ __forceinline__ float at_max3(float a, float b, float c) { float r; asm("v_max3_f32 %0, %1, %2, %3" : "=v"(r) : "v"(a), "v"(b), "v"(c)); return r; }
__device__ __forceinline__ unsigned at_bf16(float x) { return cvt_pk_bf16(x, 0.f) & 0xffffu; }
__device__ __forceinline__ unsigned at_split3(float x, unsigned& d0) { const unsigned t1 = at_bf16(x); const float r1 = x - __uint_as_float(t1 << 16); const unsigned t2 = at_bf16(r1); const float r2 = r1 - __uint_as_float(t2 << 16); d0 = t1 | (t2 << 16); return at_bf16(r2); }
__device__ __forceinline__ bf16x8s at_mfrag(float m, int hh) { unsigned d0; const unsigned t3 = at_split3(-m, d0); u32x4 w = {0x3f803f80u, 0x3f80u | (d0 << 16), (d0 >> 16) | (t3 << 16), 0u}; if (hh) w = (u32x4){0u, 0u, 0u, 0u}; return __builtin_bit_cast(bf16x8s, w); }
constexpr float AT_THR = 6.f;
template <int MODE  >
__device__ __forceinline__ void attn_step(f32x16 (&o)[2], float& mhat, float& l, const bf16x8s (&qf)[4], const LAS unsigned char* Kt, const LAS unsigned char* Vt, const LAS unsigned char* AKt, bf16x8s& mfr,
                                          const LAS float* biasrow, int qg, int kv0, int lane, bool diag = false  ) {
    const int tl = lane & 31, hh = lane >> 5;
    const LAS unsigned char* kb = Kt + tl * 128; const int ksw = (tl >> 1) & 7;
    bf16x8s kf[2][4];
#pragma unroll
    for (int kvt = 0; kvt < 2; ++kvt)
#pragma unroll
        for (int ks = 0; ks < 4; ++ks) kf[kvt][ks] = *(const LAS bf16x8s*)(kb + kvt * 4096 + (((2 * ks + hh) ^ ksw) * 16));
    bf16x8s af[2];
    if (MODE < 2) {
#pragma unroll
        for (int kvt = 0; kvt < 2; ++kvt) af[kvt] = *(const LAS bf16x8s*)(AKt + (32 * kvt + tl) * 32 + hh * 16);
    } else {
        u32x4 w = {0u, 0x3f800000u, 0x3f803f80u, 0u}; if (hh) w = (u32x4){0u, 0u, 0u, 0u};
        af[0] = __builtin_bit_cast(bf16x8s, w); af[1] = af[0];
    }
    f32x16 p[2];
    const LAS unsigned char* vb = Vt + (4 * hh + ((lane & 15) >> 2)) * 64 + ((lane >> 4) & 1) * 32 + (lane & 3) * 8;
    bf16x8s vf[2][2][2];
#pragma unroll
    for (int kvt = 0; kvt < 2; ++kvt)
#pragma unroll
        for (int s = 0; s < 2; ++s)
#pragma unroll
            for (int d0 = 0; d0 < 2; ++d0) {
                const v4i16_t lo = __builtin_amdgcn_ds_read_tr16_b64_v4i16((LAS v4i16_t*)(vb + d0 * 4096 + kvt * 2048 + s * 1024));
                const v4i16_t hi = __builtin_amdgcn_ds_read_tr16_b64_v4i16((LAS v4i16_t*)(vb + d0 * 4096 + kvt * 2048 + s * 1024 + 512));
                vf[kvt][s][d0] = (bf16x8s){lo[0], lo[1], lo[2], lo[3], hi[0], hi[1], hi[2], hi[3]};
            }
    __builtin_amdgcn_sched_barrier(0);
#pragma unroll
    for (int kvt = 0; kvt < 2; ++kvt) {
        const f32x16 z = {0.f, 0.f, 0.f, 0.f, 0.f, 0.f, 0.f, 0.f, 0.f, 0.f, 0.f, 0.f, 0.f, 0.f, 0.f, 0.f};
        p[kvt] = __builtin_amdgcn_mfma_f32_32x32x16_bf16(af[kvt], mfr, z, 0, 0, 0);
#pragma unroll
        for (int ks = 0; ks < 4; ++ks) p[kvt] = __builtin_amdgcn_mfma_f32_32x32x16_bf16(kf[kvt][ks], qf[ks], p[kvt], 0, 0, 0);
    }
    if (MODE == 1 || (MODE == 0 && diag)) {
#pragma unroll
        for (int kvt = 0; kvt < 2; ++kvt)
#pragma unroll
            for (int r = 0; r < 16; ++r) { const int kv = kv0 + 32 * kvt + crow(r, hh); p[kvt][r] = (kv > qg) ? -INFINITY : p[kvt][r]; }
    }
    if (MODE == 2) {
        const LAS float* bp = biasrow + (191 - qg + kv0 + 4 * hh);
#pragma unroll
        for (int kvt = 0; kvt < 2; ++kvt)
#pragma unroll
            for (int r = 0; r < 16; ++r) {
                p[kvt][r] += bp[32 * kvt + crow(r, 0)];
            }
    }
    float mx = at_max3(p[0][0], p[1][0], p[0][1]), mx2 = at_max3(p[1][1], p[0][2], p[1][2]);
#pragma unroll
    for (int r = 3; r < 15; r += 2) { mx = at_max3(mx, p[0][r], p[1][r]); mx2 = at_max3(mx2, p[0][r + 1], p[1][r + 1]); }
    mx = at_max3(mx, p[0][15], p[1][15]); mx = __builtin_fmaxf(mx, mx2);
    { const auto rr = __builtin_amdgcn_permlane32_swap(__float_as_uint(mx), __float_as_uint(mx), false, false); mx = __builtin_fmaxf(__uint_as_float(rr[0]), __uint_as_float(rr[1])); }
    if (__any(mx > AT_THR)) {
        const float dl = __builtin_fmaxf(mx, 0.f), f = __builtin_amdgcn_exp2f(-dl);
        mhat += dl; l *= f; mfr = at_mfrag(mhat, hh);
#pragma unroll
        for (int kvt = 0; kvt < 2; ++kvt)
#pragma unroll
            for (int r = 0; r < 16; ++r) p[kvt][r] -= dl;
#pragma unroll
        for (int d0 = 0; d0 < 2; ++d0)
#pragma unroll
            for (int r = 0; r < 16; ++r) o[d0][r] *= f;
    }
    float sum = 0.f;
#pragma unroll
    for (int kvt = 0; kvt < 2; ++kvt)
#pragma unroll
        for (int r = 0; r < 16; ++r) { const float e = __builtin_amdgcn_exp2f(p[kvt][r]); p[kvt][r] = e; sum += e; }
    l += sum;
#pragma unroll
    for (int kvt = 0; kvt < 2; ++kvt)
#pragma unroll
        for (int s = 0; s < 2; ++s) {
            u32x4 pw;
#pragma unroll
            for (int i = 0; i < 4; ++i) pw[i] = cvt_pk_bf16(p[kvt][8 * s + 2 * i], p[kvt][8 * s + 2 * i + 1]);
            const bf16x8s pf = __builtin_bit_cast(bf16x8s, pw);
#pragma unroll
            for (int d0 = 0; d0 < 2; ++d0) o[d0] = __builtin_amdgcn_mfma_f32_32x32x16_bf16(vf[kvt][s][d0], pf, o[d0], 0, 0, 0);
        }
}

template <bool FOX>
__device__ __forceinline__ void attn_unit(LAS unsigned char* ldsl, int b, int hk, int qblk, const bf16_t* __restrict__ Q, const bf16_t* __restrict__ K, const bf16_t* __restrict__ V, int kvpitch,
                                          const float* __restrict__ F2, const float* __restrict__ sinks, bf16_t* __restrict__ MIX, int wave, int lane, unsigned serial, float sbound) {
    const int tid = threadIdx.x, tl = lane & 31, hh = lane >> 5;
    const size_t rowbase = (size_t)b * SEQ;
    int head, qw0, t_begin, t_end, wl;
    if (FOX) { head = hk; qw0 = qblk * 256 + 32 * wave; t_begin = 0; t_end = 4 * qblk + 4; wl = 4 * qblk + (wave >> 1); }
    else { head = hk * 4 + (wave >> 1); qw0 = qblk * 64 + 32 * (wave & 1); t_begin = qblk >= 2 ? qblk - 2 : 0; t_end = qblk + 1; wl = t_end; }
    const int qg = qw0 + tl;
    bf16x8s qf[4];
    { const bf16_t* qp = Q + (rowbase + qg) * 512 + head * 64 + 8 * hh;
#pragma unroll
      for (int ks = 0; ks < 4; ++ks) qf[ks] = *(const bf16x8s*)(qp + 16 * ks); }
    const float* Fr = F2 + ((size_t)b * 8 + head) * SEQ;
    float m, l;
    if (FOX) { m = 0.f; l = 0.f; } else { m = sinks[head] * LOG2E; l = hh == 0 ? 1.f : 0.f; }
    bf16x8s mfr = at_mfrag(m, hh);
    f32x16 o[2];
#pragma unroll
    for (int d0 = 0; d0 < 2; ++d0)
#pragma unroll
        for (int r = 0; r < 16; ++r) o[d0][r] = 0.f;
    const int skv = tid >> 3, sc = tid & 7;
    const bf16_t* kg = K + (rowbase + skv) * kvpitch + hk * 64 + sc * 8;
    const bf16_t* vg = V + (rowbase + skv) * kvpitch + hk * 64 + sc * 8;
    const int kwoff = skv * 128 + ((sc ^ ((skv >> 1) & 7)) * 16), vwoff = (sc >> 2) * 4096 + skv * 64 + (sc & 3) * 16;
    u32x4 kA, vA, kB, vB; float fA = 0.f, fB = 0.f;
#define AT_LOAD(t, KR, VR, FR) do { const int tt_ = (t) > t_begin ? (t) : t_begin; KR = *(const u32x4*)(kg + (size_t)tt_ * 64 * kvpitch); VR = *(const u32x4*)(vg + (size_t)tt_ * 64 * kvpitch); if (FOX) FR = Fr[tt_ * 64 + lane]; } while (0)
#define AT_WRITE(buf, KR, VR, FR) do { *(LAS u32x4*)(ldsl + AT_K + (buf) * 8192 + kwoff) = KR; *(LAS u32x4*)(ldsl + AT_V + (buf) * 8192 + vwoff) = VR; if (FOX && tid < 64) { unsigned d0_; const unsigned t3_ = at_split3(-FR, d0_); LAS u32x4* ak_ = (LAS u32x4*)(ldsl + AT_FK + (buf) * 2048 + tid * 32); ak_[0] = (u32x4){d0_, t3_ | 0x3f800000u, 0x3f803f80u, 0u}; ak_[1] = (u32x4){0u, 0u, 0u, 0u}; if (tid == 63) *(LAS float*)(ldsl + AT_FL + (buf) * 4) = -FR; } } while (0)
    AT_LOAD(t_end - 1, kA, vA, fA); AT_LOAD(t_end - 2, kB, vB, fB);
    AT_WRITE(0, kA, vA, fA);
    __syncthreads();
    const LAS float* biasrow = (const LAS float*)(ldsl + AT_BIAS) + head * 128;
#define AT_STEP(KL, VL, FL, KW, VW, FW) do { \
        const int cur = (t_end - 1 - t) & 1; \
        AT_LOAD(t - 2, KL, VL, FL); \
        const LAS unsigned char* Kt = ldsl + AT_K + cur * 8192; const LAS unsigned char* Vt = ldsl + AT_V + cur * 8192; const LAS unsigned char* Fk = ldsl + AT_FK + cur * 2048; \
        if (FOX) { \
            if (!wdone && t < wl) {     \
                const float fl_ = *(const LAS float*)(ldsl + AT_FL + cur * 4); \
                if (sbound + fl_ + wave_max_u(-m) < -AT_SKIP) { wdone = true; if (lane == 0) *(LAS unsigned*)(ldsl + AT_DONE + wave * 4) = serial; } \
            } \
            if (!wdone) { \
                if (t <= wl) attn_step<0>(o, m, l, qf, Kt, Vt, Fk, mfr, biasrow, qg, t * 64, lane, t == wl);     \
            } \
        } else attn_step<2>(o, m, l, qf, Kt, Vt, Fk, mfr, biasrow, qg, t * 64, lane); \
        if (t > t_begin) AT_WRITE(cur ^ 1, KW, VW, FW); \
        __syncthreads(); \
        if (FOX) { const bool d_ = lane < 8 ? (*(const LAS unsigned*)(ldsl + AT_DONE + lane * 4) == serial) : true; bdone = __all(d_); }     \
    } while (0)
    bool wdone = false, bdone = false;
    for (int t = t_end - 1;;) {
        AT_STEP(kA, vA, fA, kB, vB, fB); if (bdone || --t < t_begin) break;
        AT_STEP(kB, vB, fB, kA, vA, fA); if (bdone || --t < t_begin) break;
    }
#undef AT_STEP
#undef AT_LOAD
#undef AT_WRITE
    { const auto rr = __builtin_amdgcn_permlane32_swap(__float_as_uint(l), __float_as_uint(l), false, false); l = __uint_as_float(rr[0]) + __uint_as_float(rr[1]); }
    const float inv = 1.f / l;
    bf16_t* op = MIX + (rowbase + qg) * D + (FOX ? 512 : 0) + head * 64 + 4 * hh;
#pragma unroll
    for (int d0 = 0; d0 < 2; ++d0)
#pragma unroll
        for (int j = 0; j < 4; ++j) {
            u32x2 w; w.x = cvt_pk_bf16(o[d0][4 * j] * inv, o[d0][4 * j + 1] * inv); w.y = cvt_pk_bf16(o[d0][4 * j + 2] * inv, o[d0][4 * j + 3] * inv);
            *(u32x2*)(op + 32 * d0 + 8 * j) = w;
        }
}

constexpr int AT_SWA_V = 0, AT_SWA_K = 32768, AT_SWA_BIAS = 65536;
__device__ __forceinline__ void attn_swa_unit(LAS unsigned char* ldsl, int b, int kvh, int qb, const bf16_t* __restrict__ Q, const bf16_t* __restrict__ K, const bf16_t* __restrict__ V,
                                              const float* __restrict__ sinks, bf16_t* __restrict__ MIX, int wave, int lane) {
    const int tid = threadIdx.x, tl = lane & 31, hh = lane >> 5;
    const size_t rowbase = (size_t)b * SEQ;
    const int q0 = qb * 128, tbase = 2 * qb - 2;
    const int head = kvh * 4 + (wave >> 1);
    const int skv = tid >> 3, sc = tid & 7;
    const int kwoff = skv * 128 + ((sc ^ ((skv >> 1) & 7)) * 16), vwoff = (sc >> 2) * 4096 + skv * 64 + (sc & 3) * 16;
    u32x4 kr[4], vr[4];
#pragma unroll
    for (int sl = 0; sl < 4; ++sl) { const int tt = tbase + sl < 0 ? 0 : tbase + sl; const size_t off = (rowbase + (size_t)tt * 64 + skv) * 128 + kvh * 64 + sc * 8; kr[sl] = *(const u32x4*)(K + off); vr[sl] = *(const u32x4*)(V + off); }
#pragma unroll
    for (int sl = 0; sl < 4; ++sl) { *(LAS u32x4*)(ldsl + AT_SWA_K + sl * 8192 + kwoff) = kr[sl]; *(LAS u32x4*)(ldsl + AT_SWA_V + sl * 8192 + vwoff) = vr[sl]; }
    __syncthreads();
    const LAS float* biasrow = (const LAS float*)(ldsl + AT_SWA_BIAS) + head * 256;
    const float sink2 = sinks[head] * LOG2E;
#pragma unroll 1
    for (int ps = 0; ps < 2; ++ps) {
        const int qg = q0 + 64 * ps + 32 * (wave & 1) + tl;
        bf16x8s qf[4];
        { const bf16_t* qp = Q + (rowbase + qg) * 512 + head * 64 + 8 * hh;
#pragma unroll
          for (int ks = 0; ks < 4; ++ks) qf[ks] = *(const bf16x8s*)(qp + 16 * ks); }
        float m = sink2, l = hh == 0 ? 1.f : 0.f;
        bf16x8s mfr = at_mfrag(m, hh);
        f32x16 o[2];
#pragma unroll
        for (int d0 = 0; d0 < 2; ++d0)
#pragma unroll
            for (int r = 0; r < 16; ++r) o[d0][r] = 0.f;
#pragma unroll 1
        for (int j = 2; j >= 0; --j) {
            const int sl = ps + j, t = tbase + sl;
            if (t >= 0) attn_step<2>(o, m, l, qf, ldsl + AT_SWA_K + sl * 8192, ldsl + AT_SWA_V + sl * 8192, ldsl, mfr, biasrow, qg, t * 64, lane);
        }
        { const auto rr = __builtin_amdgcn_permlane32_swap(__float_as_uint(l), __float_as_uint(l), false, false); l = __uint_as_float(rr[0]) + __uint_as_float(rr[1]); }
        const float inv = 1.f / l;
        bf16_t* op = MIX + (rowbase + qg) * D + head * 64 + 4 * hh;
#pragma unroll
        for (int d0 = 0; d0 < 2; ++d0)
#pragma unroll
            for (int jj = 0; jj < 4; ++jj) {
                u32x2 w; w.x = cvt_pk_bf16(o[d0][4 * jj] * inv, o[d0][4 * jj + 1] * inv); w.y = cvt_pk_bf16(o[d0][4 * jj + 2] * inv, o[d0][4 * jj + 3] * inv);
                *(u32x2*)(op + 32 * d0 + 8 * jj) = w;
            }
    }
    __syncthreads();
}

__device__ __forceinline__ void attn_phase(LAS unsigned char* ldsl, const bf16_t* QA, const bf16_t* KA, const bf16_t* VA, const bf16_t* QB, const bf16_t* KB, const bf16_t* VB,
                                           const float* __restrict__ F2, const float* __restrict__ sinks, const float* __restrict__ relb, const float* __restrict__ gqb, const float* __restrict__ gkb,
                                           bf16_t* MIX, unsigned* qctr  , int G, int wave, int lane) {
    for (int i = threadIdx.x; i < 8 * 256; i += 512) { const int h = i >> 8, dist = 191 - (i & 255); ((LAS float*)(ldsl + AT_SWA_BIAS))[i] = (unsigned)dist < 128u ? relb[(int)T5B[dist & 127] * 8 + h] * LOG2E : -INFINITY; }
    if (threadIdx.x < 8) *(LAS unsigned*)(ldsl + AT_DONE + threadIdx.x * 4) = 0u;
    const float sbound = 64.f * C2 * 1.02f * wave_max_u(fabsf(gqb[lane])) * wave_max_u(fabsf(gkb[lane]));
    __syncthreads();
    unsigned serial = 0;
    for (;;) {
        if (threadIdx.x == 0) *(LAS unsigned*)(ldsl + AT_QW) = __hip_atomic_fetch_add(qctr, 1u, __ATOMIC_RELAXED, __HIP_MEMORY_SCOPE_AGENT);
        __syncthreads();
        const unsigned u = *(const LAS unsigned*)(ldsl + AT_QW);
        __syncthreads();
        if (u >= 768u) break;
        if (u < 512u) { const int bh = (int)(u & 31u), qb = 15 - (int)(u >> 5); ++serial;
            attn_unit<true>(ldsl, bh >> 3, bh & 7, qb, QB, KB, VB, 512, F2, sinks, MIX, wave, lane, serial, sbound); }
        else { const int us = (int)u - 512; attn_swa_unit(ldsl, us >> 6, (us >> 5) & 1, us & 31, QA, KA, VA, sinks, MIX, wave, lane); }
    }
}
#define RLX_AGENT __ATOMIC_RELAXED, __HIP_MEMORY_SCOPE_AGENT
#define XB_TMO      128
#define XB_XCNT(j)  (256  + 64 * (j))
#define XB_XSUB(j)  (1280 + 64 * (j))
#define XB_XGEN(j)  (2304 + 64 * (j))
#define XB_TOP      3328
#define XB_TOPGEN   3392
#define XCD_BAR_WORDS 3456
#define XB_SPIN_CAP (1u << 22)

__device__ __forceinline__ unsigned xb_ld(unsigned* p)              { return __hip_atomic_load(p, __ATOMIC_RELAXED, __HIP_MEMORY_SCOPE_AGENT); }
__device__ __forceinline__ unsigned xb_add(unsigned* p, unsigned v) { return __hip_atomic_fetch_add(p, v, __ATOMIC_RELAXED, __HIP_MEMORY_SCOPE_AGENT); }
__device__ __forceinline__ unsigned xb_xcc_id() { return (unsigned)__builtin_amdgcn_s_getreg((3 << 11) | 20) & 0xFu; }
#define XB_SPIN(cond, bar) do { unsigned _sp = 0; while (cond) { __builtin_amdgcn_s_sleep(1); \
    if ((++_sp & 255u) == 0u) { if (xb_ld(&(bar)[XB_TMO])) break; if (_sp > XB_SPIN_CAP) { atomicAdd(&(bar)[XB_TMO], 1u); break; } } } } while (0)

struct XcdBarrier {
    unsigned* bar; unsigned x;
    volatile LAS unsigned* st;
};

__device__ __forceinline__ XcdBarrier xcd_barrier_post(unsigned* bar, volatile LAS unsigned* st) {
    XcdBarrier b; b.bar = bar; b.x = xb_xcc_id(); b.st = st;
    if (threadIdx.x == 0) (void)xb_add(&bar[XB_XCNT(b.x)], 1u);
    return b;
}
__device__ __forceinline__ void xcd_barrier_complete(unsigned* bar, unsigned x, unsigned& nloc, unsigned& nx) {
    const unsigned G = gridDim.x * gridDim.y * gridDim.z;
    unsigned sum, cnt, mine, sp = 0u;
    for (;;) {
        sum = 0u; cnt = 0u; mine = 0u;
#pragma unroll
        for (unsigned j = 0; j < 16; ++j) { const unsigned c = xb_ld(&bar[XB_XCNT(j)]); sum += c; cnt += (c > 0u) ? 1u : 0u; mine = (j == x) ? c : mine; }
        if (sum == G) break;
        __builtin_amdgcn_s_sleep(1);
        if ((++sp & 255u) == 0u) { if (xb_ld(&bar[XB_TMO])) break; if (sp > XB_SPIN_CAP) { atomicAdd(&bar[XB_TMO], 1u); break; } }
    }
    nloc = mine > 0u ? mine : 1u; nx = cnt > 0u ? cnt : 1u;
}

__device__ __forceinline__ void xcd_barrier(const XcdBarrier& b) {
    asm volatile("s_waitcnt vmcnt(0)" ::: "memory");
    __syncthreads();
    if (threadIdx.x == 0) {
        unsigned* bar = b.bar;
        __builtin_amdgcn_s_waitcnt(0);
        unsigned nloc = b.st[0], nx = b.st[1];
        if (nloc == 0u) { xcd_barrier_complete(bar, b.x, nloc, nx); b.st[0] = nloc; b.st[1] = nx; }
        const unsigned old = xb_add(&bar[XB_XSUB(b.x)], 1u);
        const unsigned gen = old / nloc;
        if (old + 1u == (gen + 1u) * nloc) {
            __builtin_amdgcn_fence(__ATOMIC_RELEASE, "agent");
            asm volatile("s_waitcnt vmcnt(0)" ::: "memory");
            const unsigned og = xb_add(&bar[XB_TOP], 1u);
            const unsigned tg = og / nx;
            if (og + 1u == (tg + 1u) * nx) xb_add(&bar[XB_TOPGEN], 1u);
            else XB_SPIN(xb_ld(&bar[XB_TOPGEN]) == tg, bar);
            __builtin_amdgcn_fence(__ATOMIC_ACQUIRE, "agent");
            xb_add(&bar[XB_XGEN(b.x)], 1u);
            asm volatile("s_waitcnt vmcnt(0)" ::: "memory");
        } else {
            XB_SPIN(xb_ld(&bar[XB_XGEN(b.x)]) == gen, bar);
            __builtin_amdgcn_fence(__ATOMIC_ACQUIRE, "agent");
            asm volatile("s_waitcnt vmcnt(0)" ::: "memory");
        }
    }
    __syncthreads();
}
constexpr int LDS_BYTES = 147456;
struct Params { const float* in[17]; float* out; unsigned char* ws; };

__global__ void __launch_bounds__(512, 2) mega(Params p) {
    extern __shared__ __attribute__((aligned(16))) unsigned char lds[];
    const float* x = p.in[0]; const float* relb = p.in[1]; const float* norm_mix = p.in[2]; const float* w_in = p.in[3];
    const float* gqa = p.in[4]; const float* gka = p.in[5]; const float* gqb = p.in[6]; const float* gkb = p.in[7];
    const float* bforget = p.in[8]; const float* sinks = p.in[9]; const float* w_out = p.in[10]; const float* norm_ffn = p.in[11];
    const float* w_query = p.in[12]; const float* sk1 = p.in[13]; const float* sk2 = p.in[14]; const float* eu = p.in[15]; const float* ev = p.in[16];
    float* out = p.out; unsigned char* ws = p.ws;
    bf16_t* WTIN = (bf16_t*)(ws + WS_WTIN); bf16_t* WTOUT = (bf16_t*)(ws + WS_WTOUT); bf16_t* WTQ = (bf16_t*)(ws + WS_WTQ);
    float* LOGF = (float*)(ws + WS_LOGF); float* F2 = (float*)(ws + WS_F2); float* SSQ = (float*)(ws + WS_SSQ);
    int* EIDX = (int*)(ws + WS_EIDX); float* GATE = (float*)(ws + WS_GATE);
    bf16_t* XN = (bf16_t*)(ws + WS_XN); bf16_t* AP = XN;
    bf16_t* QA = (bf16_t*)(ws + WS_QA); bf16_t* KA = (bf16_t*)(ws + WS_KA); bf16_t* VA = (bf16_t*)(ws + WS_VA);
    bf16_t* QB = (bf16_t*)(ws + WS_QB); bf16_t* KB = (bf16_t*)(ws + WS_KB); bf16_t* VB = (bf16_t*)(ws + WS_VB);
    bf16_t* MIX = (bf16_t*)(ws + WS_MIX); bf16_t* QV = (bf16_t*)(ws + WS_QV);

    unsigned char* EU8 = ws + WS_EU8; unsigned char* EV8 = ws + WS_EV8; float* SU = (float*)(ws + WS_SU); float* SV = (float*)(ws + WS_SV); float* RR = (float*)(ws + WS_RR);
    const int tid = threadIdx.x, lane = tid & 63, wave = __builtin_amdgcn_readfirstlane(tid >> 6);
    const int G = gridDim.x, gw = blockIdx.x * 8 + wave, NGW = G * 8;
    LAS unsigned char* ldsl = (LAS unsigned char*)lds;
    if (tid < 4) ((LAS unsigned*)(ldsl + LDS_BYTES - 16))[tid] = 0u;
    __syncthreads();
    const XcdBarrier xbar = xcd_barrier_post((unsigned*)(ws + WS_CTL), (volatile LAS unsigned*)(ldsl + LDS_BYTES - 16));

    {
        LAS float* scr = (LAS float*)(ldsl + wave * 16384);
        constexpr int I_IN = 16 * (NQKV / 32), I_OUT = 16 * (D / 32), I_Q = 16 * 32 * 4;
        for (int it = gw; it < I_IN + I_OUT + I_Q; it += NGW) {
            int r = it;
            if (r < I_Q) { p0_keyfold_item(w_query, sk1, sk2, norm_ffn, WTQ, r, lane); continue; } r -= I_Q;
            if (r < I_IN) { p0_transpose_item<true, true>(w_in, INW, D, NQKV / 32, WTIN, scr, r, lane, norm_mix); continue; } r -= I_IN;
            p0_transpose_item<false>(w_out, D, D, D / 32, WTOUT, scr, r, lane);
        }
        p0_rows(x, norm_mix, w_in, bforget, XN, RR, LOGF, gw, NGW, lane);
    }
    xcd_barrier(xbar);
    {
        { const int cb = G >= 128 ? (int)blockIdx.x - (G - 32) : (int)blockIdx.x;
          if (cb >= 0 && cb < 32) p1_cumsum(cb, (LAS float*)ldsl, LOGF, F2); }
        pg8::Gemm g{XN, WTIN, M, NQKV, D}; pg8::StaticOrder S; S.init(M, NQKV, G, (int)blockIdx.x);
        EpiQKV E{QA, KA, VA, QB, KB, VB, gqa, gka, gqb, gkb, RR};
        pg8::gemm_phase<EpiQKV, pg8::StaticOrder, true, true>(ldsl, g, S, E);
        { const int nfull = (M / 256) * (NQKV / 256) - 2 * G;
          if (nfull > 0 && nfull < G) { if ((int)blockIdx.x >= nfull) { const int qw = ((int)blockIdx.x - nfull) * 8 + wave, NQW = (G - nfull) * 8; p0_quant4_rows<true>(eu, EU8, SU, qw, NQW, lane); p0_quant4_rows<false>(ev, EV8, SV, qw, NQW, lane); } }
          else { p0_quant4_rows<true>(eu, EU8, SU, gw, NGW, lane); p0_quant4_rows<false>(ev, EV8, SV, gw, NGW, lane); } }
    }
    xcd_barrier(xbar);
    attn_phase(ldsl, QA, KA, VA, QB, KB, VB, F2, sinks, relb, gqb, gkb, MIX, (unsigned*)(ws + WS_CTL) + 3584, G, wave, lane);
    xcd_barrier(xbar);
    {
        pg8::Gemm g{MIX, WTOUT, M, D, D}; pg8::StaticOrder S; S.init(M, D, G, (int)blockIdx.x);
        EpiOut E{AP, SSQ};
        pg8::gemm_phase<EpiOut, pg8::StaticOrder, true, true>(ldsl, g, S, E);
    }
    xcd_barrier(xbar);
    {
        pg8::Gemm g{AP, WTQ, M, NQ, D}; pg8::StaticOrder S; S.init(M, NQ, G, (int)blockIdx.x);
        EpiQV E{QV, SSQ};
        pg8::gemm_phase<EpiQV, pg8::StaticOrder, true, true>(ldsl, g, S, E);
    }
    xcd_barrier(xbar);
    {
        LAS unsigned* lut = (LAS unsigned*)(ldsl + TK_LUT_OFF + wave * 8192);
        for (int task = gw; task < (M / 32) * 4; task += NGW) topk_task(task >> 2, task & 3, QV, lut, EIDX, GATE, lane);
    }
    const bool p6local = NGW == (M / 32) * 4 && NGW * 8 == M;
    if (p6local) { __builtin_amdgcn_fence(__ATOMIC_RELEASE, "workgroup"); __syncthreads(); __builtin_amdgcn_fence(__ATOMIC_ACQUIRE, "workgroup"); }
    else xcd_barrier(xbar);
    { auto gbar = [&]() { xcd_barrier(xbar); };
      const int tfirst = p6local ? 64 * (int)blockIdx.x + 8 * wave : gw, tstep = 8 * NGW, tstride = p6local ? 1 : NGW, ntb = p6local ? 1 : (M + 8 * NGW - 1) / (8 * NGW);
      gather_chunked(AP, SSQ, norm_ffn, EIDX, GATE, EU8, EV8, SU, SV, out, ldsl + wave * GQ_WAVE, tfirst, tstep, tstride, ntb, lane, gbar); }
}
}

extern "C" void kernel_launch(void* const* d_in, const int* in_sizes, int n_in, void* d_out, int out_size, void* d_ws, size_t ws_size, hipStream_t stream) {
    static int grid_blocks = 0;
    if (!grid_blocks) {
        int dev = 0, cus = 0, per_cu = 0;
        (void)hipGetDevice(&dev);
        (void)hipDeviceGetAttribute(&cus, hipDeviceAttributeMultiprocessorCount, dev);
        (void)hipFuncSetAttribute((const void*)mk::mega, hipFuncAttributeMaxDynamicSharedMemorySize, mk::LDS_BYTES);
        (void)hipOccupancyMaxActiveBlocksPerMultiprocessor(&per_cu, (const void*)mk::mega, 512, (size_t)mk::LDS_BYTES);
        if (per_cu < 1) fprintf(stderr, "occupancy query says %d blocks/CU\n", per_cu);
        grid_blocks = cus;
    }
    (void)hipMemsetAsync(d_ws, 0, 16384, stream);
    mk::Params p{};
    for (int i = 0; i < 17; ++i) p.in[i] = (const float*)d_in[i];
    p.out = (float*)d_out; p.ws = (unsigned char*)d_ws;
    void* args[] = {&p};
    hipError_t e = hipLaunchCooperativeKernel((void*)mk::mega, dim3(grid_blocks), dim3(512), args, (size_t)mk::LDS_BYTES, stream);
    if (e != hipSuccess) fprintf(stderr, "cooperative launch failed: %s (grid %d)\n", hipGetErrorString(e), grid_blocks);
}
```

```cpp
#include <hip/hip_runtime.h>
#include <cstdint>
#include <cstdio>
namespace pg8 {
#define PG8_LAS __attribute__((address_space(3)))
typedef unsigned short bf16_t;
typedef short bf16x8 __attribute__((ext_vector_type(8)));
typedef float f32x4 __attribute__((ext_vector_type(4)));
typedef unsigned u32x4 __attribute__((ext_vector_type(4)));
constexpr int BM = 256, BK = 64, HALF = 128, HTB = HALF * BK * 2  , STAGE_BYTES = 8 * HTB, NXCD = 8, WGM = 8;

__host__ __device__ __forceinline__ int lds_byte(int r, int c) { const int st = (r >> 4) * 2 + (c >> 5), rr = r & 15, cc = c & 31, ob = rr * 64 + cc * 2; return st * 1024 + (ob ^ (((ob >> 9) & 1) << 5)); }
__host__ __device__ __forceinline__ void stage_rc(int b, int& R, int& C) { const int st = b / 1024, sb = b % 1024, swz = sb ^ (((sb >> 9) & 1) << 5); R = (st >> 1) * 16 + swz / 64; C = (st & 1) * 32 + (swz % 64) / 2; }
__host__ __device__ __forceinline__ int perm32(int rho) { const int n = rho >> 4, i = rho & 15; return 8 * (i >> 2) + 4 * n + (i & 3); }

struct Unit { int pm, pn; };
struct Gemm { const bf16_t* A; const bf16_t* Bt; int M, N, K; };

struct StaticOrder {
    int nM, nN, nwg, G, c;
    __host__ __device__ void init(int M, int N, int G_, int c_) { nM = M / BM; nN = N / BM; nwg = nM * nN; G = G_; c = c_; }
    __host__ __device__ bool next(int i, Unit& u) const {
        const long L = (long)i * G + c; if (L >= nwg) return false;
        int wgid = (int)L; { const int q = nwg / NXCD, r = nwg % NXCD, xcd = wgid % NXCD, off = wgid / NXCD; wgid = (xcd < r ? xcd * (q + 1) : r * (q + 1) + (xcd - r) * q) + off; }
        const int nig = WGM * nN, gid = wgid / nig, fm = gid * WGM, gsz = (nM - fm) < WGM ? (nM - fm) : WGM;
        u.pm = fm + ((wgid % nig) % gsz); u.pn = (wgid % nig) / gsz; return true;
    }
    __device__ __forceinline__ void a_ready(const Unit&) const {}
    __device__ __forceinline__ void done(const Unit&) const {}
};

__device__ __forceinline__ unsigned cvt_pk_bf16(float lo, float hi) { unsigned r; asm volatile("v_cvt_pk_bf16_f32 %0, %1, %2" : "=v"(r) : "v"(lo), "v"(hi)); return r; }
typedef float f32x2 __attribute__((ext_vector_type(2)));
template <class Epi, class Sched, bool ALIGN_EPI = false, bool SP2 = false>
__device__ __forceinline__ void gemm_phase(PG8_LAS unsigned char* lds, const Gemm g, const Sched& S, const Epi& E) {
    int tid_ = threadIdx.x; asm volatile("" : "+v"(tid_));
    const int tid = tid_, wid = __builtin_amdgcn_readfirstlane(tid >> 6), lane = tid & 63, wr = wid >> 2, wc = wid & 3, fr = lane & 15, fq = lane >> 4;
    const int K = g.K, nt = K / BK;
    unsigned voffA[2], voffB[2];
#pragma unroll
    for (int i = 0; i < 2; ++i) { int R, C; stage_rc(tid * 16 + i * 8192, R, C); const int Rb = Epi::PERM ? ((R & ~31) + perm32(R & 31)) : R;
        voffA[i] = (unsigned)(R * K + C) * 2u; voffB[i] = (unsigned)(Rb * K + C) * 2u; }
    const size_t kstep = (size_t)(BK * 2);
    const size_t hstep = (size_t)HALF * K * 2;
    const size_t tstep = 2 * hstep;
    const unsigned ldsw = (unsigned)wid * 1024u;
    const int aoff = lds_byte(wr * 64 + fr, fq * 8), boff = lds_byte(wc * 32 + fr, fq * 8);
#define PG8_SA(b, h) (((b) * 2 + (h)) * HTB)
#define PG8_SB(b, h) ((4 + (b) * 2 + (h)) * HTB)
#define PG8_STAGE(bufoff, gbase, voff) do { _Pragma("unroll") for (int _i = 0; _i < 2; ++_i) \
        __builtin_amdgcn_global_load_lds((const unsigned*)((const char*)(gbase) + (voff)[_i]), (PG8_LAS unsigned*)(lds + (bufoff) + ldsw + _i * 8192), 16, 0, 0); } while (0)
#define PG8_LDA(dst, b, h) do { _Pragma("unroll") for (int m = 0; m < 4; ++m) _Pragma("unroll") for (int k = 0; k < 2; ++k) dst[m][k] = *(const PG8_LAS bf16x8*)(lds + PG8_SA(b, h) + aoff + m * 2048 + k * 1024); } while (0)
#define PG8_LDB(dst, b, h) do { _Pragma("unroll") for (int n = 0; n < 2; ++n) _Pragma("unroll") for (int k = 0; k < 2; ++k) dst[n][k] = *(const PG8_LAS bf16x8*)(lds + PG8_SB(b, h) + boff + n * 2048 + k * 1024); } while (0)
#define PG8_MMA(ai, bj, At, Bt) do { __builtin_amdgcn_s_setprio(1); _Pragma("unroll") for (int m = 0; m < 4; ++m) _Pragma("unroll") for (int n = 0; n < 2; ++n) _Pragma("unroll") for (int k = 0; k < 2; ++k) \
        acc[ai][bj][m][n] = __builtin_amdgcn_mfma_f32_16x16x32_bf16(Bt[n][k], At[m][k], acc[ai][bj][m][n], 0, 0, 0); __builtin_amdgcn_s_setprio(0); } while (0)
#define PG8_WAIT_V(n) asm volatile("s_waitcnt vmcnt(" #n ")" ::: "memory")
#define PG8_WAIT_L(n) asm volatile("s_waitcnt lgkmcnt(" #n ")" ::: "memory")
#define PG8_BAR __builtin_amdgcn_s_barrier()
#define PG8_SCHED __builtin_amdgcn_sched_barrier(0)
    Unit cur, nxt; int ui = 0;
    if (!S.next(0, cur)) return;
    f32x4 acc[2][2][4][2];
#pragma unroll
    for (int a = 0; a < 2; ++a)
#pragma unroll
        for (int b = 0; b < 2; ++b)
#pragma unroll
            for (int m = 0; m < 4; ++m)
#pragma unroll
                for (int n = 0; n < 2; ++n) acc[a][b][m][n] = (f32x4){0.f, 0.f, 0.f, 0.f};
    bf16x8 At[4][2], B0[2][2], B1[2][2];
    const char* cA = (const char*)g.A + (size_t)cur.pm * tstep; const char* cB = (const char*)g.Bt + (size_t)cur.pn * tstep;
    S.a_ready(cur);
    if constexpr (SP2) {
        PG8_STAGE(PG8_SB(0, 0), cB, voffB); PG8_STAGE(PG8_SB(0, 1), cB + hstep, voffB); PG8_STAGE(PG8_SA(0, 0), cA, voffA); PG8_STAGE(PG8_SA(0, 1), cA + hstep, voffA);
        if (wr == 1) PG8_BAR;
        PG8_WAIT_V(2); PG8_BAR;
        PG8_STAGE(PG8_SB(1, 0), cB + kstep, voffB); PG8_STAGE(PG8_SA(1, 0), cA + kstep, voffA); PG8_STAGE(PG8_SB(1, 1), cB + hstep + kstep, voffB);
        PG8_WAIT_V(6); PG8_BAR;
    } else {
        PG8_STAGE(PG8_SB(0, 0), cB, voffB); PG8_STAGE(PG8_SA(0, 0), cA, voffA); PG8_STAGE(PG8_SB(0, 1), cB + hstep, voffB); PG8_STAGE(PG8_SA(0, 1), cA + hstep, voffA);
        if (wr == 1) PG8_BAR;
        PG8_WAIT_V(4); PG8_BAR;
        PG8_STAGE(PG8_SB(1, 0), cB + kstep, voffB); PG8_STAGE(PG8_SA(1, 0), cA + kstep, voffA); PG8_STAGE(PG8_SB(1, 1), cB + hstep + kstep, voffB);
        PG8_WAIT_V(6); PG8_BAR;
    }
    for (;;) {
        const bool has_next = S.next(ui + 1, nxt);
        const char* nA = has_next ? (const char*)g.A + (size_t)nxt.pm * tstep : cA; const char* nB = has_next ? (const char*)g.Bt + (size_t)nxt.pn * tstep : cB;
        for (int t = 0; t < nt; t += 2) {
            const bool last = (t == nt - 2);
            const char* a1 = cA + (size_t)(t + 1) * kstep;
            const char* a2 = last ? nA : cA + (size_t)(t + 2) * kstep; const char* b2 = last ? nB : cB + (size_t)(t + 2) * kstep;
            const char* a3 = a2 + kstep; const char* b3 = b2 + kstep;
            if (last && has_next) S.a_ready(nxt);
            if constexpr (SP2) {
            PG8_LDB(B0, 0, 0); PG8_LDB(B1, 0, 1); PG8_SCHED; PG8_LDA(At, 0, 0); PG8_STAGE(PG8_SA(1, 1), a1 + hstep, voffA);
            PG8_WAIT_V(8); PG8_WAIT_L(0); PG8_BAR; PG8_MMA(0, 0, At, B0); PG8_MMA(0, 1, At, B1); PG8_BAR; PG8_SCHED;
            PG8_LDA(At, 0, 1); PG8_STAGE(PG8_SB(0, 0), b2, voffB); PG8_STAGE(PG8_SB(0, 1), b2 + hstep, voffB); PG8_STAGE(PG8_SA(0, 0), a2, voffA);
            PG8_WAIT_V(8); PG8_WAIT_L(0); PG8_BAR; PG8_MMA(1, 0, At, B0); PG8_MMA(1, 1, At, B1); PG8_BAR; PG8_SCHED;
            PG8_LDB(B0, 1, 0); PG8_LDB(B1, 1, 1); PG8_SCHED; PG8_LDA(At, 1, 0); PG8_STAGE(PG8_SA(0, 1), a2 + hstep, voffA);
            PG8_WAIT_V(8); PG8_WAIT_L(0); PG8_BAR; PG8_MMA(0, 0, At, B0); PG8_MMA(0, 1, At, B1); PG8_BAR; PG8_SCHED;
            PG8_LDA(At, 1, 1); PG8_STAGE(PG8_SB(1, 0), b3, voffB); PG8_STAGE(PG8_SB(1, 1), b3 + hstep, voffB); PG8_STAGE(PG8_SA(1, 0), a3, voffA);
            PG8_WAIT_V(8); PG8_WAIT_L(0); PG8_BAR; PG8_MMA(1, 0, At, B0); PG8_MMA(1, 1, At, B1); PG8_BAR; PG8_SCHED;
            } else {
            PG8_LDB(B0, 0, 0); PG8_SCHED; PG8_LDA(At, 0, 0); PG8_STAGE(PG8_SA(1, 1), a1 + hstep, voffA);
            PG8_WAIT_L(8); PG8_BAR; PG8_WAIT_L(0); PG8_MMA(0, 0, At, B0); PG8_BAR; PG8_SCHED;
            PG8_LDB(B1, 0, 1); PG8_STAGE(PG8_SB(0, 0), b2, voffB);
            PG8_BAR; PG8_WAIT_L(0); PG8_MMA(0, 1, At, B1); PG8_BAR;
            PG8_LDA(At, 0, 1); PG8_STAGE(PG8_SA(0, 0), a2, voffA);
            PG8_BAR; PG8_WAIT_L(0); PG8_MMA(1, 0, At, B0); PG8_BAR; PG8_SCHED;
            PG8_STAGE(PG8_SB(0, 1), b2 + hstep, voffB);
            PG8_WAIT_V(6); PG8_BAR; PG8_MMA(1, 1, At, B1); PG8_BAR;
            PG8_LDB(B0, 1, 0); PG8_SCHED; PG8_LDA(At, 1, 0); PG8_STAGE(PG8_SA(0, 1), a2 + hstep, voffA);
            PG8_WAIT_L(8); PG8_BAR; PG8_WAIT_L(0); PG8_MMA(0, 0, At, B0); PG8_BAR; PG8_SCHED;
            PG8_LDB(B1, 1, 1); PG8_STAGE(PG8_SB(1, 0), b3, voffB);
            PG8_BAR; PG8_WAIT_L(0); PG8_MMA(0, 1, At, B1); PG8_BAR;
            PG8_LDA(At, 1, 1); PG8_STAGE(PG8_SA(1, 0), a3, voffA);
            PG8_BAR; PG8_WAIT_L(0); PG8_MMA(1, 0, At, B0); PG8_BAR; PG8_SCHED;
            PG8_STAGE(PG8_SB(1, 1), b3 + hstep, voffB);
            PG8_WAIT_V(6); PG8_BAR; PG8_MMA(1, 1, At, B1); PG8_BAR;
            }
        }
        if constexpr (ALIGN_EPI) { if (wr == 0) PG8_BAR; }
        if constexpr (!Epi::AFTER_DRAIN) { E(acc, cur, wr, wc, fr, fq); S.done(cur); }
        if (!has_next) break;
#pragma unroll
        for (int a = 0; a < 2; ++a)
#pragma unroll
            for (int b = 0; b < 2; ++b)
#pragma unroll
                for (int m = 0; m < 4; ++m)
#pragma unroll
                    for (int n = 0; n < 2; ++n) acc[a][b][m][n] = (f32x4){0.f, 0.f, 0.f, 0.f};
        cur = nxt; cA = nA; cB = nB; ++ui;
        if constexpr (ALIGN_EPI) { if (wr == 1) PG8_BAR; }
    }
    PG8_WAIT_V(0);
    if constexpr (!ALIGN_EPI) { if (wr == 0) PG8_BAR; }
    PG8_BAR;
    if constexpr (Epi::AFTER_DRAIN) { E.fused(acc, cur, wr, wc, fr, fq, lds, wid, lane); S.done(cur); }
#undef PG8_SA
#undef PG8_SB
#undef PG8_STAGE
#undef PG8_LDA
#undef PG8_LDB
#undef PG8_MMA
#undef PG8_WAIT_V
#undef PG8_WAIT_L
#undef PG8_BAR
#undef PG8_SCHED
}
}
namespace mk {
using pg8::bf16_t; using pg8::f32x4; using pg8::u32x4; using pg8::Unit; using pg8::cvt_pk_bf16;
typedef unsigned u32x2 __attribute__((ext_vector_type(2)));
#define LAS __attribute__((address_space(3)))
constexpr int D = 1024, BATCH = 4, SEQ = 4096, M = BATCH * SEQ;
constexpr int INW = 2312, NQKV = 2304, NQ = 2048, NEXP = 16384;
constexpr float EPS = 1e-6f, LOG2E = 1.4426950408889634f, C2 = 0.125f * LOG2E;
constexpr size_t MiB = 1u << 20;
constexpr size_t WS_CTL = 0, WS_WTIN = 1 * MiB, WS_WTOUT = 6 * MiB, WS_WTQ = 8 * MiB, WS_SK = 12 * MiB, WS_LOGF = 13 * MiB, WS_F2 = 13 * MiB + 512 * 1024, WS_SSQ = 14 * MiB,
                 WS_EIDX = 16 * MiB, WS_GATE = 24 * MiB, WS_XN = 32 * MiB, WS_QA = 64 * MiB, WS_KA = 80 * MiB, WS_VA = 84 * MiB, WS_QB = 88 * MiB, WS_KB = 104 * MiB, WS_VB = 120 * MiB,
                 WS_MIX = 136 * MiB, WS_QV = 64 * MiB, WS_EU8 = 168 * MiB, WS_EV8 = 184 * MiB, WS_X1 = 192 * MiB, WS_COEF = 136 * MiB, WS_CSUM = 144 * MiB, WS_SU = 15 * MiB, WS_SV = 15 * MiB + 65536, WS_RR = 15 * MiB + 131072;

__device__ __constant__ unsigned char T5B[128] = {0, 1, 2, 3, 4, 5, 6, 7, 8, 9, 10, 11, 12, 13, 14, 15, 16, 16, 16, 17, 17, 18, 18, 18, 19, 19, 19, 20, 20, 20, 20, 21, 21, 21, 21, 22, 22, 22, 22, 22, 23, 23, 23, 23, 23, 23, 24, 24, 24, 24, 24, 24, 25, 25, 25, 25, 25, 25, 25, 26, 26, 26, 26, 26, 26, 26, 26, 27, 27, 27, 27, 27, 27, 27, 27, 27, 27, 28, 28, 28, 28, 28, 28, 28, 28, 28, 28, 29, 29, 29, 29, 29, 29, 29, 29, 29, 29, 29, 29, 30, 30, 30, 30, 30, 30, 30, 30, 30, 30, 30, 30, 30, 30, 31, 31, 31, 31, 31, 31, 31, 31, 31, 31, 31, 31, 31, 31, 31};

__device__ __forceinline__ float wave_sum(float v) {
#pragma unroll
    for (int o = 1; o < 64; o <<= 1) v += __shfl_xor(v, o);
    return v;
}
__device__ __forceinline__ float bf_lo(unsigned w) { return __uint_as_float(w << 16); }
__device__ __forceinline__ float bf_hi(unsigned w) { return __uint_as_float(w & 0xffff0000u); }

struct EpiQKV {
    static constexpr bool PERM = true, AFTER_DRAIN = false;
    bf16_t *QA, *KA, *VA, *QB, *KB, *VB; const float *gqa, *gka, *gqb, *gkb; const float* rr;
    __device__ __forceinline__ void operator()(const f32x4 (&acc)[2][2][4][2], const Unit& u, int wr, int wc, int fr, int fq) const {
        const int s = u.pn * 4 + wc;
        bf16_t* dst; int pitch; const float* g; float sc = 1.f;
        if (s < 8) { dst = QA + 64 * s; pitch = 512; g = gqa; sc = C2; }
        else if (s < 10) { dst = KA + 64 * (s - 8); pitch = 128; g = gka; }
        else if (s < 12) { dst = VA + 64 * (s - 10); pitch = 128; g = nullptr; }
        else if (s < 20) { dst = QB + 64 * (s - 12); pitch = 512; g = gqb; sc = C2; }
        else if (s < 28) { dst = KB + 64 * (s - 20); pitch = 512; g = gkb; }
        else { dst = VB + 64 * (s - 28); pitch = 512; g = nullptr; }
        f32x4 gv[2][2];
#pragma unroll
        for (int bj = 0; bj < 2; ++bj)
#pragma unroll
            for (int n = 0; n < 2; ++n) gv[bj][n] = g ? *(const f32x4*)(g + 32 * bj + 8 * fq + 4 * n) * sc : (f32x4){1.f, 1.f, 1.f, 1.f};
        const int row0 = u.pm * 256 + wr * 64 + fr;
        float rw[2][4];
#pragma unroll
        for (int ai = 0; ai < 2; ++ai)
#pragma unroll
            for (int m = 0; m < 4; ++m) rw[ai][m] = rr[row0 + ai * 128 + m * 16];
#pragma unroll
        for (int ai = 0; ai < 2; ++ai)
#pragma unroll
            for (int m = 0; m < 4; ++m) {
                float ss = 0.f;
#pragma unroll
                for (int bj = 0; bj < 2; ++bj)
#pragma unroll
                    for (int n = 0; n < 2; ++n) { const f32x4 v = acc[ai][bj][m][n]; ss += (v[0] * v[0] + v[1] * v[1]) + (v[2] * v[2] + v[3] * v[3]); }
                ss += __shfl_xor(ss, 16); ss += __shfl_xor(ss, 32);
                const float rx = rw[ai][m]; const float rs = g ? rsqrtf(ss * (rx * rx) * (1.f / 64.f) + EPS) * rx : rx;
                bf16_t* rowp = dst + (size_t)(row0 + ai * 128 + m * 16) * pitch + 8 * fq;
#pragma unroll
                for (int bj = 0; bj < 2; ++bj) {
                    const f32x4 v0 = acc[ai][bj][m][0] * rs * gv[bj][0], v1 = acc[ai][bj][m][1] * rs * gv[bj][1];
                    u32x4 w; w.x = cvt_pk_bf16(v0[0], v0[1]); w.y = cvt_pk_bf16(v0[2], v0[3]); w.z = cvt_pk_bf16(v1[0], v1[1]); w.w = cvt_pk_bf16(v1[2], v1[3]);
                    *(u32x4*)(rowp + 32 * bj) = w;
                }
            }
    }
};
struct EpiOut {
    static constexpr bool PERM = false, AFTER_DRAIN = false;
    bf16_t* ap; float* ssq;
    __device__ __forceinline__ void operator()(const f32x4 (&acc)[2][2][4][2], const Unit& u, int wr, int wc, int fr, int fq) const {
        const int col0 = u.pn * 256 + wc * 32 + 4 * fq;
        const int row0 = u.pm * 256 + wr * 64 + fr;
#pragma unroll
        for (int ai = 0; ai < 2; ++ai) {
            u32x2 xc[4][2][2];
#pragma unroll
            for (int m = 0; m < 4; ++m)
#pragma unroll
                for (int bj = 0; bj < 2; ++bj)
#pragma unroll
                    for (int n = 0; n < 2; ++n) xc[m][bj][n] = *(const u32x2*)(ap + (size_t)(row0 + ai * 128 + m * 16) * D + col0 + bj * 128 + n * 16);
            __builtin_amdgcn_sched_barrier(0);
#pragma unroll
            for (int m = 0; m < 4; ++m) {
                const int row = row0 + ai * 128 + m * 16; const size_t off = (size_t)row * D + col0; float ss = 0.f;
#pragma unroll
                for (int bj = 0; bj < 2; ++bj)
#pragma unroll
                    for (int n = 0; n < 2; ++n) {
                        const size_t o2 = off + bj * 128 + n * 16;
                        const u32x2 xw = xc[m][bj][n]; const f32x4 v = acc[ai][bj][m][n] + (f32x4){bf_lo(xw.x), bf_hi(xw.x), bf_lo(xw.y), bf_hi(xw.y)};
                        ss += (v[0] * v[0] + v[1] * v[1]) + (v[2] * v[2] + v[3] * v[3]);
                        u32x2 w; w.x = cvt_pk_bf16(v[0], v[1]); w.y = cvt_pk_bf16(v[2], v[3]);
                        *(u32x2*)(ap + o2) = w;
                    }
                ss += __shfl_xor(ss, 16); ss += __shfl_xor(ss, 32);
                if (fq == 0) ssq[(size_t)row * 16 + u.pn * 4 + wc] = ss;
            }
        }
    }
};
struct EpiQV {
    static constexpr bool PERM = true, AFTER_DRAIN = false;
    bf16_t* qv; const float* ssq;
    __device__ __forceinline__ void operator()(const f32x4 (&acc)[2][2][4][2], const Unit& u, int wr, int wc, int fr, int fq) const {
        const int row0 = u.pm * 256 + wr * 64 + fr, col0 = u.pn * 256 + wc * 32 + 8 * fq;
#pragma unroll
        for (int ai = 0; ai < 2; ++ai)
#pragma unroll
            for (int m = 0; m < 4; ++m) {
                const int row = row0 + ai * 128 + m * 16;
                const f32x4* sp = (const f32x4*)(ssq + (size_t)row * 16);
                const f32x4 s0 = sp[0], s1 = sp[1], s2 = sp[2], s3 = sp[3];
                const float tot = ((s0[0] + s0[1]) + (s0[2] + s0[3])) + ((s1[0] + s1[1]) + (s1[2] + s1[3])) + ((s2[0] + s2[1]) + (s2[2] + s2[3])) + ((s3[0] + s3[1]) + (s3[2] + s3[3]));
                const float rs = rsqrtf(tot * (1.f / D) + EPS);
                bf16_t* rowp = qv + (size_t)row * NQ + col0;
#pragma unroll
                for (int bj = 0; bj < 2; ++bj) {
                    const f32x4 v0 = acc[ai][bj][m][0] * rs, v1 = acc[ai][bj][m][1] * rs;
                    u32x4 w; w.x = cvt_pk_bf16(v0[0], v0[1]); w.y = cvt_pk_bf16(v0[2], v0[3]); w.z = cvt_pk_bf16(v1[0], v1[1]); w.w = cvt_pk_bf16(v1[2], v1[3]);
                    *(u32x4*)(rowp + 128 * bj) = w;
                }
            }
    }
};

__device__ __forceinline__ int rowmap_in(int n0) { const int s = n0 >> 6, bj = (n0 >> 5) & 1; return 256 * (s >> 2) + 128 * bj + 32 * (s & 3); }
template <bool MAPIN, bool SCALE = false  >
__device__ __forceinline__ void p0_transpose_item(const float* __restrict__ W, int ldw, int K, int nblk, bf16_t* __restrict__ WT, LAS float* scr, int item, int lane, const float* __restrict__ rsc = nullptr) {
    const int kb = item / nblk, nb = item % nblk, k0 = 64 * kb, n0 = 32 * nb;
    const int r0 = MAPIN ? rowmap_in(n0) : n0;
#pragma unroll 8
    for (int i = 0; i < 32; ++i) { const int kk = 2 * i + (lane >> 5); scr[kk * 33 + (lane & 31)] = W[(size_t)(k0 + kk) * ldw + n0 + (lane & 31)] * (SCALE ? rsc[k0 + kk] : 1.f); }
    asm volatile("s_waitcnt lgkmcnt(0)" ::: "memory");
    const int c = lane & 7;
#pragma unroll
    for (int j = 0; j < 4; ++j) { const int n = (lane >> 3) + 8 * j; const LAS float* s = scr + (8 * c) * 33 + n;
        u32x4 o; o.x = cvt_pk_bf16(s[0 * 33], s[1 * 33]); o.y = cvt_pk_bf16(s[2 * 33], s[3 * 33]); o.z = cvt_pk_bf16(s[4 * 33], s[5 * 33]); o.w = cvt_pk_bf16(s[6 * 33], s[7 * 33]);
        *(u32x4*)(WT + (size_t)(r0 + n) * K + k0 + 8 * c) = o; }
    asm volatile("s_waitcnt lgkmcnt(0)" ::: "memory");
}
__device__ __forceinline__ void p0_keyfold_item(const float* __restrict__ wq, const float* __restrict__ sk1, const float* __restrict__ sk2, const float* __restrict__ g, bf16_t* __restrict__ WT, int item, int lane) {
    typedef short bf16x8s_ __attribute__((ext_vector_type(8)));
    typedef float f32x16_ __attribute__((ext_vector_type(16)));
    const int tile = item & 3, k0 = 32 * ((item >> 2) & 31), hh2 = item >> 7, tl = lane & 31, dg = lane >> 5;
    const float* sp = ((hh2 & 1) ? sk2 : sk1) + (size_t)(32 * tile + tl) * 128 + dg * 8;
    const float* wrow = wq + (size_t)(k0 + tl) * NQ + hh2 * 128 + dg * 8;
    const float gk = g[k0 + tl];
    f32x4 a0[8], a1[8], b0[8], b1[8];
#pragma unroll
    for (int ds = 0; ds < 8; ++ds) { b0[ds] = *(const f32x4*)(wrow + ds * 16); b1[ds] = *(const f32x4*)(wrow + ds * 16 + 4); a0[ds] = *(const f32x4*)(sp + ds * 16); a1[ds] = *(const f32x4*)(sp + ds * 16 + 4); }
    f32x16_ acc;
#pragma unroll
    for (int r = 0; r < 16; ++r) acc[r] = 0.f;
#pragma unroll
    for (int ds = 0; ds < 8; ++ds) {
        const f32x4 p0 = b0[ds] * gk, p1 = b1[ds] * gk;
        const u32x4 bw = {cvt_pk_bf16(p0[0], p0[1]), cvt_pk_bf16(p0[2], p0[3]), cvt_pk_bf16(p1[0], p1[1]), cvt_pk_bf16(p1[2], p1[3])};
        const u32x4 aw = {cvt_pk_bf16(a0[ds][0], a0[ds][1]), cvt_pk_bf16(a0[ds][2], a0[ds][3]), cvt_pk_bf16(a1[ds][0], a1[ds][1]), cvt_pk_bf16(a1[ds][2], a1[ds][3])};
        acc = __builtin_amdgcn_mfma_f32_32x32x16_bf16(__builtin_bit_cast(bf16x8s_, aw), __builtin_bit_cast(bf16x8s_, bw), acc, 0, 0, 0);
    }
    const int odd = tl & 1;
#pragma unroll
    for (int r = 0; r < 16; r += 2) {
        const float own0 = acc[r], own1 = acc[r + 1];
        const float recv = __shfl_xor(odd ? own0 : own1, 1);
        const int n = 32 * tile + ((r + odd) & 3) + 8 * ((r + odd) >> 2) + 4 * dg;
        const unsigned w = odd ? cvt_pk_bf16(recv, own1) : cvt_pk_bf16(own0, recv);
        *(unsigned*)(WT + (size_t)(hh2 * 128 + n) * D + k0 + (tl & ~1)) = w;
    }
}
__device__ __forceinline__ void p0_convert(const float* __restrict__ src, bf16_t* __restrict__ dst, size_t n8, int gw, int NGW, int lane) {
    for (size_t i = (size_t)gw * 64 + lane; i < n8; i += (size_t)NGW * 64) {
        const f32x4 a = ((const f32x4*)src)[2 * i], b = ((const f32x4*)src)[2 * i + 1];
        u32x4 w; w.x = cvt_pk_bf16(a[0], a[1]); w.y = cvt_pk_bf16(a[2], a[3]); w.z = cvt_pk_bf16(b[0], b[1]); w.w = cvt_pk_bf16(b[2], b[3]);
        ((u32x4*)dst)[i] = w;
    }
}
__device__ __forceinline__ void p0_rows(const float* __restrict__ x, const float* __restrict__ g, const float* __restrict__ w_in, const float* __restrict__ bforget, bf16_t* __restrict__ XN, float* __restrict__ RR, float* __restrict__ logf, int gw, int NGW, int lane) {
    f32x4 wa[16], wb[16];
#pragma unroll
    for (int jj = 0; jj < 4; ++jj)
#pragma unroll
        for (int e = 0; e < 4; ++e) { const f32x4* wp = (const f32x4*)(w_in + (size_t)(256 * jj + 4 * lane + e) * INW + NQKV); wa[jj * 4 + e] = wp[0]; wb[jj * 4 + e] = wp[1]; }
    const float bl = bforget[lane & 7];
#pragma unroll 1
    for (int rowb = gw; rowb < M; rowb += 4 * NGW) {
        f32x4 v4[4][4];
#pragma unroll
        for (int r = 0; r < 4; ++r) { const int row = rowb + r * NGW < M ? rowb + r * NGW : rowb; const f32x4* xr = (const f32x4*)(x + (size_t)row * D);
#pragma unroll
            for (int jj = 0; jj < 4; ++jj) v4[r][jj] = __builtin_nontemporal_load(xr + lane + 64 * jj); }
#pragma unroll
        for (int r = 0; r < 4; ++r) {
            const int row = rowb + r * NGW;
            if (row < M) {
                float s = 0.f;
#pragma unroll
                for (int jj = 0; jj < 4; ++jj) { const f32x4 v = v4[r][jj]; s += (v[0] * v[0] + v[1] * v[1]) + (v[2] * v[2] + v[3] * v[3]); }
                s = wave_sum(s);
                const float rs = rsqrtf(s * (1.f / D) + EPS);
                f32x4 pa = {0.f, 0.f, 0.f, 0.f}, pb = {0.f, 0.f, 0.f, 0.f};
#pragma unroll
                for (int jj = 0; jj < 4; ++jj) {
                    const f32x4 v = v4[r][jj]; const f32x4 h = v * rs * ((const f32x4*)g)[lane + 64 * jj];
                    u32x2 w; w.x = cvt_pk_bf16(v[0], v[1]); w.y = cvt_pk_bf16(v[2], v[3]);
                    *(u32x2*)(XN + (size_t)row * D + 256 * jj + 4 * lane) = w;
#pragma unroll
                    for (int e = 0; e < 4; ++e) { pa += wa[jj * 4 + e] * h[e]; pb += wb[jj * 4 + e] * h[e]; }
                }
                float z = 0.f;
#pragma unroll
                for (int j = 0; j < 4; ++j) { const float sa = wave_sum(pa[j]), sb = wave_sum(pb[j]); if (lane == j) z = sa; if (lane == 4 + j) z = sb; }
                if (lane == 8) RR[row] = rs;
                if (lane < 8) { z += bl; logf[(size_t)row * 8 + lane] = fminf(z, 0.f) - log1pf(expf(-fabsf(z))); }
            }
        }
    }
}
__device__ __forceinline__ void p1_cumsum(int bh, LAS float* part, const float* __restrict__ logf, float* __restrict__ F2) {
    const int b = bh >> 3, h = bh & 7, tid = threadIdx.x, lane = tid & 63, wv = tid >> 6;
    float v[8]; float s = 0.f;
#pragma unroll
    for (int i = 0; i < 8; ++i) { s += logf[((size_t)b * SEQ + tid * 8 + i) * 8 + h]; v[i] = s; }
    float inc = s;
#pragma unroll
    for (int o = 1; o < 64; o <<= 1) { const float t = __shfl_up(inc, o); if (lane >= o) inc += t; }
    if (lane == 63) part[wv] = inc;
    __syncthreads();
    float base = inc - s;
    for (int w = 0; w < wv; ++w) base += part[w];
#pragma unroll
    for (int i = 0; i < 8; ++i) F2[(size_t)bh * SEQ + tid * 8 + i] = (base + v[i]) * LOG2E;
    __syncthreads();
}
__device__ __forceinline__ float wave_max(float v) {
#pragma unroll
    for (int o = 1; o < 64; o <<= 1) v = fmaxf(v, __shfl_xor(v, o));
    return v;
}
template <int SIGNED  >
__device__ __forceinline__ void p0_quant4_rows(const float* __restrict__ T, unsigned char* __restrict__ T4, float* __restrict__ SC, int gw, int NGW, int lane) {
    for (int row = gw; row < NEXP; row += NGW) {
        const f32x4* tr = (const f32x4*)(T + (size_t)row * D + 16 * lane);
        f32x4 v[4]; float ss = 0.f;
#pragma unroll
        for (int j = 0; j < 4; ++j) { v[j] = __builtin_nontemporal_load(tr + j); ss += (v[j][0] * v[j][0] + v[j][1] * v[j][1]) + (v[j][2] * v[j][2] + v[j][3] * v[j][3]); }
        ss = wave_sum(ss);
        const float s = fmaxf(0.3352f * sqrtf(ss * (1.f / D)), 1e-30f), inv = 1.f / s;
        u32x2 w;
#pragma unroll
        for (int j2 = 0; j2 < 2; ++j2) {
            unsigned p = 0;
#pragma unroll
            for (int e = 0; e < 4; ++e) {
                const int lo = ((int)fminf(fmaxf(floorf(v[2 * j2][e] * inv), -8.f), 7.f) + (SIGNED == 1 ? 0 : 8)) & 15, hi = (int)fminf(fmaxf(floorf(v[2 * j2 + 1][e] * inv), -8.f), 7.f) & 15;
                p |= ((unsigned)lo | ((unsigned)hi << 4)) << (8 * e);
            }
            w[j2] = p;
        }
        *(u32x2*)(T4 + (size_t)row * 512 + 8 * lane) = w;
        if (lane == 0) SC[row] = s;
    }
}

__device__ __forceinline__ int row16_sum_i(int v) {
    v += __builtin_amdgcn_update_dpp(0, v, 0xB1, 0xf, 0xf, false);
    v += __builtin_amdgcn_update_dpp(0, v, 0x4E, 0xf, 0xf, false);
    v += __builtin_amdgcn_update_dpp(0, v, 0x141, 0xf, 0xf, false);
    v += __builtin_amdgcn_update_dpp(0, v, 0x140, 0xf, 0xf, false);
    return v;
}
typedef int i32x4 __attribute__((ext_vector_type(4)));
typedef float f32x2 __attribute__((ext_vector_type(2)));
__device__ __forceinline__ float ub(unsigned w, int k) { return (float)((w >> (8 * k)) & 0xffu); }

constexpr int GQ_DOT = 0, GQ_TOKC = 4096, GQ_PKL = 4352, GQ_UN = 5376, GQ_H2Q = GQ_UN, GQ_UIMG = GQ_UN + 8192, GQ_VIMG = GQ_UN, GQ_WAVE = 17920;
constexpr int GQ_UROW = 68, GQ_VROW = 36;
static_assert(GQ_UIMG + 16 * GQ_UROW * 4 <= GQ_WAVE && GQ_VIMG + 64 * GQ_VROW * 4 <= GQ_WAVE && 8 * GQ_WAVE <= 147440, "gather LDS");
#define GT_DPP(v, ctrl) __uint_as_float((unsigned)__builtin_amdgcn_update_dpp(0, (int)__float_as_uint(v), ctrl, 0xf, 0xf, false))
__device__ __forceinline__ float wave_max_u(float v) {
    v = fmaxf(v, GT_DPP(v, 0xB1)); v = fmaxf(v, GT_DPP(v, 0x4E)); v = fmaxf(v, GT_DPP(v, 0x141)); v = fmaxf(v, GT_DPP(v, 0x140));
    const int iv = (int)__float_as_uint(v);
    const float a = __uint_as_float((unsigned)__builtin_amdgcn_readlane(iv, 0)), b = __uint_as_float((unsigned)__builtin_amdgcn_readlane(iv, 16)), c = __uint_as_float((unsigned)__builtin_amdgcn_readlane(iv, 32)), d = __uint_as_float((unsigned)__builtin_amdgcn_readlane(iv, 48));
    return fmaxf(fmaxf(a, b), fmaxf(c, d));
}
__device__ __forceinline__ int wave_sum_iu(int v) { v = row16_sum_i(v); return (__builtin_amdgcn_readlane(v, 0) + __builtin_amdgcn_readlane(v, 16)) + (__builtin_amdgcn_readlane(v, 32) + __builtin_amdgcn_readlane(v, 48)); }

template <class Bar>
__device__ __forceinline__ void gather_chunked(const bf16_t* __restrict__ ap, const float* __restrict__ ssq, const float* __restrict__ gffn, const int* __restrict__ eidx, const float* __restrict__ gate,
                                               const unsigned char* __restrict__ EU4, const unsigned char* __restrict__ EV4, const float* __restrict__ SU, const float* __restrict__ SV,
                                               float* __restrict__ out, LAS unsigned char* wl, int tfirst, int tstep, int tstride, int ntb  , int lane, const Bar& bar) {
    const int g8 = lane >> 3, pc = lane & 7, g84 = 4 * g8;
    const unsigned pc16 = (unsigned)pc * 16u;
    LAS int* DOT = (LAS int*)(wl + GQ_DOT); LAS float* TOKC = (LAS float*)(wl + GQ_TOKC); LAS unsigned* PKL = (LAS unsigned*)(wl + GQ_PKL);
    LAS unsigned char* H2Q = wl + GQ_H2Q; LAS int* UIMG = (LAS int*)(wl + GQ_UIMG); LAS int* VIMG = (LAS int*)(wl + GQ_VIMG);
#pragma unroll 1
    for (int tb = 0; tb < ntb; ++tb) {
        const int t0 = tfirst + tb * tstep;
        int ntok = 0; if (t0 < M) { ntok = (M - t0 + tstride - 1) / tstride; ntok = ntok > 8 ? 8 : ntok; }
#pragma unroll 1
        for (int i = 0; i < ntok; ++i) {
            const int t = t0 + i * tstride;
            float rs;
            { const f32x4* sp = (const f32x4*)(ssq + (size_t)t * 16); const f32x4 a = sp[0], b = sp[1], c = sp[2], d = sp[3];
              const float tot = ((a[0] + a[1]) + (a[2] + a[3])) + ((b[0] + b[1]) + (b[2] + b[3])) + ((c[0] + c[1]) + (c[2] + c[3])) + ((d[0] + d[1]) + (d[2] + d[3]));
              rs = rsqrtf(tot * (1.f / D) + EPS); }
            const u32x4* hp = (const u32x4*)(ap + (size_t)t * D + 16 * lane); const u32x4 w0 = hp[0], w1 = hp[1];
            float h[16];
#pragma unroll
            for (int k = 0; k < 4; ++k) { h[2 * k] = bf_lo(w0[k]); h[2 * k + 1] = bf_hi(w0[k]); h[8 + 2 * k] = bf_lo(w1[k]); h[8 + 2 * k + 1] = bf_hi(w1[k]); }
#pragma unroll
            for (int k = 0; k < 4; ++k) { const f32x4 gk = ((const f32x4*)(gffn + 16 * lane))[k]; h[4 * k] *= gk[0]; h[4 * k + 1] *= gk[1]; h[4 * k + 2] *= gk[2]; h[4 * k + 3] *= gk[3]; }
            float am = 0.f;
#pragma unroll
            for (int k = 0; k < 16; ++k) am = fmaxf(am, fabsf(h[k]));
            am = wave_max_u(am);
            const float hinv = am > 0.f ? 119.f / am : 0.f;
            u32x4 qw; int hs = 0;
#pragma unroll
            for (int d = 0; d < 2; ++d) { unsigned ph = 0, pl = 0;
#pragma unroll
                for (int k = 0; k < 8; ++k) { const int col = 8 * d + ((k & 1) ? 4 + (k >> 1) : (k >> 1)); const int q = __float2int_rn(h[col] * hinv); hs += q;
                    const int hh_ = (q + 8) >> 4, hl_ = q - 16 * hh_; ph |= ((unsigned)hh_ & 15u) << (4 * k); pl |= ((unsigned)hl_ & 15u) << (4 * k); }
                qw[2 * d] = ph; qw[2 * d + 1] = pl; }
            *(LAS u32x4*)(H2Q + i * 1024 + 16 * lane) = qw;
            hs = wave_sum_iu(hs);
            if (lane == 0) { TOKC[i * 8 + 0] = am * (1.f / 119.f) * rs; TOKC[i * 8 + 1] = (float)hs; }
            DOT[i * 128 + lane] = 0; DOT[i * 128 + 64 + lane] = 0;
        }
        u32x4 r[16];
        {
            const int nit = 4 * ntok;
            int e0 = 0, e1 = 0, en0 = 0, en1 = 0;
            if (ntok > 0) { e0 = eidx[(size_t)t0 * 128 + lane]; e1 = eidx[(size_t)t0 * 128 + 64 + lane]; }
            if (nit > 1) { const int tn = t0 + (1 % ntok) * tstride; en0 = eidx[(size_t)tn * 128 + lane]; en1 = eidx[(size_t)tn * 128 + 64 + lane]; }
            if (nit > 0) {
#pragma unroll
                for (int s_ = 0; s_ < 16; ++s_) { const unsigned e = (unsigned)__builtin_amdgcn_ds_bpermute(g84 + 32 * (s_ & 7), s_ < 8 ? e0 : e1); r[s_] = *(const u32x4*)(EU4 + (e * 512u + pc16)); }
            }
#pragma unroll 1
            for (int n = 0; n < nit; ++n) {
                const int c = n / ntok, i = n - c * ntok;
                const int n1 = n + 1; const bool more = n1 < nit; const int c1 = more ? n1 / ntok : 0;
                int ef0 = 0, ef1 = 0;
                { const int n2 = n + 2; const int i2 = n2 % ntok; const int tn = t0 + i2 * tstride; ef0 = eidx[(size_t)tn * 128 + lane]; ef1 = eidx[(size_t)tn * 128 + 64 + lane]; }
                int hq[8];
                { const LAS i32x4* hp = (const LAS i32x4*)(H2Q + i * 1024 + 256 * c + 32 * pc); const i32x4 a = hp[0], b = hp[1];
                  hq[0] = a[0]; hq[1] = a[1]; hq[2] = a[2]; hq[3] = a[3]; hq[4] = b[0]; hq[5] = b[1]; hq[6] = b[2]; hq[7] = b[3]; }
                const unsigned noff = (unsigned)c1 * 128u + pc16;
                unsigned enx = (unsigned)__builtin_amdgcn_ds_bpermute(g84, en0);
#pragma unroll
                for (int s_ = 0; s_ < 16; ++s_) {
                    const unsigned ecur = enx;
                    if (s_ + 1 < 16) enx = (unsigned)__builtin_amdgcn_ds_bpermute(g84 + 32 * ((s_ + 1) & 7), (s_ + 1) < 8 ? en0 : en1);
                    int ah, al;
                    { const int w = (int)r[s_][0]; asm("v_dot8_i32_i4 %0, %1, %2, 0" : "=v"(ah) : "v"(w), "v"(hq[0])); asm("v_dot8_i32_i4 %0, %1, %2, 0" : "=v"(al) : "v"(w), "v"(hq[1])); }
#pragma unroll
                    for (int q = 1; q < 4; ++q) { const int w = (int)r[s_][q]; ah = __builtin_amdgcn_sdot8(w, hq[2 * q], ah, false); al = __builtin_amdgcn_sdot8(w, hq[2 * q + 1], al, false); }
                    UIMG[s_ * GQ_UROW + lane] = 16 * ah + al;
                    r[s_] = *(const u32x4*)(EU4 + (ecur * 512u + noff));
                    __builtin_amdgcn_sched_barrier(0);
                }
                { const LAS int* rp = UIMG + (lane >> 3) * GQ_UROW + 8 * (lane & 7);
                  const i32x4 a0 = *(const LAS i32x4*)(rp), a1 = *(const LAS i32x4*)(rp + 4), b0 = *(const LAS i32x4*)(rp + 8 * GQ_UROW), b1 = *(const LAS i32x4*)(rp + 8 * GQ_UROW + 4);
                  DOT[i * 128 + lane] += ((a0[0] + a0[1]) + (a0[2] + a0[3])) + ((a1[0] + a1[1]) + (a1[2] + a1[3]));
                  DOT[i * 128 + 64 + lane] += ((b0[0] + b0[1]) + (b0[2] + b0[3])) + ((b1[0] + b1[1]) + (b1[2] + b1[3])); }
                en0 = ef0; en1 = ef1;
            }
        }
#pragma unroll 1
        for (int i = 0; i < ntok; ++i) {
            const int t = t0 + i * tstride;
            const int e0 = eidx[(size_t)t * 128 + lane], e1 = eidx[(size_t)t * 128 + 64 + lane];
            const float g0 = gate[(size_t)t * 128 + lane], g1 = gate[(size_t)t * 128 + 64 + lane];
            const float su0 = SU[e0], su1 = SU[e1], sv0 = SV[e0], sv1 = SV[e1];
            const float sh = TOKC[i * 8 + 0], hoff = 0.5f * TOKC[i * 8 + 1];
            const float p0 = ((float)DOT[i * 128 + lane] + hoff) * su0 * sh, p1 = ((float)DOT[i * 128 + 64 + lane] + hoff) * su1 * sh;
            const float c0 = g0 * 0.5f * p0 * (1.f + erff(p0 * 0.70710678118654752f)) * sv0, c1 = g1 * 0.5f * p1 * (1.f + erff(p1 * 0.70710678118654752f)) * sv1;
            const float cmax = wave_max_u(fmaxf(fabsf(c0), fabsf(c1)));
            const float cinv = cmax > 0.f ? 127.f / cmax : 0.f;
            const int cq0 = __float2int_rn(c0 * cinv), cq1 = __float2int_rn(c1 * cinv);
            const int csq = wave_sum_iu(cq0 + cq1);
            unsigned pk = 0;
            { const int G = (lane >> 3) & 3, gl = lane & 7;
#pragma unroll
              for (int m = 0; m < 4; ++m) { const int slot = 32 * G + gl + 8 * m; const int a = __builtin_amdgcn_ds_bpermute(4 * (slot & 63), cq0), b = __builtin_amdgcn_ds_bpermute(4 * (slot & 63), cq1);
                  pk |= ((unsigned)(G < 2 ? a : b) & 0xffu) << (8 * m); } }
            if (lane < 32) PKL[i * 32 + lane] = pk;
            if (lane == 0) { TOKC[i * 8 + 2] = cmax * (1.f / 127.f); TOKC[i * 8 + 3] = (float)csq; }
        }
        {
            const int nit = 4 * ntok;
            int e0 = 0, e1 = 0, en0 = 0, en1 = 0;
            if (ntok > 0) { e0 = eidx[(size_t)t0 * 128 + lane]; e1 = eidx[(size_t)t0 * 128 + 64 + lane]; }
            if (nit > 1) { const int tn = t0 + (1 % ntok) * tstride; en0 = eidx[(size_t)tn * 128 + lane]; en1 = eidx[(size_t)tn * 128 + 64 + lane]; }
            if (nit > 0) {
#pragma unroll
                for (int s_ = 0; s_ < 16; ++s_) { const unsigned e = (unsigned)__builtin_amdgcn_ds_bpermute(g84 + 32 * (s_ & 7), s_ < 8 ? e0 : e1); r[s_] = *(const u32x4*)(EV4 + (e * 512u + pc16)); }
            }
#pragma unroll 1
            for (int n = 0; n < nit; ++n) {
                const int c = n / ntok, i = n - c * ntok;
                const int n1 = n + 1; const bool more = n1 < nit; const int c1 = more ? n1 / ntok : 0;
                const int t = t0 + i * tstride;
                int ef0 = 0, ef1 = 0;
                { const int n2 = n + 2; const int i2 = n2 % ntok; const int tn = t0 + i2 * tstride; ef0 = eidx[(size_t)tn * 128 + lane]; ef1 = eidx[(size_t)tn * 128 + 64 + lane]; }
                const u32x2 xrw = *(const u32x2*)(ap + (size_t)t * D + 256 * c + 4 * lane); const f32x4 xres = {bf_lo(xrw.x), bf_hi(xrw.x), bf_lo(xrw.y), bf_hi(xrw.y)};
                const unsigned noff = (unsigned)c1 * 128u + pc16;
                int accl[16], accf[16];
#pragma unroll
                for (int G = 0; G < 4; ++G) {
                    const int cp = (int)PKL[i * 32 + 8 * G + g8];
                    unsigned en[4];
#pragma unroll
                    for (int m = 0; m < 4; ++m) { const int s_ = 4 * G + m; en[m] = (unsigned)__builtin_amdgcn_ds_bpermute(g84 + 32 * (s_ & 7), s_ < 8 ? en0 : en1); }
#pragma unroll
                    for (int q = 0; q < 4; ++q) {
                        const unsigned x0 = r[4 * G][q], x1_ = r[4 * G + 1][q], x2 = r[4 * G + 2][q], x3 = r[4 * G + 3][q];
                        const unsigned t0_ = __builtin_amdgcn_perm(x1_, x0, 0x05010400u), t1_ = __builtin_amdgcn_perm(x1_, x0, 0x07030602u);
                        const unsigned t2_ = __builtin_amdgcn_perm(x3, x2, 0x05010400u), t3_ = __builtin_amdgcn_perm(x3, x2, 0x07030602u);
                        unsigned y[4];
                        y[0] = __builtin_amdgcn_perm(t2_, t0_, 0x05040100u); y[1] = __builtin_amdgcn_perm(t2_, t0_, 0x07060302u);
                        y[2] = __builtin_amdgcn_perm(t3_, t1_, 0x05040100u); y[3] = __builtin_amdgcn_perm(t3_, t1_, 0x07060302u);
#pragma unroll
                        for (int cI = 0; cI < 4; ++cI) {
                            const int yl = (int)(y[cI] & 0x0f0f0f0fu), yf = (int)y[cI];
                            if (G == 0) { asm("v_dot4_i32_i8 %0, %1, %2, 0" : "=v"(accl[4 * q + cI]) : "v"(yl), "v"(cp)); asm("v_dot4_i32_i8 %0, %1, %2, 0" : "=v"(accf[4 * q + cI]) : "v"(yf), "v"(cp)); }
                            else { accl[4 * q + cI] = __builtin_amdgcn_sdot4(yl, cp, accl[4 * q + cI], false); accf[4 * q + cI] = __builtin_amdgcn_sdot4(yf, cp, accf[4 * q + cI], false); }
                        }
                    }
#pragma unroll
                    for (int m = 0; m < 4; ++m) r[4 * G + m] = *(const u32x4*)(EV4 + (en[m] * 512u + noff));
                    __builtin_amdgcn_sched_barrier(0);
                }
#pragma unroll
                for (int q = 0; q < 4; ++q) {
                    *(LAS i32x4*)(VIMG + lane * GQ_VROW + 8 * q) = (i32x4){accl[4 * q], accl[4 * q + 1], accl[4 * q + 2], accl[4 * q + 3]};
                    *(LAS i32x4*)(VIMG + lane * GQ_VROW + 8 * q + 4) = (i32x4){accf[4 * q] - accl[4 * q], accf[4 * q + 1] - accl[4 * q + 1], accf[4 * q + 2] - accl[4 * q + 2], accf[4 * q + 3] - accl[4 * q + 3]};
                }
                i32x4 sm = {0, 0, 0, 0};
#pragma unroll
                for (int gl = 0; gl < 8; ++gl) sm += *(const LAS i32x4*)(VIMG + (8 * gl + (lane >> 3)) * GQ_VROW + 4 * (lane & 7));
                const float csc0 = TOKC[i * 8 + 2], csc = (lane & 1) ? csc0 * 0.0625f : csc0, off = ((lane & 1) ? 0.5f : -7.5f) * csc0 * TOKC[i * 8 + 3];
                f32x4 o; o[0] = xres[0] + (float)sm[0] * csc + off; o[1] = xres[1] + (float)sm[1] * csc + off; o[2] = xres[2] + (float)sm[2] * csc + off; o[3] = xres[3] + (float)sm[3] * csc + off;
                *(f32x4*)(out + (size_t)t * D + 256 * c + 4 * lane) = o;
                en0 = ef0; en1 = ef1;
            }
        }
    }
}
#define CE(a, b) do { const float _h = __builtin_fmaxf(a, b), _l = __builtin_fminf(a, b); a = _h; b = _l; } while (0)
#define SORT16(K, B) do { \
    CE(K[(B)+0], K[(B)+1]); CE(K[(B)+2], K[(B)+3]); CE(K[(B)+0], K[(B)+2]); CE(K[(B)+1], K[(B)+3]); \
    CE(K[(B)+1], K[(B)+2]); CE(K[(B)+4], K[(B)+5]); CE(K[(B)+6], K[(B)+7]); CE(K[(B)+4], K[(B)+6]); \
    CE(K[(B)+5], K[(B)+7]); CE(K[(B)+5], K[(B)+6]); CE(K[(B)+0], K[(B)+4]); CE(K[(B)+2], K[(B)+6]); \
    CE(K[(B)+2], K[(B)+4]); CE(K[(B)+1], K[(B)+5]); CE(K[(B)+3], K[(B)+7]); CE(K[(B)+3], K[(B)+5]); \
    CE(K[(B)+1], K[(B)+2]); CE(K[(B)+3], K[(B)+4]); CE(K[(B)+5], K[(B)+6]); CE(K[(B)+8], K[(B)+9]); \
    CE(K[(B)+10], K[(B)+11]); CE(K[(B)+8], K[(B)+10]); CE(K[(B)+9], K[(B)+11]); CE(K[(B)+9], K[(B)+10]); \
    CE(K[(B)+12], K[(B)+13]); CE(K[(B)+14], K[(B)+15]); CE(K[(B)+12], K[(B)+14]); CE(K[(B)+13], K[(B)+15]); \
    CE(K[(B)+13], K[(B)+14]); CE(K[(B)+8], K[(B)+12]); CE(K[(B)+10], K[(B)+14]); CE(K[(B)+10], K[(B)+12]); \
    CE(K[(B)+9], K[(B)+13]); CE(K[(B)+11], K[(B)+15]); CE(K[(B)+11], K[(B)+13]); CE(K[(B)+9], K[(B)+10]); \
    CE(K[(B)+11], K[(B)+12]); CE(K[(B)+13], K[(B)+14]); CE(K[(B)+0], K[(B)+8]); CE(K[(B)+4], K[(B)+12]); \
    CE(K[(B)+4], K[(B)+8]); CE(K[(B)+2], K[(B)+10]); CE(K[(B)+6], K[(B)+14]); CE(K[(B)+6], K[(B)+10]); \
    CE(K[(B)+2], K[(B)+4]); CE(K[(B)+6], K[(B)+8]); CE(K[(B)+10], K[(B)+12]); CE(K[(B)+1], K[(B)+9]); \
    CE(K[(B)+5], K[(B)+13]); CE(K[(B)+5], K[(B)+9]); CE(K[(B)+3], K[(B)+11]); CE(K[(B)+7], K[(B)+15]); \
    CE(K[(B)+7], K[(B)+11]); CE(K[(B)+3], K[(B)+5]); CE(K[(B)+7], K[(B)+9]); CE(K[(B)+11], K[(B)+13]); \
    CE(K[(B)+1], K[(B)+2]); CE(K[(B)+3], K[(B)+4]); CE(K[(B)+5], K[(B)+6]); CE(K[(B)+7], K[(B)+8]); \
    CE(K[(B)+9], K[(B)+10]); CE(K[(B)+11], K[(B)+12]); CE(K[(B)+13], K[(B)+14]); \
} while (0)
#define BMERGE16(K, B) do { \
    CE(K[(B)+0], K[(B)+8]); CE(K[(B)+1], K[(B)+9]); CE(K[(B)+2], K[(B)+10]); CE(K[(B)+3], K[(B)+11]); \
    CE(K[(B)+4], K[(B)+12]); CE(K[(B)+5], K[(B)+13]); CE(K[(B)+6], K[(B)+14]); CE(K[(B)+7], K[(B)+15]); \
    CE(K[(B)+0], K[(B)+4]); CE(K[(B)+1], K[(B)+5]); CE(K[(B)+2], K[(B)+6]); CE(K[(B)+3], K[(B)+7]); \
    CE(K[(B)+8], K[(B)+12]); CE(K[(B)+9], K[(B)+13]); CE(K[(B)+10], K[(B)+14]); CE(K[(B)+11], K[(B)+15]); \
    CE(K[(B)+0], K[(B)+2]); CE(K[(B)+1], K[(B)+3]); CE(K[(B)+4], K[(B)+6]); CE(K[(B)+5], K[(B)+7]); \
    CE(K[(B)+8], K[(B)+10]); CE(K[(B)+9], K[(B)+11]); CE(K[(B)+12], K[(B)+14]); CE(K[(B)+13], K[(B)+15]); \
    CE(K[(B)+0], K[(B)+1]); CE(K[(B)+2], K[(B)+3]); CE(K[(B)+4], K[(B)+5]); CE(K[(B)+6], K[(B)+7]); \
    CE(K[(B)+8], K[(B)+9]); CE(K[(B)+10], K[(B)+11]); CE(K[(B)+12], K[(B)+13]); CE(K[(B)+14], K[(B)+15]); \
} while (0)
typedef short bf16x8s __attribute__((ext_vector_type(8)));
typedef float f32x16 __attribute__((ext_vector_type(16)));
constexpr int TK_LUT_OFF = 0, TK_LDS_END = TK_LUT_OFF + 8 * 8192;
__device__ __forceinline__ void top16_of_64(float (&k)[64]) {
    SORT16(k, 0); SORT16(k, 16); SORT16(k, 32); SORT16(k, 48);
#pragma unroll
    for (int i = 0; i < 16; ++i) { k[i] = __builtin_fmaxf(k[i], k[31 - i]); k[32 + i] = __builtin_fmaxf(k[32 + i], k[63 - i]); }
    BMERGE16(k, 0); BMERGE16(k, 32);
#pragma unroll
    for (int i = 0; i < 16; ++i) k[i] = __builtin_fmaxf(k[i], k[47 - i]);
    BMERGE16(k, 0);
}
__device__ __forceinline__ float ctag(float s, unsigned code) { return __uint_as_float((__float_as_uint(s) & 0xffffff00u) | code); }
__device__ __forceinline__ void topk_load(u32x4 (&w)[8], const bf16_t* __restrict__ srow  ) {
#pragma unroll
    for (int i = 0; i < 8; ++i) w[i] = ((const u32x4*)srow)[i];
}
__device__ __forceinline__ void topk_half(float (&v)[16], u32x4 (&w)[8], const bf16_t* __restrict__ nxt, unsigned hx  ) {
    float k[64];
#pragma unroll
    for (int i = 0; i < 8; ++i)
#pragma unroll
        for (int q = 0; q < 4; ++q) { const unsigned x = w[i][q]; k[8 * i + 2 * q] = __uint_as_float((x << 16) | (unsigned)(8 * i + 2 * q)); k[8 * i + 2 * q + 1] = __uint_as_float((x & 0xffff0000u) | (unsigned)(8 * i + 2 * q + 1)); }
    if (nxt) topk_load(w, nxt);
    top16_of_64(k);
    float r0[16], r1[16];
#pragma unroll
    for (int i = 0; i < 16; ++i) { const unsigned ki = __float_as_uint(k[i]) | hx; const auto rr = __builtin_amdgcn_permlane32_swap(ki, ki, false, false); r0[i] = __uint_as_float(rr[0]); r1[i] = __uint_as_float(rr[1]); }
#pragma unroll
    for (int i = 0; i < 16; ++i) v[i] = __builtin_fmaxf(r0[i], r1[15 - i]);
    BMERGE16(v, 0);
}
__device__ __forceinline__ void topk_task(int tg, int hp, const bf16_t* __restrict__ qv  , LAS unsigned* lut, int* __restrict__ eidx, float* __restrict__ gate, int lane) {
    const int tl = lane & 31, hh = lane >> 5, t = tg * 32 + tl;
    const unsigned hx = (unsigned)hh << 6;
    float v1[16], v2[16];
    {
        const bf16_t* qrow = qv + (size_t)t * NQ + (2 * hp) * 256 + 64 * hh;
        float a[16], b_[16];
        u32x4 wa[8], wb[8];
        topk_load(wa, qrow); topk_load(wb, qrow + 256);
        topk_half(a, wa, qrow + 128, hx);
        __builtin_amdgcn_sched_barrier(0);
        topk_half(b_, wb, qrow + 384, hx);
#pragma unroll
        for (int i = 0; i < 16; ++i) v1[i] = hh ? b_[i] : a[i];
        __builtin_amdgcn_sched_barrier(0);
        topk_half(a, wa, nullptr, hx);
        __builtin_amdgcn_sched_barrier(0);
        topk_half(b_, wb, nullptr, hx);
#pragma unroll
        for (int i = 0; i < 16; ++i) v2[i] = hh ? b_[i] : a[i];
        __builtin_amdgcn_sched_barrier(0);
    }
    const int h = 2 * hp + hh;
    float f1[16], f2[16];
#pragma unroll
    for (int i = 0; i < 16; ++i) {
        const unsigned b1 = __float_as_uint(v1[i]), b2 = __float_as_uint(v2[i]);
        f1[i] = __uint_as_float(b1 & 0xffffff80u); f2[i] = __uint_as_float(b2 & 0xffffff80u);
        lut[i * 64 + lane] = (b1 & 127u) << 7; lut[(16 + i) * 64 + lane] = b2 & 127u;
    }
    float cand[64];
    cand[0] = ctag(f1[0] + f2[0], 255u);
    cand[1] = ctag(f1[0] + f2[1], 254u);
    cand[2] = ctag(f1[0] + f2[2], 253u);
    cand[3] = ctag(f1[0] + f2[3], 252u);
    cand[4] = ctag(f1[0] + f2[4], 251u);
    cand[5] = ctag(f1[0] + f2[5], 250u);
    cand[6] = ctag(f1[0] + f2[6], 249u);
    cand[7] = ctag(f1[0] + f2[7], 248u);
    cand[8] = ctag(f1[0] + f2[8], 247u);
    cand[9] = ctag(f1[0] + f2[9], 246u);
    cand[10] = ctag(f1[0] + f2[10], 245u);
    cand[11] = ctag(f1[0] + f2[11], 244u);
    cand[12] = ctag(f1[0] + f2[12], 243u);
    cand[13] = ctag(f1[0] + f2[13], 242u);
    cand[14] = ctag(f1[0] + f2[14], 241u);
    cand[15] = ctag(f1[0] + f2[15], 240u);
    cand[16] = ctag(f1[1] + f2[0], 239u);
    cand[17] = ctag(f1[1] + f2[1], 238u);
    cand[18] = ctag(f1[1] + f2[2], 237u);
    cand[19] = ctag(f1[1] + f2[3], 236u);
    cand[20] = ctag(f1[1] + f2[4], 235u);
    cand[21] = ctag(f1[1] + f2[5], 234u);
    cand[22] = ctag(f1[1] + f2[6], 233u);
    cand[23] = ctag(f1[1] + f2[7], 232u);
    cand[24] = ctag(f1[2] + f2[0], 223u);
    cand[25] = ctag(f1[2] + f2[1], 222u);
    cand[26] = ctag(f1[2] + f2[2], 221u);
    cand[27] = ctag(f1[2] + f2[3], 220u);
    cand[28] = ctag(f1[2] + f2[4], 219u);
    cand[29] = ctag(f1[3] + f2[0], 207u);
    cand[30] = ctag(f1[3] + f2[1], 206u);
    cand[31] = ctag(f1[3] + f2[2], 205u);
    cand[32] = ctag(f1[3] + f2[3], 204u);
    cand[33] = ctag(f1[4] + f2[0], 191u);
    cand[34] = ctag(f1[4] + f2[1], 190u);
    cand[35] = ctag(f1[4] + f2[2], 189u);
    cand[36] = ctag(f1[5] + f2[0], 175u);
    cand[37] = ctag(f1[5] + f2[1], 174u);
    cand[38] = ctag(f1[6] + f2[0], 159u);
    cand[39] = ctag(f1[6] + f2[1], 158u);
    cand[40] = ctag(f1[7] + f2[0], 143u);
    cand[41] = ctag(f1[7] + f2[1], 142u);
    cand[42] = ctag(f1[8] + f2[0], 127u);
    cand[43] = ctag(f1[9] + f2[0], 111u);
    cand[44] = ctag(f1[10] + f2[0], 95u);
    cand[45] = ctag(f1[11] + f2[0], 79u);
    cand[46] = ctag(f1[12] + f2[0], 63u);
    cand[47] = ctag(f1[13] + f2[0], 47u);
    cand[48] = ctag(f1[14] + f2[0], 31u);
    cand[49] = ctag(f1[15] + f2[0], 15u);
#pragma unroll
    for (int c = 50; c < 64; ++c) cand[c] = -INFINITY;
    top16_of_64(cand);
    float sc[16]; unsigned ex[16];
#pragma unroll
    for (int w = 0; w < 16; ++w) {
        const unsigned b = __float_as_uint(cand[w]), code = 255u - (b & 255u);
        sc[w] = __uint_as_float(b & 0xffffff00u);
        ex[w] = lut[(code >> 4) * 64 + lane] + lut[(16 + (code & 15u)) * 64 + lane];
    }
    float sum = 0.f; const float mx = sc[0];
#pragma unroll
    for (int w = 0; w < 16; ++w) { sc[w] = __expf(sc[w] - mx); sum += sc[w]; }
    const size_t o = ((size_t)t * 8 + h) * 16;
    const float inv = 1.f / sum;
#pragma unroll
    for (int i = 0; i < 4; ++i) { u32x4 w4 = {ex[4 * i], ex[4 * i + 1], ex[4 * i + 2], ex[4 * i + 3]}; *(u32x4*)(eidx + o + 4 * i) = w4; }
#pragma unroll
    for (int i = 0; i < 4; ++i) { f32x4 g4 = {sc[4 * i] * inv, sc[4 * i + 1] * inv, sc[4 * i + 2] * inv, sc[4 * i + 3] * inv}; *(f32x4*)(gate + o + 4 * i) = g4; }
}

typedef short v4i16_t __attribute__((ext_vector_type(4)));
constexpr int AT_K = 0, AT_V = 16384, AT_FK = 32768, AT_BIAS = AT_FK + 2 * 2048, AT_END = AT_BIAS + 4096,
              AT_FL = 73728, AT_DONE = AT_FL + 16, AT_QW = AT_FL + 48;
constexpr float AT_SKIP = 24.f;
__device__ __forceinline__ int crow(int r, int hh) { return (r & 3) + 8 * (r >> 2) + 4 * hh; }

__device__ __forceinline__ float at_max3(float a, float b, float c) { float r; asm("v_max3_f32 %0, %1, %2, %3" : "=v"(r) : "v"(a), "v"(b), "v"(c)); return r; }
__device__ __forceinline__ unsigned at_bf16(float x) { return cvt_pk_bf16(x, 0.f) & 0xffffu; }
__device__ __forceinline__ unsigned at_split3(float x, unsigned& d0) { const unsigned t1 = at_bf16(x); const float r1 = x - __uint_as_float(t1 << 16); const unsigned t2 = at_bf16(r1); const float r2 = r1 - __uint_as_float(t2 << 16); d0 = t1 | (t2 << 16); return at_bf16(r2); }
__device__ __forceinline__ bf16x8s at_mfrag(float m, int hh) { unsigned d0; const unsigned t3 = at_split3(-m, d0); u32x4 w = {0x3f803f80u, 0x3f80u | (d0 << 16), (d0 >> 16) | (t3 << 16), 0u}; if (hh) w = (u32x4){0u, 0u, 0u, 0u}; return __builtin_bit_cast(bf16x8s, w); }
constexpr float AT_THR = 6.f;
template <int MODE  >
__device__ __forceinline__ void attn_step(f32x16 (&o)[2], float& mhat, float& l, const bf16x8s (&qf)[4], const LAS unsigned char* Kt, const LAS unsigned char* Vt, const LAS unsigned char* AKt, bf16x8s& mfr,
                                          const LAS float* biasrow, int qg, int kv0, int lane, bool diag = false  ) {
    const int tl = lane & 31, hh = lane >> 5;
    const LAS unsigned char* kb = Kt + tl * 128; const int ksw = (tl >> 1) & 7;
    bf16x8s kf[2][4];
#pragma unroll
    for (int kvt = 0; kvt < 2; ++kvt)
#pragma unroll
        for (int ks = 0; ks < 4; ++ks) kf[kvt][ks] = *(const LAS bf16x8s*)(kb + kvt * 4096 + (((2 * ks + hh) ^ ksw) * 16));
    bf16x8s af[2];
    if (MODE < 2) {
#pragma unroll
        for (int kvt = 0; kvt < 2; ++kvt) af[kvt] = *(const LAS bf16x8s*)(AKt + (32 * kvt + tl) * 32 + hh * 16);
    } else {
        u32x4 w = {0u, 0x3f800000u, 0x3f803f80u, 0u}; if (hh) w = (u32x4){0u, 0u, 0u, 0u};
        af[0] = __builtin_bit_cast(bf16x8s, w); af[1] = af[0];
    }
    f32x16 p[2];
    const LAS unsigned char* vb = Vt + (4 * hh + ((lane & 15) >> 2)) * 64 + ((lane >> 4) & 1) * 32 + (lane & 3) * 8;
    bf16x8s vf[2][2][2];
#pragma unroll
    for (int kvt = 0; kvt < 2; ++kvt)
#pragma unroll
        for (int s = 0; s < 2; ++s)
#pragma unroll
            for (int d0 = 0; d0 < 2; ++d0) {
                const v4i16_t lo = __builtin_amdgcn_ds_read_tr16_b64_v4i16((LAS v4i16_t*)(vb + d0 * 4096 + kvt * 2048 + s * 1024));
                const v4i16_t hi = __builtin_amdgcn_ds_read_tr16_b64_v4i16((LAS v4i16_t*)(vb + d0 * 4096 + kvt * 2048 + s * 1024 + 512));
                vf[kvt][s][d0] = (bf16x8s){lo[0], lo[1], lo[2], lo[3], hi[0], hi[1], hi[2], hi[3]};
            }
    __builtin_amdgcn_sched_barrier(0);
#pragma unroll
    for (int kvt = 0; kvt < 2; ++kvt) {
        const f32x16 z = {0.f, 0.f, 0.f, 0.f, 0.f, 0.f, 0.f, 0.f, 0.f, 0.f, 0.f, 0.f, 0.f, 0.f, 0.f, 0.f};
        p[kvt] = __builtin_amdgcn_mfma_f32_32x32x16_bf16(af[kvt], mfr, z, 0, 0, 0);
#pragma unroll
        for (int ks = 0; ks < 4; ++ks) p[kvt] = __builtin_amdgcn_mfma_f32_32x32x16_bf16(kf[kvt][ks], qf[ks], p[kvt], 0, 0, 0);
    }
    if (MODE == 1 || (MODE == 0 && diag)) {
#pragma unroll
        for (int kvt = 0; kvt < 2; ++kvt)
#pragma unroll
            for (int r = 0; r < 16; ++r) { const int kv = kv0 + 32 * kvt + crow(r, hh); p[kvt][r] = (kv > qg) ? -INFINITY : p[kvt][r]; }
    }
    if (MODE == 2) {
        const LAS float* bp = biasrow + (191 - qg + kv0 + 4 * hh);
#pragma unroll
        for (int kvt = 0; kvt < 2; ++kvt)
#pragma unroll
            for (int r = 0; r < 16; ++r) {
                p[kvt][r] += bp[32 * kvt + crow(r, 0)];
            }
    }
    float mx = at_max3(p[0][0], p[1][0], p[0][1]), mx2 = at_max3(p[1][1], p[0][2], p[1][2]);
#pragma unroll
    for (int r = 3; r < 15; r += 2) { mx = at_max3(mx, p[0][r], p[1][r]); mx2 = at_max3(mx2, p[0][r + 1], p[1][r + 1]); }
    mx = at_max3(mx, p[0][15], p[1][15]); mx = __builtin_fmaxf(mx, mx2);
    { const auto rr = __builtin_amdgcn_permlane32_swap(__float_as_uint(mx), __float_as_uint(mx), false, false); mx = __builtin_fmaxf(__uint_as_float(rr[0]), __uint_as_float(rr[1])); }
    if (__any(mx > AT_THR)) {
        const float dl = __builtin_fmaxf(mx, 0.f), f = __builtin_amdgcn_exp2f(-dl);
        mhat += dl; l *= f; mfr = at_mfrag(mhat, hh);
#pragma unroll
        for (int kvt = 0; kvt < 2; ++kvt)
#pragma unroll
            for (int r = 0; r < 16; ++r) p[kvt][r] -= dl;
#pragma unroll
        for (int d0 = 0; d0 < 2; ++d0)
#pragma unroll
            for (int r = 0; r < 16; ++r) o[d0][r] *= f;
    }
    float sum = 0.f;
#pragma unroll
    for (int kvt = 0; kvt < 2; ++kvt)
#pragma unroll
        for (int r = 0; r < 16; ++r) { const float e = __builtin_amdgcn_exp2f(p[kvt][r]); p[kvt][r] = e; sum += e; }
    l += sum;
#pragma unroll
    for (int kvt = 0; kvt < 2; ++kvt)
#pragma unroll
        for (int s = 0; s < 2; ++s) {
            u32x4 pw;
#pragma unroll
            for (int i = 0; i < 4; ++i) pw[i] = cvt_pk_bf16(p[kvt][8 * s + 2 * i], p[kvt][8 * s + 2 * i + 1]);
            const bf16x8s pf = __builtin_bit_cast(bf16x8s, pw);
#pragma unroll
            for (int d0 = 0; d0 < 2; ++d0) o[d0] = __builtin_amdgcn_mfma_f32_32x32x16_bf16(vf[kvt][s][d0], pf, o[d0], 0, 0, 0);
        }
}

template <bool FOX>
__device__ __forceinline__ void attn_unit(LAS unsigned char* ldsl, int b, int hk, int qblk, const bf16_t* __restrict__ Q, const bf16_t* __restrict__ K, const bf16_t* __restrict__ V, int kvpitch,
                                          const float* __restrict__ F2, const float* __restrict__ sinks, bf16_t* __restrict__ MIX, int wave, int lane, unsigned serial, float sbound) {
    const int tid = threadIdx.x, tl = lane & 31, hh = lane >> 5;
    const size_t rowbase = (size_t)b * SEQ;
    int head, qw0, t_begin, t_end, wl;
    if (FOX) { head = hk; qw0 = qblk * 256 + 32 * wave; t_begin = 0; t_end = 4 * qblk + 4; wl = 4 * qblk + (wave >> 1); }
    else { head = hk * 4 + (wave >> 1); qw0 = qblk * 64 + 32 * (wave & 1); t_begin = qblk >= 2 ? qblk - 2 : 0; t_end = qblk + 1; wl = t_end; }
    const int qg = qw0 + tl;
    bf16x8s qf[4];
    { const bf16_t* qp = Q + (rowbase + qg) * 512 + head * 64 + 8 * hh;
#pragma unroll
      for (int ks = 0; ks < 4; ++ks) qf[ks] = *(const bf16x8s*)(qp + 16 * ks); }
    const float* Fr = F2 + ((size_t)b * 8 + head) * SEQ;
    float m, l;
    if (FOX) { m = 0.f; l = 0.f; } else { m = sinks[head] * LOG2E; l = hh == 0 ? 1.f : 0.f; }
    bf16x8s mfr = at_mfrag(m, hh);
    f32x16 o[2];
#pragma unroll
    for (int d0 = 0; d0 < 2; ++d0)
#pragma unroll
        for (int r = 0; r < 16; ++r) o[d0][r] = 0.f;
    const int skv = tid >> 3, sc = tid & 7;
    const bf16_t* kg = K + (rowbase + skv) * kvpitch + hk * 64 + sc * 8;
    const bf16_t* vg = V + (rowbase + skv) * kvpitch + hk * 64 + sc * 8;
    const int kwoff = skv * 128 + ((sc ^ ((skv >> 1) & 7)) * 16), vwoff = (sc >> 2) * 4096 + skv * 64 + (sc & 3) * 16;
    u32x4 kA, vA, kB, vB; float fA = 0.f, fB = 0.f;
#define AT_LOAD(t, KR, VR, FR) do { const int tt_ = (t) > t_begin ? (t) : t_begin; KR = *(const u32x4*)(kg + (size_t)tt_ * 64 * kvpitch); VR = *(const u32x4*)(vg + (size_t)tt_ * 64 * kvpitch); if (FOX) FR = Fr[tt_ * 64 + lane]; } while (0)
#define AT_WRITE(buf, KR, VR, FR) do { *(LAS u32x4*)(ldsl + AT_K + (buf) * 8192 + kwoff) = KR; *(LAS u32x4*)(ldsl + AT_V + (buf) * 8192 + vwoff) = VR; if (FOX && tid < 64) { unsigned d0_; const unsigned t3_ = at_split3(-FR, d0_); LAS u32x4* ak_ = (LAS u32x4*)(ldsl + AT_FK + (buf) * 2048 + tid * 32); ak_[0] = (u32x4){d0_, t3_ | 0x3f800000u, 0x3f803f80u, 0u}; ak_[1] = (u32x4){0u, 0u, 0u, 0u}; if (tid == 63) *(LAS float*)(ldsl + AT_FL + (buf) * 4) = -FR; } } while (0)
    AT_LOAD(t_end - 1, kA, vA, fA); AT_LOAD(t_end - 2, kB, vB, fB);
    AT_WRITE(0, kA, vA, fA);
    __syncthreads();
    const LAS float* biasrow = (const LAS float*)(ldsl + AT_BIAS) + head * 128;
#define AT_STEP(KL, VL, FL, KW, VW, FW) do { \
        const int cur = (t_end - 1 - t) & 1; \
        AT_LOAD(t - 2, KL, VL, FL); \
        const LAS unsigned char* Kt = ldsl + AT_K + cur * 8192; const LAS unsigned char* Vt = ldsl + AT_V + cur * 8192; const LAS unsigned char* Fk = ldsl + AT_FK + cur * 2048; \
        if (FOX) { \
            if (!wdone && t < wl) {     \
                const float fl_ = *(const LAS float*)(ldsl + AT_FL + cur * 4); \
                if (sbound + fl_ + wave_max_u(-m) < -AT_SKIP) { wdone = true; if (lane == 0) *(LAS unsigned*)(ldsl + AT_DONE + wave * 4) = serial; } \
            } \
            if (!wdone) { \
                if (t <= wl) attn_step<0>(o, m, l, qf, Kt, Vt, Fk, mfr, biasrow, qg, t * 64, lane, t == wl);     \
            } \
        } else attn_step<2>(o, m, l, qf, Kt, Vt, Fk, mfr, biasrow, qg, t * 64, lane); \
        if (t > t_begin) AT_WRITE(cur ^ 1, KW, VW, FW); \
        __syncthreads(); \
        if (FOX) { const bool d_ = lane < 8 ? (*(const LAS unsigned*)(ldsl + AT_DONE + lane * 4) == serial) : true; bdone = __all(d_); }     \
    } while (0)
    bool wdone = false, bdone = false;
    for (int t = t_end - 1;;) {
        AT_STEP(kA, vA, fA, kB, vB, fB); if (bdone || --t < t_begin) break;
        AT_STEP(kB, vB, fB, kA, vA, fA); if (bdone || --t < t_begin) break;
    }
#undef AT_STEP
#undef AT_LOAD
#undef AT_WRITE
    { const auto rr = __builtin_amdgcn_permlane32_swap(__float_as_uint(l), __float_as_uint(l), false, false); l = __uint_as_float(rr[0]) + __uint_as_float(rr[1]); }
    const float inv = 1.f / l;
    bf16_t* op = MIX + (rowbase + qg) * D + (FOX ? 512 : 0) + head * 64 + 4 * hh;
#pragma unroll
    for (int d0 = 0; d0 < 2; ++d0)
#pragma unroll
        for (int j = 0; j < 4; ++j) {
            u32x2 w; w.x = cvt_pk_bf16(o[d0][4 * j] * inv, o[d0][4 * j + 1] * inv); w.y = cvt_pk_bf16(o[d0][4 * j + 2] * inv, o[d0][4 * j + 3] * inv);
            *(u32x2*)(op + 32 * d0 + 8 * j) = w;
        }
}

constexpr int AT_SWA_V = 0, AT_SWA_K = 32768, AT_SWA_BIAS = 65536;
__device__ __forceinline__ void attn_swa_unit(LAS unsigned char* ldsl, int b, int kvh, int qb, const bf16_t* __restrict__ Q, const bf16_t* __restrict__ K, const bf16_t* __restrict__ V,
                                              const float* __restrict__ sinks, bf16_t* __restrict__ MIX, int wave, int lane) {
    const int tid = threadIdx.x, tl = lane & 31, hh = lane >> 5;
    const size_t rowbase = (size_t)b * SEQ;
    const int q0 = qb * 128, tbase = 2 * qb - 2;
    const int head = kvh * 4 + (wave >> 1);
    const int skv = tid >> 3, sc = tid & 7;
    const int kwoff = skv * 128 + ((sc ^ ((skv >> 1) & 7)) * 16), vwoff = (sc >> 2) * 4096 + skv * 64 + (sc & 3) * 16;
    u32x4 kr[4], vr[4];
#pragma unroll
    for (int sl = 0; sl < 4; ++sl) { const int tt = tbase + sl < 0 ? 0 : tbase + sl; const size_t off = (rowbase + (size_t)tt * 64 + skv) * 128 + kvh * 64 + sc * 8; kr[sl] = *(const u32x4*)(K + off); vr[sl] = *(const u32x4*)(V + off); }
#pragma unroll
    for (int sl = 0; sl < 4; ++sl) { *(LAS u32x4*)(ldsl + AT_SWA_K + sl * 8192 + kwoff) = kr[sl]; *(LAS u32x4*)(ldsl + AT_SWA_V + sl * 8192 + vwoff) = vr[sl]; }
    __syncthreads();
    const LAS float* biasrow = (const LAS float*)(ldsl + AT_SWA_BIAS) + head * 256;
    const float sink2 = sinks[head] * LOG2E;
#pragma unroll 1
    for (int ps = 0; ps < 2; ++ps) {
        const int qg = q0 + 64 * ps + 32 * (wave & 1) + tl;
        bf16x8s qf[4];
        { const bf16_t* qp = Q + (rowbase + qg) * 512 + head * 64 + 8 * hh;
#pragma unroll
          for (int ks = 0; ks < 4; ++ks) qf[ks] = *(const bf16x8s*)(qp + 16 * ks); }
        float m = sink2, l = hh == 0 ? 1.f : 0.f;
        bf16x8s mfr = at_mfrag(m, hh);
        f32x16 o[2];
#pragma unroll
        for (int d0 = 0; d0 < 2; ++d0)
#pragma unroll
            for (int r = 0; r < 16; ++r) o[d0][r] = 0.f;
#pragma unroll 1
        for (int j = 2; j >= 0; --j) {
            const int sl = ps + j, t = tbase + sl;
            if (t >= 0) attn_step<2>(o, m, l, qf, ldsl + AT_SWA_K + sl * 8192, ldsl + AT_SWA_V + sl * 8192, ldsl, mfr, biasrow, qg, t * 64, lane);
        }
        { const auto rr = __builtin_amdgcn_permlane32_swap(__float_as_uint(l), __float_as_uint(l), false, false); l = __uint_as_float(rr[0]) + __uint_as_float(rr[1]); }
        const float inv = 1.f / l;
        bf16_t* op = MIX + (rowbase + qg) * D + head * 64 + 4 * hh;
#pragma unroll
        for (int d0 = 0; d0 < 2; ++d0)
#pragma unroll
            for (int jj = 0; jj < 4; ++jj) {
                u32x2 w; w.x = cvt_pk_bf16(o[d0][4 * jj] * inv, o[d0][4 * jj + 1] * inv); w.y = cvt_pk_bf16(o[d0][4 * jj + 2] * inv, o[d0][4 * jj + 3] * inv);
                *(u32x2*)(op + 32 * d0 + 8 * jj) = w;
            }
    }
    __syncthreads();
}

__device__ __forceinline__ void attn_phase(LAS unsigned char* ldsl, const bf16_t* QA, const bf16_t* KA, const bf16_t* VA, const bf16_t* QB, const bf16_t* KB, const bf16_t* VB,
                                           const float* __restrict__ F2, const float* __restrict__ sinks, const float* __restrict__ relb, const float* __restrict__ gqb, const float* __restrict__ gkb,
                                           bf16_t* MIX, unsigned* qctr  , int G, int wave, int lane) {
    for (int i = threadIdx.x; i < 8 * 256; i += 512) { const int h = i >> 8, dist = 191 - (i & 255); ((LAS float*)(ldsl + AT_SWA_BIAS))[i] = (unsigned)dist < 128u ? relb[(int)T5B[dist & 127] * 8 + h] * LOG2E : -INFINITY; }
    if (threadIdx.x < 8) *(LAS unsigned*)(ldsl + AT_DONE + threadIdx.x * 4) = 0u;
    const float sbound = 64.f * C2 * 1.02f * wave_max_u(fabsf(gqb[lane])) * wave_max_u(fabsf(gkb[lane]));
    __syncthreads();
    unsigned serial = 0;
    for (;;) {
        if (threadIdx.x == 0) *(LAS unsigned*)(ldsl + AT_QW) = __hip_atomic_fetch_add(qctr, 1u, __ATOMIC_RELAXED, __HIP_MEMORY_SCOPE_AGENT);
        __syncthreads();
        const unsigned u = *(const LAS unsigned*)(ldsl + AT_QW);
        __syncthreads();
        if (u >= 768u) break;
        if (u < 512u) { const int bh = (int)(u & 31u), qb = 15 - (int)(u >> 5); ++serial;
            attn_unit<true>(ldsl, bh >> 3, bh & 7, qb, QB, KB, VB, 512, F2, sinks, MIX, wave, lane, serial, sbound); }
        else { const int us = (int)u - 512; attn_swa_unit(ldsl, us >> 6, (us >> 5) & 1, us & 31, QA, KA, VA, sinks, MIX, wave, lane); }
    }
}
#define RLX_AGENT __ATOMIC_RELAXED, __HIP_MEMORY_SCOPE_AGENT
#define XB_TMO      128
#define XB_XCNT(j)  (256  + 64 * (j))
#define XB_XSUB(j)  (1280 + 64 * (j))
#define XB_XGEN(j)  (2304 + 64 * (j))
#define XB_TOP      3328
#define XB_TOPGEN   3392
#define XCD_BAR_WORDS 3456
#define XB_SPIN_CAP (1u << 22)

__device__ __forceinline__ unsigned xb_ld(unsigned* p)              { return __hip_atomic_load(p, __ATOMIC_RELAXED, __HIP_MEMORY_SCOPE_AGENT); }
__device__ __forceinline__ unsigned xb_add(unsigned* p, unsigned v) { return __hip_atomic_fetch_add(p, v, __ATOMIC_RELAXED, __HIP_MEMORY_SCOPE_AGENT); }
__device__ __forceinline__ unsigned xb_xcc_id() { return (unsigned)__builtin_amdgcn_s_getreg((3 << 11) | 20) & 0xFu; }
#define XB_SPIN(cond, bar) do { unsigned _sp = 0; while (cond) { __builtin_amdgcn_s_sleep(1); \
    if ((++_sp & 255u) == 0u) { if (xb_ld(&(bar)[XB_TMO])) break; if (_sp > XB_SPIN_CAP) { atomicAdd(&(bar)[XB_TMO], 1u); break; } } } } while (0)

struct XcdBarrier {
    unsigned* bar; unsigned x;
    volatile LAS unsigned* st;
};

__device__ __forceinline__ XcdBarrier xcd_barrier_post(unsigned* bar, volatile LAS unsigned* st) {
    XcdBarrier b; b.bar = bar; b.x = xb_xcc_id(); b.st = st;
    if (threadIdx.x == 0) (void)xb_add(&bar[XB_XCNT(b.x)], 1u);
    return b;
}
__device__ __forceinline__ void xcd_barrier_complete(unsigned* bar, unsigned x, unsigned& nloc, unsigned& nx) {
    const unsigned G = gridDim.x * gridDim.y * gridDim.z;
    unsigned sum, cnt, mine, sp = 0u;
    for (;;) {
        sum = 0u; cnt = 0u; mine = 0u;
#pragma unroll
        for (unsigned j = 0; j < 16; ++j) { const unsigned c = xb_ld(&bar[XB_XCNT(j)]); sum += c; cnt += (c > 0u) ? 1u : 0u; mine = (j == x) ? c : mine; }
        if (sum == G) break;
        __builtin_amdgcn_s_sleep(1);
        if ((++sp & 255u) == 0u) { if (xb_ld(&bar[XB_TMO])) break; if (sp > XB_SPIN_CAP) { atomicAdd(&bar[XB_TMO], 1u); break; } }
    }
    nloc = mine > 0u ? mine : 1u; nx = cnt > 0u ? cnt : 1u;
}

__device__ __forceinline__ void xcd_barrier(const XcdBarrier& b) {
    asm volatile("s_waitcnt vmcnt(0)" ::: "memory");
    __syncthreads();
    if (threadIdx.x == 0) {
        unsigned* bar = b.bar;
        __builtin_amdgcn_s_waitcnt(0);
        unsigned nloc = b.st[0], nx = b.st[1];
        if (nloc == 0u) { xcd_barrier_complete(bar, b.x, nloc, nx); b.st[0] = nloc; b.st[1] = nx; }
        const unsigned old = xb_add(&bar[XB_XSUB(b.x)], 1u);
        const unsigned gen = old / nloc;
        if (old + 1u == (gen + 1u) * nloc) {
            __builtin_amdgcn_fence(__ATOMIC_RELEASE, "agent");
            asm volatile("s_waitcnt vmcnt(0)" ::: "memory");
            const unsigned og = xb_add(&bar[XB_TOP], 1u);
            const unsigned tg = og / nx;
            if (og + 1u == (tg + 1u) * nx) xb_add(&bar[XB_TOPGEN], 1u);
            else XB_SPIN(xb_ld(&bar[XB_TOPGEN]) == tg, bar);
            __builtin_amdgcn_fence(__ATOMIC_ACQUIRE, "agent");
            xb_add(&bar[XB_XGEN(b.x)], 1u);
            asm volatile("s_waitcnt vmcnt(0)" ::: "memory");
        } else {
            XB_SPIN(xb_ld(&bar[XB_XGEN(b.x)]) == gen, bar);
            __builtin_amdgcn_fence(__ATOMIC_ACQUIRE, "agent");
            asm volatile("s_waitcnt vmcnt(0)" ::: "memory");
        }
    }
    __syncthreads();
}
constexpr int LDS_BYTES = 147456;
struct Params { const float* in[17]; float* out; unsigned char* ws; };

__global__ void __launch_bounds__(512, 2) mega(Params p) {
    extern __shared__ __attribute__((aligned(16))) unsigned char lds[];
    const float* x = p.in[0]; const float* relb = p.in[1]; const float* norm_mix = p.in[2]; const float* w_in = p.in[3];
    const float* gqa = p.in[4]; const float* gka = p.in[5]; const float* gqb = p.in[6]; const float* gkb = p.in[7];
    const float* bforget = p.in[8]; const float* sinks = p.in[9]; const float* w_out = p.in[10]; const float* norm_ffn = p.in[11];
    const float* w_query = p.in[12]; const float* sk1 = p.in[13]; const float* sk2 = p.in[14]; const float* eu = p.in[15]; const float* ev = p.in[16];
    float* out = p.out; unsigned char* ws = p.ws;
    bf16_t* WTIN = (bf16_t*)(ws + WS_WTIN); bf16_t* WTOUT = (bf16_t*)(ws + WS_WTOUT); bf16_t* WTQ = (bf16_t*)(ws + WS_WTQ);
    float* LOGF = (float*)(ws + WS_LOGF); float* F2 = (float*)(ws + WS_F2); float* SSQ = (float*)(ws + WS_SSQ);
    int* EIDX = (int*)(ws + WS_EIDX); float* GATE = (float*)(ws + WS_GATE);
    bf16_t* XN = (bf16_t*)(ws + WS_XN); bf16_t* AP = XN;
    bf16_t* QA = (bf16_t*)(ws + WS_QA); bf16_t* KA = (bf16_t*)(ws + WS_KA); bf16_t* VA = (bf16_t*)(ws + WS_VA);
    bf16_t* QB = (bf16_t*)(ws + WS_QB); bf16_t* KB = (bf16_t*)(ws + WS_KB); bf16_t* VB = (bf16_t*)(ws + WS_VB);
    bf16_t* MIX = (bf16_t*)(ws + WS_MIX); bf16_t* QV = (bf16_t*)(ws + WS_QV);

    unsigned char* EU8 = ws + WS_EU8; unsigned char* EV8 = ws + WS_EV8; float* SU = (float*)(ws + WS_SU); float* SV = (float*)(ws + WS_SV); float* RR = (float*)(ws + WS_RR);
    const int tid = threadIdx.x, lane = tid & 63, wave = __builtin_amdgcn_readfirstlane(tid >> 6);
    const int G = gridDim.x, gw = blockIdx.x * 8 + wave, NGW = G * 8;
    LAS unsigned char* ldsl = (LAS unsigned char*)lds;
    if (tid < 4) ((LAS unsigned*)(ldsl + LDS_BYTES - 16))[tid] = 0u;
    __syncthreads();
    const XcdBarrier xbar = xcd_barrier_post((unsigned*)(ws + WS_CTL), (volatile LAS unsigned*)(ldsl + LDS_BYTES - 16));

    {
        LAS float* scr = (LAS float*)(ldsl + wave * 16384);
        constexpr int I_IN = 16 * (NQKV / 32), I_OUT = 16 * (D / 32), I_Q = 16 * 32 * 4;
        for (int it = gw; it < I_IN + I_OUT + I_Q; it += NGW) {
            int r = it;
            if (r < I_Q) { p0_keyfold_item(w_query, sk1, sk2, norm_ffn, WTQ, r, lane); continue; } r -= I_Q;
            if (r < I_IN) { p0_transpose_item<true, true>(w_in, INW, D, NQKV / 32, WTIN, scr, r, lane, norm_mix); continue; } r -= I_IN;
            p0_transpose_item<false>(w_out, D, D, D / 32, WTOUT, scr, r, lane);
        }
        p0_rows(x, norm_mix, w_in, bforget, XN, RR, LOGF, gw, NGW, lane);
    }
    xcd_barrier(xbar);
    {
        { const int cb = G >= 128 ? (int)blockIdx.x - (G - 32) : (int)blockIdx.x;
          if (cb >= 0 && cb < 32) p1_cumsum(cb, (LAS float*)ldsl, LOGF, F2); }
        pg8::Gemm g{XN, WTIN, M, NQKV, D}; pg8::StaticOrder S; S.init(M, NQKV, G, (int)blockIdx.x);
        EpiQKV E{QA, KA, VA, QB, KB, VB, gqa, gka, gqb, gkb, RR};
        pg8::gemm_phase<EpiQKV, pg8::StaticOrder, true, true>(ldsl, g, S, E);
        { const int nfull = (M / 256) * (NQKV / 256) - 2 * G;
          if (nfull > 0 && nfull < G) { if ((int)blockIdx.x >= nfull) { const int qw = ((int)blockIdx.x - nfull) * 8 + wave, NQW = (G - nfull) * 8; p0_quant4_rows<1>(eu, EU8, SU, qw, NQW, lane); p0_quant4_rows<2>(ev, EV8, SV, qw, NQW, lane); } }
          else { p0_quant4_rows<1>(eu, EU8, SU, gw, NGW, lane); p0_quant4_rows<2>(ev, EV8, SV, gw, NGW, lane); } }
    }
    xcd_barrier(xbar);
    attn_phase(ldsl, QA, KA, VA, QB, KB, VB, F2, sinks, relb, gqb, gkb, MIX, (unsigned*)(ws + WS_CTL) + 3584, G, wave, lane);
    xcd_barrier(xbar);
    {
        pg8::Gemm g{MIX, WTOUT, M, D, D}; pg8::StaticOrder S; S.init(M, D, G, (int)blockIdx.x);
        EpiOut E{AP, SSQ};
        pg8::gemm_phase<EpiOut, pg8::StaticOrder, true, true>(ldsl, g, S, E);
    }
    xcd_barrier(xbar);
    {
        pg8::Gemm g{AP, WTQ, M, NQ, D}; pg8::StaticOrder S; S.init(M, NQ, G, (int)blockIdx.x);
        EpiQV E{QV, SSQ};
        pg8::gemm_phase<EpiQV, pg8::StaticOrder, true, true>(ldsl, g, S, E);
    }
    xcd_barrier(xbar);
    {
        LAS unsigned* lut = (LAS unsigned*)(ldsl + TK_LUT_OFF + wave * 8192);
        for (int task = gw; task < (M / 32) * 4; task += NGW) topk_task(task >> 2, task & 3, QV, lut, EIDX, GATE, lane);
    }
    const bool p6local = NGW == (M / 32) * 4 && NGW * 8 == M;
    if (p6local) { __builtin_amdgcn_fence(__ATOMIC_RELEASE, "workgroup"); __syncthreads(); __builtin_amdgcn_fence(__ATOMIC_ACQUIRE, "workgroup"); }
    else xcd_barrier(xbar);
    { auto gbar = [&]() { xcd_barrier(xbar); };
      const int tfirst = p6local ? 64 * (int)blockIdx.x + 8 * wave : gw, tstep = 8 * NGW, tstride = p6local ? 1 : NGW, ntb = p6local ? 1 : (M + 8 * NGW - 1) / (8 * NGW);
      gather_chunked(AP, SSQ, norm_ffn, EIDX, GATE, EU8, EV8, SU, SV, out, ldsl + wave * GQ_WAVE, tfirst, tstep, tstride, ntb, lane, gbar); }
}
}

extern "C" void kernel_launch(void* const* d_in, const int* in_sizes, int n_in, void* d_out, int out_size, void* d_ws, size_t ws_size, hipStream_t stream) {
    static int grid_blocks = 0;
    if (!grid_blocks) {
        int dev = 0, cus = 0, per_cu = 0;
        (void)hipGetDevice(&dev);
        (void)hipDeviceGetAttribute(&cus, hipDeviceAttributeMultiprocessorCount, dev);
        (void)hipFuncSetAttribute((const void*)mk::mega, hipFuncAttributeMaxDynamicSharedMemorySize, mk::LDS_BYTES);
        (void)hipOccupancyMaxActiveBlocksPerMultiprocessor(&per_cu, (const void*)mk::mega, 512, (size_t)mk::LDS_BYTES);
        if (per_cu < 1) fprintf(stderr, "occupancy query says %d blocks/CU\n", per_cu);
        grid_blocks = cus;
    }
    (void)hipMemsetAsync(d_ws, 0, 16384, stream);
    mk::Params p{};
    for (int i = 0; i < 17; ++i) p.in[i] = (const float*)d_in[i];
    p.out = (float*)d_out; p.ws = (unsigned char*)d_ws;
    void* args[] = {&p};
    hipError_t e = hipLaunchCooperativeKernel((void*)mk::mega, dim3(grid_blocks), dim3(512), args, (size_t)mk::LDS_BYTES, stream);
    if (e != hipSuccess) fprintf(stderr, "cooperative launch failed: %s (grid %d)\n", hipGetErrorString(e), grid_blocks);
}
```

```cpp
#include <hip/hip_runtime.h>
#include <cstdint>
#include <cstdio>
namespace pg8 {
#define PG8_LAS __attribute__((address_space(3)))
typedef unsigned short bf16_t;
typedef short bf16x8 __attribute__((ext_vector_type(8)));
typedef float f32x4 __attribute__((ext_vector_type(4)));
typedef unsigned u32x4 __attribute__((ext_vector_type(4)));
constexpr int BM = 256, BK = 64, HALF = 128, HTB = HALF * BK * 2  , STAGE_BYTES = 8 * HTB, NXCD = 8, WGM = 8;

__host__ __device__ __forceinline__ int lds_byte(int r, int c) { const int st = (r >> 4) * 2 + (c >> 5), rr = r & 15, cc = c & 31, ob = rr * 64 + cc * 2; return st * 1024 + (ob ^ (((ob >> 9) & 1) << 5)); }
__host__ __device__ __forceinline__ void stage_rc(int b, int& R, int& C) { const int st = b / 1024, sb = b % 1024, swz = sb ^ (((sb >> 9) & 1) << 5); R = (st >> 1) * 16 + swz / 64; C = (st & 1) * 32 + (swz % 64) / 2; }
__host__ __device__ __forceinline__ int perm32(int rho) { const int n = rho >> 4, i = rho & 15; return 8 * (i >> 2) + 4 * n + (i & 3); }

struct Unit { int pm, pn; };
struct Gemm { const bf16_t* A; const bf16_t* Bt; int M, N, K; };

struct StaticOrder {
    int nM, nN, nwg, G, c;
    __host__ __device__ void init(int M, int N, int G_, int c_) { nM = M / BM; nN = N / BM; nwg = nM * nN; G = G_; c = c_; }
    __host__ __device__ bool next(int i, Unit& u) const {
        const long L = (long)i * G + c; if (L >= nwg) return false;
        int wgid = (int)L; { const int q = nwg / NXCD, r = nwg % NXCD, xcd = wgid % NXCD, off = wgid / NXCD; wgid = (xcd < r ? xcd * (q + 1) : r * (q + 1) + (xcd - r) * q) + off; }
        const int nig = WGM * nN, gid = wgid / nig, fm = gid * WGM, gsz = (nM - fm) < WGM ? (nM - fm) : WGM;
        u.pm = fm + ((wgid % nig) % gsz); u.pn = (wgid % nig) / gsz; return true;
    }
    __device__ __forceinline__ void a_ready(const Unit&) const {}
    __device__ __forceinline__ void done(const Unit&) const {}
};

__device__ __forceinline__ unsigned cvt_pk_bf16(float lo, float hi) { unsigned r; asm volatile("v_cvt_pk_bf16_f32 %0, %1, %2" : "=v"(r) : "v"(lo), "v"(hi)); return r; }
typedef float f32x2 __attribute__((ext_vector_type(2)));
template <class Epi, class Sched, bool ALIGN_EPI = false, bool SP2 = false>
__device__ __forceinline__ void gemm_phase(PG8_LAS unsigned char* lds, const Gemm g, const Sched& S, const Epi& E) {
    int tid_ = threadIdx.x; asm volatile("" : "+v"(tid_));
    const int tid = tid_, wid = __builtin_amdgcn_readfirstlane(tid >> 6), lane = tid & 63, wr = wid >> 2, wc = wid & 3, fr = lane & 15, fq = lane >> 4;
    const int K = g.K, nt = K / BK;
    unsigned voffA[2], voffB[2];
#pragma unroll
    for (int i = 0; i < 2; ++i) { int R, C; stage_rc(tid * 16 + i * 8192, R, C); const int Rb = Epi::PERM ? ((R & ~31) + perm32(R & 31)) : R;
        voffA[i] = (unsigned)(R * K + C) * 2u; voffB[i] = (unsigned)(Rb * K + C) * 2u; }
    const size_t kstep = (size_t)(BK * 2);
    const size_t hstep = (size_t)HALF * K * 2;
    const size_t tstep = 2 * hstep;
    const unsigned ldsw = (unsigned)wid * 1024u;
    const int aoff = lds_byte(wr * 64 + fr, fq * 8), boff = lds_byte(wc * 32 + fr, fq * 8);
#define PG8_SA(b, h) (((b) * 2 + (h)) * HTB)
#define PG8_SB(b, h) ((4 + (b) * 2 + (h)) * HTB)
#define PG8_STAGE(bufoff, gbase, voff) do { _Pragma("unroll") for (int _i = 0; _i < 2; ++_i) \
        __builtin_amdgcn_global_load_lds((const unsigned*)((const char*)(gbase) + (voff)[_i]), (PG8_LAS unsigned*)(lds + (bufoff) + ldsw + _i * 8192), 16, 0, 0); } while (0)
#define PG8_LDA(dst, b, h) do { _Pragma("unroll") for (int m = 0; m < 4; ++m) _Pragma("unroll") for (int k = 0; k < 2; ++k) dst[m][k] = *(const PG8_LAS bf16x8*)(lds + PG8_SA(b, h) + aoff + m * 2048 + k * 1024); } while (0)
#define PG8_LDB(dst, b, h) do { _Pragma("unroll") for (int n = 0; n < 2; ++n) _Pragma("unroll") for (int k = 0; k < 2; ++k) dst[n][k] = *(const PG8_LAS bf16x8*)(lds + PG8_SB(b, h) + boff + n * 2048 + k * 1024); } while (0)
#define PG8_MMA(ai, bj, At, Bt) do { __builtin_amdgcn_s_setprio(1); _Pragma("unroll") for (int m = 0; m < 4; ++m) _Pragma("unroll") for (int n = 0; n < 2; ++n) _Pragma("unroll") for (int k = 0; k < 2; ++k) \
        acc[ai][bj][m][n] = __builtin_amdgcn_mfma_f32_16x16x32_bf16(Bt[n][k], At[m][k], acc[ai][bj][m][n], 0, 0, 0); __builtin_amdgcn_s_setprio(0); } while (0)
#define PG8_WAIT_V(n) asm volatile("s_waitcnt vmcnt(" #n ")" ::: "memory")
#define PG8_WAIT_L(n) asm volatile("s_waitcnt lgkmcnt(" #n ")" ::: "memory")
#define PG8_BAR __builtin_amdgcn_s_barrier()
#define PG8_SCHED __builtin_amdgcn_sched_barrier(0)
    Unit cur, nxt; int ui = 0;
    if (!S.next(0, cur)) return;
    f32x4 acc[2][2][4][2];
#pragma unroll
    for (int a = 0; a < 2; ++a)
#pragma unroll
        for (int b = 0; b < 2; ++b)
#pragma unroll
            for (int m = 0; m < 4; ++m)
#pragma unroll
                for (int n = 0; n < 2; ++n) acc[a][b][m][n] = (f32x4){0.f, 0.f, 0.f, 0.f};
    bf16x8 At[4][2], B0[2][2], B1[2][2];
    const char* cA = (const char*)g.A + (size_t)cur.pm * tstep; const char* cB = (const char*)g.Bt + (size_t)cur.pn * tstep;
    S.a_ready(cur);
    if constexpr (SP2) {
        PG8_STAGE(PG8_SB(0, 0), cB, voffB); PG8_STAGE(PG8_SB(0, 1), cB + hstep, voffB); PG8_STAGE(PG8_SA(0, 0), cA, voffA); PG8_STAGE(PG8_SA(0, 1), cA + hstep, voffA);
        if (wr == 1) PG8_BAR;
        PG8_WAIT_V(2); PG8_BAR;
        PG8_STAGE(PG8_SB(1, 0), cB + kstep, voffB); PG8_STAGE(PG8_SA(1, 0), cA + kstep, voffA); PG8_STAGE(PG8_SB(1, 1), cB + hstep + kstep, voffB);
        PG8_WAIT_V(6); PG8_BAR;
    } else {
        PG8_STAGE(PG8_SB(0, 0), cB, voffB); PG8_STAGE(PG8_SA(0, 0), cA, voffA); PG8_STAGE(PG8_SB(0, 1), cB + hstep, voffB); PG8_STAGE(PG8_SA(0, 1), cA + hstep, voffA);
        if (wr == 1) PG8_BAR;
        PG8_WAIT_V(4); PG8_BAR;
        PG8_STAGE(PG8_SB(1, 0), cB + kstep, voffB); PG8_STAGE(PG8_SA(1, 0), cA + kstep, voffA); PG8_STAGE(PG8_SB(1, 1), cB + hstep + kstep, voffB);
        PG8_WAIT_V(6); PG8_BAR;
    }
    for (;;) {
        const bool has_next = S.next(ui + 1, nxt);
        const char* nA = has_next ? (const char*)g.A + (size_t)nxt.pm * tstep : cA; const char* nB = has_next ? (const char*)g.Bt + (size_t)nxt.pn * tstep : cB;
        for (int t = 0; t < nt; t += 2) {
            const bool last = (t == nt - 2);
            const char* a1 = cA + (size_t)(t + 1) * kstep;
            const char* a2 = last ? nA : cA + (size_t)(t + 2) * kstep; const char* b2 = last ? nB : cB + (size_t)(t + 2) * kstep;
            const char* a3 = a2 + kstep; const char* b3 = b2 + kstep;
            if (last && has_next) S.a_ready(nxt);
            if constexpr (SP2) {
            PG8_LDB(B0, 0, 0); PG8_LDB(B1, 0, 1); PG8_SCHED; PG8_LDA(At, 0, 0); PG8_STAGE(PG8_SA(1, 1), a1 + hstep, voffA);
            PG8_WAIT_V(8); PG8_WAIT_L(0); PG8_BAR; PG8_MMA(0, 0, At, B0); PG8_MMA(0, 1, At, B1); PG8_BAR; PG8_SCHED;
            PG8_LDA(At, 0, 1); PG8_STAGE(PG8_SB(0, 0), b2, voffB); PG8_STAGE(PG8_SB(0, 1), b2 + hstep, voffB); PG8_STAGE(PG8_SA(0, 0), a2, voffA);
            PG8_WAIT_V(8); PG8_WAIT_L(0); PG8_BAR; PG8_MMA(1, 0, At, B0); PG8_MMA(1, 1, At, B1); PG8_BAR; PG8_SCHED;
            PG8_LDB(B0, 1, 0); PG8_LDB(B1, 1, 1); PG8_SCHED; PG8_LDA(At, 1, 0); PG8_STAGE(PG8_SA(0, 1), a2 + hstep, voffA);
            PG8_WAIT_V(8); PG8_WAIT_L(0); PG8_BAR; PG8_MMA(0, 0, At, B0); PG8_MMA(0, 1, At, B1); PG8_BAR; PG8_SCHED;
            PG8_LDA(At, 1, 1); PG8_STAGE(PG8_SB(1, 0), b3, voffB); PG8_STAGE(PG8_SB(1, 1), b3 + hstep, voffB); PG8_STAGE(PG8_SA(1, 0), a3, voffA);
            PG8_WAIT_V(8); PG8_WAIT_L(0); PG8_BAR; PG8_MMA(1, 0, At, B0); PG8_MMA(1, 1, At, B1); PG8_BAR; PG8_SCHED;
            } else {
            PG8_LDB(B0, 0, 0); PG8_SCHED; PG8_LDA(At, 0, 0); PG8_STAGE(PG8_SA(1, 1), a1 + hstep, voffA);
            PG8_WAIT_L(8); PG8_BAR; PG8_WAIT_L(0); PG8_MMA(0, 0, At, B0); PG8_BAR; PG8_SCHED;
            PG8_LDB(B1, 0, 1); PG8_STAGE(PG8_SB(0, 0), b2, voffB);
            PG8_BAR; PG8_WAIT_L(0); PG8_MMA(0, 1, At, B1); PG8_BAR;
            PG8_LDA(At, 0, 1); PG8_STAGE(PG8_SA(0, 0), a2, voffA);
            PG8_BAR; PG8_WAIT_L(0); PG8_MMA(1, 0, At, B0); PG8_BAR; PG8_SCHED;
            PG8_STAGE(PG8_SB(0, 1), b2 + hstep, voffB);
            PG8_WAIT_V(6); PG8_BAR; PG8_MMA(1, 1, At, B1); PG8_BAR;
            PG8_LDB(B0, 1, 0); PG8_SCHED; PG8_LDA(At, 1, 0); PG8_STAGE(PG8_SA(0, 1), a2 + hstep, voffA);
            PG8_WAIT_L(8); PG8_BAR; PG8_WAIT_L(0); PG8_MMA(0, 0, At, B0); PG8_BAR; PG8_SCHED;
            PG8_LDB(B1, 1, 1); PG8_STAGE(PG8_SB(1, 0), b3, voffB);
            PG8_BAR; PG8_WAIT_L(0); PG8_MMA(0, 1, At, B1); PG8_BAR;
            PG8_LDA(At, 1, 1); PG8_STAGE(PG8_SA(1, 0), a3, voffA);
            PG8_BAR; PG8_WAIT_L(0); PG8_MMA(1, 0, At, B0); PG8_BAR; PG8_SCHED;
            PG8_STAGE(PG8_SB(1, 1), b3 + hstep, voffB);
            PG8_WAIT_V(6); PG8_BAR; PG8_MMA(1, 1, At, B1); PG8_BAR;
            }
        }
        if constexpr (ALIGN_EPI) { if (wr == 0) PG8_BAR; }
        if constexpr (!Epi::AFTER_DRAIN) { E(acc, cur, wr, wc, fr, fq); S.done(cur); }
        if (!has_next) break;
#pragma unroll
        for (int a = 0; a < 2; ++a)
#pragma unroll
            for (int b = 0; b < 2; ++b)
#pragma unroll
                for (int m = 0; m < 4; ++m)
#pragma unroll
                    for (int n = 0; n < 2; ++n) acc[a][b][m][n] = (f32x4){0.f, 0.f, 0.f, 0.f};
        cur = nxt; cA = nA; cB = nB; ++ui;
        if constexpr (ALIGN_EPI) { if (wr == 1) PG8_BAR; }
    }
    PG8_WAIT_V(0);
    if constexpr (!ALIGN_EPI) { if (wr == 0) PG8_BAR; }
    PG8_BAR;
    if constexpr (Epi::AFTER_DRAIN) { E.fused(acc, cur, wr, wc, fr, fq, lds, wid, lane); S.done(cur); }
#undef PG8_SA
#undef PG8_SB
#undef PG8_STAGE
#undef PG8_LDA
#undef PG8_LDB
#undef PG8_MMA
#undef PG8_WAIT_V
#undef PG8_WAIT_L
#undef PG8_BAR
#undef PG8_SCHED
}
}
namespace mk {
using pg8::bf16_t; using pg8::f32x4; using pg8::u32x4; using pg8::Unit; using pg8::cvt_pk_bf16;
typedef unsigned u32x2 __attribute__((ext_vector_type(2)));
#define LAS __attribute__((address_space(3)))
constexpr int D = 1024, BATCH = 4, SEQ = 4096, M = BATCH * SEQ;
constexpr int INW = 2312, NQKV = 2304, NQ = 2048, NEXP = 16384;
constexpr float EPS = 1e-6f, LOG2E = 1.4426950408889634f, C2 = 0.125f * LOG2E;
constexpr size_t MiB = 1u << 20;
constexpr size_t WS_CTL = 0, WS_WTIN = 1 * MiB, WS_WTOUT = 6 * MiB, WS_WTQ = 8 * MiB, WS_SK = 12 * MiB, WS_LOGF = 13 * MiB, WS_F2 = 13 * MiB + 512 * 1024, WS_SSQ = 14 * MiB,
                 WS_EIDX = 16 * MiB, WS_GATE = 24 * MiB, WS_XN = 32 * MiB, WS_QA = 64 * MiB, WS_KA = 80 * MiB, WS_VA = 84 * MiB, WS_QB = 88 * MiB, WS_KB = 104 * MiB, WS_VB = 120 * MiB,
                 WS_MIX = 136 * MiB, WS_QV = 64 * MiB, WS_EU8 = 168 * MiB, WS_EV8 = 184 * MiB, WS_X1 = 192 * MiB, WS_COEF = 136 * MiB, WS_CSUM = 144 * MiB, WS_SU = 15 * MiB, WS_SV = 15 * MiB + 65536, WS_RR = 15 * MiB + 131072;

__device__ __constant__ unsigned char T5B[128] = {0, 1, 2, 3, 4, 5, 6, 7, 8, 9, 10, 11, 12, 13, 14, 15, 16, 16, 16, 17, 17, 18, 18, 18, 19, 19, 19, 20, 20, 20, 20, 21, 21, 21, 21, 22, 22, 22, 22, 22, 23, 23, 23, 23, 23, 23, 24, 24, 24, 24, 24, 24, 25, 25, 25, 25, 25, 25, 25, 26, 26, 26, 26, 26, 26, 26, 26, 27, 27, 27, 27, 27, 27, 27, 27, 27, 27, 28, 28, 28, 28, 28, 28, 28, 28, 28, 28, 29, 29, 29, 29, 29, 29, 29, 29, 29, 29, 29, 29, 30, 30, 30, 30, 30, 30, 30, 30, 30, 30, 30, 30, 30, 30, 31, 31, 31, 31, 31, 31, 31, 31, 31, 31, 31, 31, 31, 31, 31};

__device__ __forceinline__ float wave_sum(float v) {
#pragma unroll
    for (int o = 1; o < 64; o <<= 1) v += __shfl_xor(v, o);
    return v;
}
__device__ __forceinline__ float bf_lo(unsigned w) { return __uint_as_float(w << 16); }
__device__ __forceinline__ float bf_hi(unsigned w) { return __uint_as_float(w & 0xffff0000u); }

struct EpiQKV {
    static constexpr bool PERM = true, AFTER_DRAIN = false;
    bf16_t *QA, *KA, *VA, *QB, *KB, *VB; const float *gqa, *gka, *gqb, *gkb; const float* rr;
    __device__ __forceinline__ void operator()(const f32x4 (&acc)[2][2][4][2], const Unit& u, int wr, int wc, int fr, int fq) const {
        const int s = u.pn * 4 + wc;
        bf16_t* dst; int pitch; const float* g; float sc = 1.f;
        if (s < 8) { dst = QA + 64 * s; pitch = 512; g = gqa; sc = C2; }
        else if (s < 10) { dst = KA + 64 * (s - 8); pitch = 128; g = gka; }
        else if (s < 12) { dst = VA + 64 * (s - 10); pitch = 128; g = nullptr; }
        else if (s < 20) { dst = QB + 64 * (s - 12); pitch = 512; g = gqb; sc = C2; }
        else if (s < 28) { dst = KB + 64 * (s - 20); pitch = 512; g = gkb; }
        else { dst = VB + 64 * (s - 28); pitch = 512; g = nullptr; }
        f32x4 gv[2][2];
#pragma unroll
        for (int bj = 0; bj < 2; ++bj)
#pragma unroll
            for (int n = 0; n < 2; ++n) gv[bj][n] = g ? *(const f32x4*)(g + 32 * bj + 8 * fq + 4 * n) * sc : (f32x4){1.f, 1.f, 1.f, 1.f};
        const int row0 = u.pm * 256 + wr * 64 + fr;
        float rw[2][4];
#pragma unroll
        for (int ai = 0; ai < 2; ++ai)
#pragma unroll
            for (int m = 0; m < 4; ++m) rw[ai][m] = rr[row0 + ai * 128 + m * 16];
#pragma unroll
        for (int ai = 0; ai < 2; ++ai)
#pragma unroll
            for (int m = 0; m < 4; ++m) {
                float ss = 0.f;
#pragma unroll
                for (int bj = 0; bj < 2; ++bj)
#pragma unroll
                    for (int n = 0; n < 2; ++n) { const f32x4 v = acc[ai][bj][m][n]; ss += (v[0] * v[0] + v[1] * v[1]) + (v[2] * v[2] + v[3] * v[3]); }
                ss += __shfl_xor(ss, 16); ss += __shfl_xor(ss, 32);
                const float rx = rw[ai][m]; const float rs = g ? rsqrtf(ss * (rx * rx) * (1.f / 64.f) + EPS) * rx : rx;
                bf16_t* rowp = dst + (size_t)(row0 + ai * 128 + m * 16) * pitch + 8 * fq;
#pragma unroll
                for (int bj = 0; bj < 2; ++bj) {
                    const f32x4 v0 = acc[ai][bj][m][0] * rs * gv[bj][0], v1 = acc[ai][bj][m][1] * rs * gv[bj][1];
                    u32x4 w; w.x = cvt_pk_bf16(v0[0], v0[1]); w.y = cvt_pk_bf16(v0[2], v0[3]); w.z = cvt_pk_bf16(v1[0], v1[1]); w.w = cvt_pk_bf16(v1[2], v1[3]);
                    *(u32x4*)(rowp + 32 * bj) = w;
                }
            }
    }
};
struct EpiOut {
    static constexpr bool PERM = false, AFTER_DRAIN = false;
    bf16_t* ap; float* ssq;
    __device__ __forceinline__ void operator()(const f32x4 (&acc)[2][2][4][2], const Unit& u, int wr, int wc, int fr, int fq) const {
        const int col0 = u.pn * 256 + wc * 32 + 4 * fq;
        const int row0 = u.pm * 256 + wr * 64 + fr;
#pragma unroll
        for (int ai = 0; ai < 2; ++ai) {
            u32x2 xc[4][2][2];
#pragma unroll
            for (int m = 0; m < 4; ++m)
#pragma unroll
                for (int bj = 0; bj < 2; ++bj)
#pragma unroll
                    for (int n = 0; n < 2; ++n) xc[m][bj][n] = *(const u32x2*)(ap + (size_t)(row0 + ai * 128 + m * 16) * D + col0 + bj * 128 + n * 16);
            __builtin_amdgcn_sched_barrier(0);
#pragma unroll
            for (int m = 0; m < 4; ++m) {
                const int row = row0 + ai * 128 + m * 16; const size_t off = (size_t)row * D + col0; float ss = 0.f;
#pragma unroll
                for (int bj = 0; bj < 2; ++bj)
#pragma unroll
                    for (int n = 0; n < 2; ++n) {
                        const size_t o2 = off + bj * 128 + n * 16;
                        const u32x2 xw = xc[m][bj][n]; const f32x4 v = acc[ai][bj][m][n] + (f32x4){bf_lo(xw.x), bf_hi(xw.x), bf_lo(xw.y), bf_hi(xw.y)};
                        ss += (v[0] * v[0] + v[1] * v[1]) + (v[2] * v[2] + v[3] * v[3]);
                        u32x2 w; w.x = cvt_pk_bf16(v[0], v[1]); w.y = cvt_pk_bf16(v[2], v[3]);
                        *(u32x2*)(ap + o2) = w;
                    }
                ss += __shfl_xor(ss, 16); ss += __shfl_xor(ss, 32);
                if (fq == 0) ssq[(size_t)row * 16 + u.pn * 4 + wc] = ss;
            }
        }
    }
};
struct EpiQV {
    static constexpr bool PERM = true, AFTER_DRAIN = false;
    bf16_t* qv; const float* ssq;
    __device__ __forceinline__ void operator()(const f32x4 (&acc)[2][2][4][2], const Unit& u, int wr, int wc, int fr, int fq) const {
        const int row0 = u.pm * 256 + wr * 64 + fr, col0 = u.pn * 256 + wc * 32 + 8 * fq;
#pragma unroll
        for (int ai = 0; ai < 2; ++ai)
#pragma unroll
            for (int m = 0; m < 4; ++m) {
                const int row = row0 + ai * 128 + m * 16;
                const f32x4* sp = (const f32x4*)(ssq + (size_t)row * 16);
                const f32x4 s0 = sp[0], s1 = sp[1], s2 = sp[2], s3 = sp[3];
                const float tot = ((s0[0] + s0[1]) + (s0[2] + s0[3])) + ((s1[0] + s1[1]) + (s1[2] + s1[3])) + ((s2[0] + s2[1]) + (s2[2] + s2[3])) + ((s3[0] + s3[1]) + (s3[2] + s3[3]));
                const float rs = rsqrtf(tot * (1.f / D) + EPS);
                bf16_t* rowp = qv + (size_t)row * NQ + col0;
#pragma unroll
                for (int bj = 0; bj < 2; ++bj) {
                    const f32x4 v0 = acc[ai][bj][m][0] * rs, v1 = acc[ai][bj][m][1] * rs;
                    u32x4 w; w.x = cvt_pk_bf16(v0[0], v0[1]); w.y = cvt_pk_bf16(v0[2], v0[3]); w.z = cvt_pk_bf16(v1[0], v1[1]); w.w = cvt_pk_bf16(v1[2], v1[3]);
                    *(u32x4*)(rowp + 128 * bj) = w;
                }
            }
    }
};

__device__ __forceinline__ int rowmap_in(int n0) { const int s = n0 >> 6, bj = (n0 >> 5) & 1; return 256 * (s >> 2) + 128 * bj + 32 * (s & 3); }
template <bool MAPIN, bool SCALE = false  >
__device__ __forceinline__ void p0_transpose_item(const float* __restrict__ W, int ldw, int K, int nblk, bf16_t* __restrict__ WT, LAS float* scr, int item, int lane, const float* __restrict__ rsc = nullptr) {
    const int kb = item / nblk, nb = item % nblk, k0 = 64 * kb, n0 = 32 * nb;
    const int r0 = MAPIN ? rowmap_in(n0) : n0;
#pragma unroll 8
    for (int i = 0; i < 32; ++i) { const int kk = 2 * i + (lane >> 5); scr[kk * 33 + (lane & 31)] = W[(size_t)(k0 + kk) * ldw + n0 + (lane & 31)] * (SCALE ? rsc[k0 + kk] : 1.f); }
    asm volatile("s_waitcnt lgkmcnt(0)" ::: "memory");
    const int c = lane & 7;
#pragma unroll
    for (int j = 0; j < 4; ++j) { const int n = (lane >> 3) + 8 * j; const LAS float* s = scr + (8 * c) * 33 + n;
        u32x4 o; o.x = cvt_pk_bf16(s[0 * 33], s[1 * 33]); o.y = cvt_pk_bf16(s[2 * 33], s[3 * 33]); o.z = cvt_pk_bf16(s[4 * 33], s[5 * 33]); o.w = cvt_pk_bf16(s[6 * 33], s[7 * 33]);
        *(u32x4*)(WT + (size_t)(r0 + n) * K + k0 + 8 * c) = o; }
    asm volatile("s_waitcnt lgkmcnt(0)" ::: "memory");
}
__device__ __forceinline__ void p0_keyfold_item(const float* __restrict__ wq, const float* __restrict__ sk1, const float* __restrict__ sk2, const float* __restrict__ g, bf16_t* __restrict__ WT, int item, int lane) {
    typedef short bf16x8s_ __attribute__((ext_vector_type(8)));
    typedef float f32x16_ __attribute__((ext_vector_type(16)));
    const int tile = item & 3, k0 = 32 * ((item >> 2) & 31), hh2 = item >> 7, tl = lane & 31, dg = lane >> 5;
    const float* sp = ((hh2 & 1) ? sk2 : sk1) + (size_t)(32 * tile + tl) * 128 + dg * 8;
    const float* wrow = wq + (size_t)(k0 + tl) * NQ + hh2 * 128 + dg * 8;
    const float gk = g[k0 + tl];
    f32x4 a0[8], a1[8], b0[8], b1[8];
#pragma unroll
    for (int ds = 0; ds < 8; ++ds) { b0[ds] = *(const f32x4*)(wrow + ds * 16); b1[ds] = *(const f32x4*)(wrow + ds * 16 + 4); a0[ds] = *(const f32x4*)(sp + ds * 16); a1[ds] = *(const f32x4*)(sp + ds * 16 + 4); }
    f32x16_ acc;
#pragma unroll
    for (int r = 0; r < 16; ++r) acc[r] = 0.f;
#pragma unroll
    for (int ds = 0; ds < 8; ++ds) {
        const f32x4 p0 = b0[ds] * gk, p1 = b1[ds] * gk;
        const u32x4 bw = {cvt_pk_bf16(p0[0], p0[1]), cvt_pk_bf16(p0[2], p0[3]), cvt_pk_bf16(p1[0], p1[1]), cvt_pk_bf16(p1[2], p1[3])};
        const u32x4 aw = {cvt_pk_bf16(a0[ds][0], a0[ds][1]), cvt_pk_bf16(a0[ds][2], a0[ds][3]), cvt_pk_bf16(a1[ds][0], a1[ds][1]), cvt_pk_bf16(a1[ds][2], a1[ds][3])};
        acc = __builtin_amdgcn_mfma_f32_32x32x16_bf16(__builtin_bit_cast(bf16x8s_, aw), __builtin_bit_cast(bf16x8s_, bw), acc, 0, 0, 0);
    }
    const int odd = tl & 1;
#pragma unroll
    for (int r = 0; r < 16; r += 2) {
        const float own0 = acc[r], own1 = acc[r + 1];
        const float recv = __shfl_xor(odd ? own0 : own1, 1);
        const int n = 32 * tile + ((r + odd) & 3) + 8 * ((r + odd) >> 2) + 4 * dg;
        const unsigned w = odd ? cvt_pk_bf16(recv, own1) : cvt_pk_bf16(own0, recv);
        *(unsigned*)(WT + (size_t)(hh2 * 128 + n) * D + k0 + (tl & ~1)) = w;
    }
}
__device__ __forceinline__ void p0_convert(const float* __restrict__ src, bf16_t* __restrict__ dst, size_t n8, int gw, int NGW, int lane) {
    for (size_t i = (size_t)gw * 64 + lane; i < n8; i += (size_t)NGW * 64) {
        const f32x4 a = ((const f32x4*)src)[2 * i], b = ((const f32x4*)src)[2 * i + 1];
        u32x4 w; w.x = cvt_pk_bf16(a[0], a[1]); w.y = cvt_pk_bf16(a[2], a[3]); w.z = cvt_pk_bf16(b[0], b[1]); w.w = cvt_pk_bf16(b[2], b[3]);
        ((u32x4*)dst)[i] = w;
    }
}
__device__ __forceinline__ void p0_rows(const float* __restrict__ x, const float* __restrict__ g, const float* __restrict__ w_in, const float* __restrict__ bforget, bf16_t* __restrict__ XN, float* __restrict__ RR, float* __restrict__ logf, int gw, int NGW, int lane) {
    f32x4 wa[16], wb[16];
#pragma unroll
    for (int jj = 0; jj < 4; ++jj)
#pragma unroll
        for (int e = 0; e < 4; ++e) { const f32x4* wp = (const f32x4*)(w_in + (size_t)(256 * jj + 4 * lane + e) * INW + NQKV); wa[jj * 4 + e] = wp[0]; wb[jj * 4 + e] = wp[1]; }
    const float bl = bforget[lane & 7];
#pragma unroll 1
    for (int rowb = gw; rowb < M; rowb += 4 * NGW) {
        f32x4 v4[4][4];
#pragma unroll
        for (int r = 0; r < 4; ++r) { const int row = rowb + r * NGW < M ? rowb + r * NGW : rowb; const f32x4* xr = (const f32x4*)(x + (size_t)row * D);
#pragma unroll
            for (int jj = 0; jj < 4; ++jj) v4[r][jj] = __builtin_nontemporal_load(xr + lane + 64 * jj); }
#pragma unroll
        for (int r = 0; r < 4; ++r) {
            const int row = rowb + r * NGW;
            if (row < M) {
                float s = 0.f;
#pragma unroll
                for (int jj = 0; jj < 4; ++jj) { const f32x4 v = v4[r][jj]; s += (v[0] * v[0] + v[1] * v[1]) + (v[2] * v[2] + v[3] * v[3]); }
                s = wave_sum(s);
                const float rs = rsqrtf(s * (1.f / D) + EPS);
                f32x4 pa = {0.f, 0.f, 0.f, 0.f}, pb = {0.f, 0.f, 0.f, 0.f};
#pragma unroll
                for (int jj = 0; jj < 4; ++jj) {
                    const f32x4 v = v4[r][jj]; const f32x4 h = v * rs * ((const f32x4*)g)[lane + 64 * jj];
                    u32x2 w; w.x = cvt_pk_bf16(v[0], v[1]); w.y = cvt_pk_bf16(v[2], v[3]);
                    *(u32x2*)(XN + (size_t)row * D + 256 * jj + 4 * lane) = w;
#pragma unroll
                    for (int e = 0; e < 4; ++e) { pa += wa[jj * 4 + e] * h[e]; pb += wb[jj * 4 + e] * h[e]; }
                }
                float z = 0.f;
#pragma unroll
                for (int j = 0; j < 4; ++j) { const float sa = wave_sum(pa[j]), sb = wave_sum(pb[j]); if (lane == j) z = sa; if (lane == 4 + j) z = sb; }
                if (lane == 8) RR[row] = rs;
                if (lane < 8) { z += bl; logf[(size_t)row * 8 + lane] = fminf(z, 0.f) - log1pf(expf(-fabsf(z))); }
            }
        }
    }
}
__device__ __forceinline__ void p1_cumsum(int bh, LAS float* part, const float* __restrict__ logf, float* __restrict__ F2) {
    const int b = bh >> 3, h = bh & 7, tid = threadIdx.x, lane = tid & 63, wv = tid >> 6;
    float v[8]; float s = 0.f;
#pragma unroll
    for (int i = 0; i < 8; ++i) { s += logf[((size_t)b * SEQ + tid * 8 + i) * 8 + h]; v[i] = s; }
    float inc = s;
#pragma unroll
    for (int o = 1; o < 64; o <<= 1) { const float t = __shfl_up(inc, o); if (lane >= o) inc += t; }
    if (lane == 63) part[wv] = inc;
    __syncthreads();
    float base = inc - s;
    for (int w = 0; w < wv; ++w) base += part[w];
#pragma unroll
    for (int i = 0; i < 8; ++i) F2[(size_t)bh * SEQ + tid * 8 + i] = (base + v[i]) * LOG2E;
    __syncthreads();
}
__device__ __forceinline__ float wave_max(float v) {
#pragma unroll
    for (int o = 1; o < 64; o <<= 1) v = fmaxf(v, __shfl_xor(v, o));
    return v;
}
template <int SIGNED  >
__device__ __forceinline__ void p0_quant4_rows(const float* __restrict__ T, unsigned char* __restrict__ T4, float* __restrict__ SC, int gw, int NGW, int lane) {
    for (int row = gw; row < NEXP; row += NGW) {
        const f32x4* tr = (const f32x4*)(T + (size_t)row * D + 16 * lane);
        f32x4 v[4]; float ss = 0.f;
#pragma unroll
        for (int j = 0; j < 4; ++j) { v[j] = __builtin_nontemporal_load(tr + j); ss += (v[j][0] * v[j][0] + v[j][1] * v[j][1]) + (v[j][2] * v[j][2] + v[j][3] * v[j][3]); }
        ss = wave_sum(ss);
        const float s = fmaxf(0.3352f * sqrtf(ss * (1.f / D)), 1e-30f), inv = 1.f / s;
        u32x2 w;
#pragma unroll
        for (int j2 = 0; j2 < 2; ++j2) {
            unsigned p = 0;
#pragma unroll
            for (int e = 0; e < 4; ++e) {
                const int lo = ((int)fminf(fmaxf(floorf(v[2 * j2][e] * inv), -8.f), 7.f) + (SIGNED == 1 ? 0 : 8)) & 15, hi = (int)fminf(fmaxf(floorf(v[2 * j2 + 1][e] * inv), -8.f), 7.f) & 15;
                p |= ((unsigned)lo | ((unsigned)hi << 4)) << (8 * e);
            }
            w[j2] = p;
        }
        *(u32x2*)(T4 + (size_t)row * 512 + 8 * lane) = w;
        if (lane == 0) SC[row] = s;
    }
}

__device__ __forceinline__ int row16_sum_i(int v) {
    v += __builtin_amdgcn_update_dpp(0, v, 0xB1, 0xf, 0xf, false);
    v += __builtin_amdgcn_update_dpp(0, v, 0x4E, 0xf, 0xf, false);
    v += __builtin_amdgcn_update_dpp(0, v, 0x141, 0xf, 0xf, false);
    v += __builtin_amdgcn_update_dpp(0, v, 0x140, 0xf, 0xf, false);
    return v;
}
typedef int i32x4 __attribute__((ext_vector_type(4)));
typedef float f32x2 __attribute__((ext_vector_type(2)));
__device__ __forceinline__ float ub(unsigned w, int k) { return (float)((w >> (8 * k)) & 0xffu); }

constexpr int GQ_DOT = 0, GQ_TOKC = 4096, GQ_PKL = 4352, GQ_UN = 5376, GQ_H2Q = GQ_UN, GQ_UIMG = GQ_UN + 8192, GQ_VIMG = GQ_UN, GQ_WAVE = 17920;
constexpr int GQ_UROW = 68, GQ_VROW = 36;
static_assert(GQ_UIMG + 16 * GQ_UROW * 4 <= GQ_WAVE && GQ_VIMG + 64 * GQ_VROW * 4 <= GQ_WAVE && 8 * GQ_WAVE <= 147440, "gather LDS");
#define GT_DPP(v, ctrl) __uint_as_float((unsigned)__builtin_amdgcn_update_dpp(0, (int)__float_as_uint(v), ctrl, 0xf, 0xf, false))
__device__ __forceinline__ float wave_max_u(float v) {
    v = fmaxf(v, GT_DPP(v, 0xB1)); v = fmaxf(v, GT_DPP(v, 0x4E)); v = fmaxf(v, GT_DPP(v, 0x141)); v = fmaxf(v, GT_DPP(v, 0x140));
    const int iv = (int)__float_as_uint(v);
    const float a = __uint_as_float((unsigned)__builtin_amdgcn_readlane(iv, 0)), b = __uint_as_float((unsigned)__builtin_amdgcn_readlane(iv, 16)), c = __uint_as_float((unsigned)__builtin_amdgcn_readlane(iv, 32)), d = __uint_as_float((unsigned)__builtin_amdgcn_readlane(iv, 48));
    return fmaxf(fmaxf(a, b), fmaxf(c, d));
}
__device__ __forceinline__ int wave_sum_iu(int v) { v = row16_sum_i(v); return (__builtin_amdgcn_readlane(v, 0) + __builtin_amdgcn_readlane(v, 16)) + (__builtin_amdgcn_readlane(v, 32) + __builtin_amdgcn_readlane(v, 48)); }

template <class Bar>
__device__ __forceinline__ void gather_chunked(const bf16_t* __restrict__ ap, const float* __restrict__ ssq, const float* __restrict__ gffn, const int* __restrict__ eidx, const float* __restrict__ gate,
                                               const unsigned char* __restrict__ EU4, const unsigned char* __restrict__ EV4, const float* __restrict__ SU, const float* __restrict__ SV,
                                               float* __restrict__ out, LAS unsigned char* wl, int tfirst, int tstep, int tstride, int ntb  , int lane, const Bar& bar) {
    const int g8 = lane >> 3, pc = lane & 7, g84 = 4 * g8;
    const unsigned pc16 = (unsigned)pc * 16u;
    LAS int* DOT = (LAS int*)(wl + GQ_DOT); LAS float* TOKC = (LAS float*)(wl + GQ_TOKC); LAS unsigned* PKL = (LAS unsigned*)(wl + GQ_PKL);
    LAS unsigned char* H2Q = wl + GQ_H2Q; LAS int* UIMG = (LAS int*)(wl + GQ_UIMG); LAS int* VIMG = (LAS int*)(wl + GQ_VIMG);
#pragma unroll 1
    for (int tb = 0; tb < ntb; ++tb) {
        const int t0 = tfirst + tb * tstep;
        int ntok = 0; if (t0 < M) { ntok = (M - t0 + tstride - 1) / tstride; ntok = ntok > 8 ? 8 : ntok; }
#pragma unroll 1
        for (int i = 0; i < ntok; ++i) {
            const int t = t0 + i * tstride;
            float rs;
            { const f32x4* sp = (const f32x4*)(ssq + (size_t)t * 16); const f32x4 a = sp[0], b = sp[1], c = sp[2], d = sp[3];
              const float tot = ((a[0] + a[1]) + (a[2] + a[3])) + ((b[0] + b[1]) + (b[2] + b[3])) + ((c[0] + c[1]) + (c[2] + c[3])) + ((d[0] + d[1]) + (d[2] + d[3]));
              rs = rsqrtf(tot * (1.f / D) + EPS); }
            const u32x4* hp = (const u32x4*)(ap + (size_t)t * D + 16 * lane); const u32x4 w0 = hp[0], w1 = hp[1];
            float h[16];
#pragma unroll
            for (int k = 0; k < 4; ++k) { h[2 * k] = bf_lo(w0[k]); h[2 * k + 1] = bf_hi(w0[k]); h[8 + 2 * k] = bf_lo(w1[k]); h[8 + 2 * k + 1] = bf_hi(w1[k]); }
#pragma unroll
            for (int k = 0; k < 4; ++k) { const f32x4 gk = ((const f32x4*)(gffn + 16 * lane))[k]; h[4 * k] *= gk[0]; h[4 * k + 1] *= gk[1]; h[4 * k + 2] *= gk[2]; h[4 * k + 3] *= gk[3]; }
            float am = 0.f;
#pragma unroll
            for (int k = 0; k < 16; ++k) am = fmaxf(am, fabsf(h[k]));
            am = wave_max_u(am);
            const float hinv = am > 0.f ? 119.f / am : 0.f;
            u32x4 qw; int hs = -128;
#pragma unroll
            for (int d = 0; d < 2; ++d) {
                unsigned u[8];
#pragma unroll
                for (int j = 0; j < 8; ++j) u[j] = __float_as_uint(__builtin_fmaf(h[8 * d + j], hinv, 12582920.f));
                const unsigned ba = __builtin_amdgcn_perm(__builtin_amdgcn_perm(u[3], u[2], 0x0c0c0400u), __builtin_amdgcn_perm(u[1], u[0], 0x0c0c0400u), 0x05040100u);
                const unsigned bb = __builtin_amdgcn_perm(__builtin_amdgcn_perm(u[7], u[6], 0x0c0c0400u), __builtin_amdgcn_perm(u[5], u[4], 0x0c0c0400u), 0x05040100u);
                hs = __builtin_amdgcn_sdot4((int)ba, 0x01010101, hs, false); hs = __builtin_amdgcn_sdot4((int)bb, 0x01010101, hs, false);
                qw[2 * d] = ((ba >> 4) & 0x0f0f0f0fu) | (((bb >> 4) & 0x0f0f0f0fu) << 4);
                qw[2 * d + 1] = ((ba & 0x0f0f0f0fu) ^ 0x08080808u) | (((bb & 0x0f0f0f0fu) ^ 0x08080808u) << 4);
            }
            *(LAS u32x4*)(H2Q + i * 1024 + 16 * lane) = qw;
            hs = wave_sum_iu(hs);
            if (lane == 0) { TOKC[i * 8 + 0] = am * (1.f / 119.f) * rs; TOKC[i * 8 + 1] = (float)hs; }
            DOT[i * 128 + lane] = 0; DOT[i * 128 + 64 + lane] = 0;
        }
        u32x4 r[16];
        {
            const int nit = 4 * ntok;
            int e0 = 0, e1 = 0, en0 = 0, en1 = 0;
            if (ntok > 0) { e0 = eidx[(size_t)t0 * 128 + lane]; e1 = eidx[(size_t)t0 * 128 + 64 + lane]; }
            if (nit > 1) { const int tn = t0 + (1 % ntok) * tstride; en0 = eidx[(size_t)tn * 128 + lane]; en1 = eidx[(size_t)tn * 128 + 64 + lane]; }
            if (nit > 0) {
#pragma unroll
                for (int s_ = 0; s_ < 16; ++s_) { const unsigned e = (unsigned)__builtin_amdgcn_ds_bpermute(g84 + 32 * (s_ & 7), s_ < 8 ? e0 : e1); r[s_] = *(const u32x4*)(EU4 + (e * 512u + pc16)); }
            }
#pragma unroll 1
            for (int n = 0; n < nit; ++n) {
                const int c = n / ntok, i = n - c * ntok;
                const int n1 = n + 1; const bool more = n1 < nit; const int c1 = more ? n1 / ntok : 0;
                int ef0 = 0, ef1 = 0;
                { const int n2 = n + 2; const int i2 = n2 % ntok; const int tn = t0 + i2 * tstride; ef0 = eidx[(size_t)tn * 128 + lane]; ef1 = eidx[(size_t)tn * 128 + 64 + lane]; }
                int hq[8];
                { const LAS i32x4* hp = (const LAS i32x4*)(H2Q + i * 1024 + 256 * c + 32 * pc); const i32x4 a = hp[0], b = hp[1];
                  hq[0] = a[0]; hq[1] = a[1]; hq[2] = a[2]; hq[3] = a[3]; hq[4] = b[0]; hq[5] = b[1]; hq[6] = b[2]; hq[7] = b[3]; }
                const unsigned noff = (unsigned)c1 * 128u + pc16;
                unsigned enx = (unsigned)__builtin_amdgcn_ds_bpermute(g84, en0);
#pragma unroll
                for (int s_ = 0; s_ < 16; ++s_) {
                    const unsigned ecur = enx;
                    if (s_ + 1 < 16) enx = (unsigned)__builtin_amdgcn_ds_bpermute(g84 + 32 * ((s_ + 1) & 7), (s_ + 1) < 8 ? en0 : en1);
                    int ah, al;
                    { const int w = (int)r[s_][0]; asm("v_dot8_i32_i4 %0, %1, %2, 0" : "=v"(ah) : "v"(w), "v"(hq[0])); asm("v_dot8_i32_i4 %0, %1, %2, 0" : "=v"(al) : "v"(w), "v"(hq[1])); }
#pragma unroll
                    for (int q = 1; q < 4; ++q) { const int w = (int)r[s_][q]; ah = __builtin_amdgcn_sdot8(w, hq[2 * q], ah, false); al = __builtin_amdgcn_sdot8(w, hq[2 * q + 1], al, false); }
                    UIMG[s_ * GQ_UROW + lane] = 16 * ah + al;
                    r[s_] = *(const u32x4*)(EU4 + (ecur * 512u + noff));
                    __builtin_amdgcn_sched_barrier(0);
                }
                { const LAS int* rp = UIMG + (lane >> 3) * GQ_UROW + 8 * (lane & 7);
                  const i32x4 a0 = *(const LAS i32x4*)(rp), a1 = *(const LAS i32x4*)(rp + 4), b0 = *(const LAS i32x4*)(rp + 8 * GQ_UROW), b1 = *(const LAS i32x4*)(rp + 8 * GQ_UROW + 4);
                  DOT[i * 128 + lane] += ((a0[0] + a0[1]) + (a0[2] + a0[3])) + ((a1[0] + a1[1]) + (a1[2] + a1[3]));
                  DOT[i * 128 + 64 + lane] += ((b0[0] + b0[1]) + (b0[2] + b0[3])) + ((b1[0] + b1[1]) + (b1[2] + b1[3])); }
                en0 = ef0; en1 = ef1;
            }
        }
#pragma unroll 1
        for (int i = 0; i < ntok; ++i) {
            const int t = t0 + i * tstride;
            const int e0 = eidx[(size_t)t * 128 + lane], e1 = eidx[(size_t)t * 128 + 64 + lane];
            const float g0 = gate[(size_t)t * 128 + lane], g1 = gate[(size_t)t * 128 + 64 + lane];
            const float su0 = SU[e0], su1 = SU[e1], sv0 = SV[e0], sv1 = SV[e1];
            const float sh = TOKC[i * 8 + 0], hoff = 0.5f * TOKC[i * 8 + 1];
            const float p0 = ((float)DOT[i * 128 + lane] + hoff) * su0 * sh, p1 = ((float)DOT[i * 128 + 64 + lane] + hoff) * su1 * sh;
            const float c0 = g0 * 0.5f * p0 * (1.f + erff(p0 * 0.70710678118654752f)) * sv0, c1 = g1 * 0.5f * p1 * (1.f + erff(p1 * 0.70710678118654752f)) * sv1;
            const float cmax = wave_max_u(fmaxf(fabsf(c0), fabsf(c1)));
            const float cinv = cmax > 0.f ? 127.f / cmax : 0.f;
            const int cq0 = __float2int_rn(c0 * cinv), cq1 = __float2int_rn(c1 * cinv);
            const int csq = wave_sum_iu(cq0 + cq1);
            unsigned pk = 0;
            { const int G = (lane >> 3) & 3, gl = lane & 7;
#pragma unroll
              for (int m = 0; m < 4; ++m) { const int slot = 32 * G + gl + 8 * m; const int a = __builtin_amdgcn_ds_bpermute(4 * (slot & 63), cq0), b = __builtin_amdgcn_ds_bpermute(4 * (slot & 63), cq1);
                  pk |= ((unsigned)(G < 2 ? a : b) & 0xffu) << (8 * m); } }
            if (lane < 32) PKL[i * 32 + lane] = pk;
            if (lane == 0) { TOKC[i * 8 + 2] = cmax * (1.f / 127.f); TOKC[i * 8 + 3] = (float)csq; }
        }
        {
            const int nit = 4 * ntok;
            int e0 = 0, e1 = 0, en0 = 0, en1 = 0;
            if (ntok > 0) { e0 = eidx[(size_t)t0 * 128 + lane]; e1 = eidx[(size_t)t0 * 128 + 64 + lane]; }
            if (nit > 1) { const int tn = t0 + (1 % ntok) * tstride; en0 = eidx[(size_t)tn * 128 + lane]; en1 = eidx[(size_t)tn * 128 + 64 + lane]; }
            if (nit > 0) {
#pragma unroll
                for (int s_ = 0; s_ < 16; ++s_) { const unsigned e = (unsigned)__builtin_amdgcn_ds_bpermute(g84 + 32 * (s_ & 7), s_ < 8 ? e0 : e1); r[s_] = *(const u32x4*)(EV4 + (e * 512u + pc16)); }
            }
#pragma unroll 1
            for (int n = 0; n < nit; ++n) {
                const int c = n / ntok, i = n - c * ntok;
                const int n1 = n + 1; const bool more = n1 < nit; const int c1 = more ? n1 / ntok : 0;
                const int t = t0 + i * tstride;
                int ef0 = 0, ef1 = 0;
                { const int n2 = n + 2; const int i2 = n2 % ntok; const int tn = t0 + i2 * tstride; ef0 = eidx[(size_t)tn * 128 + lane]; ef1 = eidx[(size_t)tn * 128 + 64 + lane]; }
                const u32x2 xrw = *(const u32x2*)(ap + (size_t)t * D + 256 * c + 4 * lane); const f32x4 xres = {bf_lo(xrw.x), bf_hi(xrw.x), bf_lo(xrw.y), bf_hi(xrw.y)};
                const unsigned noff = (unsigned)c1 * 128u + pc16;
                int accl[16], accf[16];
#pragma unroll
                for (int G = 0; G < 4; ++G) {
                    const int cp = (int)PKL[i * 32 + 8 * G + g8];
                    unsigned en[4];
#pragma unroll
                    for (int m = 0; m < 4; ++m) { const int s_ = 4 * G + m; en[m] = (unsigned)__builtin_amdgcn_ds_bpermute(g84 + 32 * (s_ & 7), s_ < 8 ? en0 : en1); }
#pragma unroll
                    for (int q = 0; q < 4; ++q) {
                        const unsigned x0 = r[4 * G][q], x1_ = r[4 * G + 1][q], x2 = r[4 * G + 2][q], x3 = r[4 * G + 3][q];
                        const unsigned t0_ = __builtin_amdgcn_perm(x1_, x0, 0x05010400u), t1_ = __builtin_amdgcn_perm(x1_, x0, 0x07030602u);
                        const unsigned t2_ = __builtin_amdgcn_perm(x3, x2, 0x05010400u), t3_ = __builtin_amdgcn_perm(x3, x2, 0x07030602u);
                        unsigned y[4];
                        y[0] = __builtin_amdgcn_perm(t2_, t0_, 0x05040100u); y[1] = __builtin_amdgcn_perm(t2_, t0_, 0x07060302u);
                        y[2] = __builtin_amdgcn_perm(t3_, t1_, 0x05040100u); y[3] = __builtin_amdgcn_perm(t3_, t1_, 0x07060302u);
#pragma unroll
                        for (int cI = 0; cI < 4; ++cI) {
                            const int yl = (int)(y[cI] & 0x0f0f0f0fu), yf = (int)y[cI];
                            if (G == 0) { asm("v_dot4_i32_i8 %0, %1, %2, 0" : "=v"(accl[4 * q + cI]) : "v"(yl), "v"(cp)); asm("v_dot4_i32_i8 %0, %1, %2, 0" : "=v"(accf[4 * q + cI]) : "v"(yf), "v"(cp)); }
                            else { accl[4 * q + cI] = __builtin_amdgcn_sdot4(yl, cp, accl[4 * q + cI], false); accf[4 * q + cI] = __builtin_amdgcn_sdot4(yf, cp, accf[4 * q + cI], false); }
                        }
                    }
#pragma unroll
                    for (int m = 0; m < 4; ++m) r[4 * G + m] = *(const u32x4*)(EV4 + (en[m] * 512u + noff));
                    __builtin_amdgcn_sched_barrier(0);
                }
#pragma unroll
                for (int q = 0; q < 4; ++q) {
                    *(LAS i32x4*)(VIMG + lane * GQ_VROW + 8 * q) = (i32x4){accl[4 * q], accl[4 * q + 1], accl[4 * q + 2], accl[4 * q + 3]};
                    *(LAS i32x4*)(VIMG + lane * GQ_VROW + 8 * q + 4) = (i32x4){accf[4 * q] - accl[4 * q], accf[4 * q + 1] - accl[4 * q + 1], accf[4 * q + 2] - accl[4 * q + 2], accf[4 * q + 3] - accl[4 * q + 3]};
                }
                i32x4 sm = {0, 0, 0, 0};
#pragma unroll
                for (int gl = 0; gl < 8; ++gl) sm += *(const LAS i32x4*)(VIMG + (8 * gl + (lane >> 3)) * GQ_VROW + 4 * (lane & 7));
                const float csc0 = TOKC[i * 8 + 2], csc = (lane & 1) ? csc0 * 0.0625f : csc0, off = ((lane & 1) ? 0.5f : -7.5f) * csc0 * TOKC[i * 8 + 3];
                f32x4 o; o[0] = xres[0] + (float)sm[0] * csc + off; o[1] = xres[1] + (float)sm[1] * csc + off; o[2] = xres[2] + (float)sm[2] * csc + off; o[3] = xres[3] + (float)sm[3] * csc + off;
                *(f32x4*)(out + (size_t)t * D + 256 * c + 4 * lane) = o;
                en0 = ef0; en1 = ef1;
            }
        }
    }
}
#define CE(a, b) do { const float _h = __builtin_fmaxf(a, b), _l = __builtin_fminf(a, b); a = _h; b = _l; } while (0)
#define SORT16(K, B) do { \
    CE(K[(B)+0], K[(B)+1]); CE(K[(B)+2], K[(B)+3]); CE(K[(B)+0], K[(B)+2]); CE(K[(B)+1], K[(B)+3]); \
    CE(K[(B)+1], K[(B)+2]); CE(K[(B)+4], K[(B)+5]); CE(K[(B)+6], K[(B)+7]); CE(K[(B)+4], K[(B)+6]); \
    CE(K[(B)+5], K[(B)+7]); CE(K[(B)+5], K[(B)+6]); CE(K[(B)+0], K[(B)+4]); CE(K[(B)+2], K[(B)+6]); \
    CE(K[(B)+2], K[(B)+4]); CE(K[(B)+1], K[(B)+5]); CE(K[(B)+3], K[(B)+7]); CE(K[(B)+3], K[(B)+5]); \
    CE(K[(B)+1], K[(B)+2]); CE(K[(B)+3], K[(B)+4]); CE(K[(B)+5], K[(B)+6]); CE(K[(B)+8], K[(B)+9]); \
    CE(K[(B)+10], K[(B)+11]); CE(K[(B)+8], K[(B)+10]); CE(K[(B)+9], K[(B)+11]); CE(K[(B)+9], K[(B)+10]); \
    CE(K[(B)+12], K[(B)+13]); CE(K[(B)+14], K[(B)+15]); CE(K[(B)+12], K[(B)+14]); CE(K[(B)+13], K[(B)+15]); \
    CE(K[(B)+13], K[(B)+14]); CE(K[(B)+8], K[(B)+12]); CE(K[(B)+10], K[(B)+14]); CE(K[(B)+10], K[(B)+12]); \
    CE(K[(B)+9], K[(B)+13]); CE(K[(B)+11], K[(B)+15]); CE(K[(B)+11], K[(B)+13]); CE(K[(B)+9], K[(B)+10]); \
    CE(K[(B)+11], K[(B)+12]); CE(K[(B)+13], K[(B)+14]); CE(K[(B)+0], K[(B)+8]); CE(K[(B)+4], K[(B)+12]); \
    CE(K[(B)+4], K[(B)+8]); CE(K[(B)+2], K[(B)+10]); CE(K[(B)+6], K[(B)+14]); CE(K[(B)+6], K[(B)+10]); \
    CE(K[(B)+2], K[(B)+4]); CE(K[(B)+6], K[(B)+8]); CE(K[(B)+10], K[(B)+12]); CE(K[(B)+1], K[(B)+9]); \
    CE(K[(B)+5], K[(B)+13]); CE(K[(B)+5], K[(B)+9]); CE(K[(B)+3], K[(B)+11]); CE(K[(B)+7], K[(B)+15]); \
    CE(K[(B)+7], K[(B)+11]); CE(K[(B)+3], K[(B)+5]); CE(K[(B)+7], K[(B)+9]); CE(K[(B)+11], K[(B)+13]); \
    CE(K[(B)+1], K[(B)+2]); CE(K[(B)+3], K[(B)+4]); CE(K[(B)+5], K[(B)+6]); CE(K[(B)+7], K[(B)+8]); \
    CE(K[(B)+9], K[(B)+10]); CE(K[(B)+11], K[(B)+12]); CE(K[(B)+13], K[(B)+14]); \
} while (0)
#define BMERGE16(K, B) do { \
    CE(K[(B)+0], K[(B)+8]); CE(K[(B)+1], K[(B)+9]); CE(K[(B)+2], K[(B)+10]); CE(K[(B)+3], K[(B)+11]); \
    CE(K[(B)+4], K[(B)+12]); CE(K[(B)+5], K[(B)+13]); CE(K[(B)+6], K[(B)+14]); CE(K[(B)+7], K[(B)+15]); \
    CE(K[(B)+0], K[(B)+4]); CE(K[(B)+1], K[(B)+5]); CE(K[(B)+2], K[(B)+6]); CE(K[(B)+3], K[(B)+7]); \
    CE(K[(B)+8], K[(B)+12]); CE(K[(B)+9], K[(B)+13]); CE(K[(B)+10], K[(B)+14]); CE(K[(B)+11], K[(B)+15]); \
    CE(K[(B)+0], K[(B)+2]); CE(K[(B)+1], K[(B)+3]); CE(K[(B)+4], K[(B)+6]); CE(K[(B)+5], K[(B)+7]); \
    CE(K[(B)+8], K[(B)+10]); CE(K[(B)+9], K[(B)+11]); CE(K[(B)+12], K[(B)+14]); CE(K[(B)+13], K[(B)+15]); \
    CE(K[(B)+0], K[(B)+1]); CE(K[(B)+2], K[(B)+3]); CE(K[(B)+4], K[(B)+5]); CE(K[(B)+6], K[(B)+7]); \
    CE(K[(B)+8], K[(B)+9]); CE(K[(B)+10], K[(B)+11]); CE(K[(B)+12], K[(B)+13]); CE(K[(B)+14], K[(B)+15]); \
} while (0)
typedef short bf16x8s __attribute__((ext_vector_type(8)));
typedef float f32x16 __attribute__((ext_vector_type(16)));
constexpr int TK_LUT_OFF = 0, TK_LDS_END = TK_LUT_OFF + 8 * 8192;
__device__ __forceinline__ void top16_of_64(float (&k)[64]) {
    SORT16(k, 0); SORT16(k, 16); SORT16(k, 32); SORT16(k, 48);
#pragma unroll
    for (int i = 0; i < 16; ++i) { k[i] = __builtin_fmaxf(k[i], k[31 - i]); k[32 + i] = __builtin_fmaxf(k[32 + i], k[63 - i]); }
    BMERGE16(k, 0); BMERGE16(k, 32);
#pragma unroll
    for (int i = 0; i < 16; ++i) k[i] = __builtin_fmaxf(k[i], k[47 - i]);
    BMERGE16(k, 0);
}
__device__ __forceinline__ float ctag(float s, unsigned code) { return __uint_as_float((__float_as_uint(s) & 0xffffff00u) | code); }
__device__ __forceinline__ void topk_load(u32x4 (&w)[8], const bf16_t* __restrict__ srow  ) {
#pragma unroll
    for (int i = 0; i < 8; ++i) w[i] = ((const u32x4*)srow)[i];
}
__device__ __forceinline__ void topk_half(float (&v)[16], u32x4 (&w)[8], const bf16_t* __restrict__ nxt, unsigned hx  ) {
    float k[64];
#pragma unroll
    for (int i = 0; i < 8; ++i)
#pragma unroll
        for (int q = 0; q < 4; ++q) { const unsigned x = w[i][q]; k[8 * i + 2 * q] = __uint_as_float((x << 16) | (unsigned)(8 * i + 2 * q)); k[8 * i + 2 * q + 1] = __uint_as_float((x & 0xffff0000u) | (unsigned)(8 * i + 2 * q + 1)); }
    if (nxt) topk_load(w, nxt);
    top16_of_64(k);
    float r0[16], r1[16];
#pragma unroll
    for (int i = 0; i < 16; ++i) { const unsigned ki = __float_as_uint(k[i]) | hx; const auto rr = __builtin_amdgcn_permlane32_swap(ki, ki, false, false); r0[i] = __uint_as_float(rr[0]); r1[i] = __uint_as_float(rr[1]); }
#pragma unroll
    for (int i = 0; i < 16; ++i) v[i] = __builtin_fmaxf(r0[i], r1[15 - i]);
    BMERGE16(v, 0);
}
__device__ __forceinline__ void topk_task(int tg, int hp, const bf16_t* __restrict__ qv  , LAS unsigned* lut, int* __restrict__ eidx, float* __restrict__ gate, int lane) {
    const int tl = lane & 31, hh = lane >> 5, t = tg * 32 + tl;
    const unsigned hx = (unsigned)hh << 6;
    float v1[16], v2[16];
    {
        const bf16_t* qrow = qv + (size_t)t * NQ + (2 * hp) * 256 + 64 * hh;
        float a[16], b_[16];
        u32x4 wa[8], wb[8];
        topk_load(wa, qrow); topk_load(wb, qrow + 256);
        topk_half(a, wa, qrow + 128, hx);
        __builtin_amdgcn_sched_barrier(0);
        topk_half(b_, wb, qrow + 384, hx);
#pragma unroll
        for (int i = 0; i < 16; ++i) v1[i] = hh ? b_[i] : a[i];
        __builtin_amdgcn_sched_barrier(0);
        topk_half(a, wa, nullptr, hx);
        __builtin_amdgcn_sched_barrier(0);
        topk_half(b_, wb, nullptr, hx);
#pragma unroll
        for (int i = 0; i < 16; ++i) v2[i] = hh ? b_[i] : a[i];
        __builtin_amdgcn_sched_barrier(0);
    }
    const int h = 2 * hp + hh;
    float f1[16], f2[16];
#pragma unroll
    for (int i = 0; i < 16; ++i) {
        const unsigned b1 = __float_as_uint(v1[i]), b2 = __float_as_uint(v2[i]);
        f1[i] = __uint_as_float(b1 & 0xffffff80u); f2[i] = __uint_as_float(b2 & 0xffffff80u);
        lut[i * 64 + lane] = (b1 & 127u) << 7; lut[(16 + i) * 64 + lane] = b2 & 127u;
    }
    float cand[64];
    cand[0] = ctag(f1[0] + f2[0], 255u);
    cand[1] = ctag(f1[0] + f2[1], 254u);
    cand[2] = ctag(f1[0] + f2[2], 253u);
    cand[3] = ctag(f1[0] + f2[3], 252u);
    cand[4] = ctag(f1[0] + f2[4], 251u);
    cand[5] = ctag(f1[0] + f2[5], 250u);
    cand[6] = ctag(f1[0] + f2[6], 249u);
    cand[7] = ctag(f1[0] + f2[7], 248u);
    cand[8] = ctag(f1[0] + f2[8], 247u);
    cand[9] = ctag(f1[0] + f2[9], 246u);
    cand[10] = ctag(f1[0] + f2[10], 245u);
    cand[11] = ctag(f1[0] + f2[11], 244u);
    cand[12] = ctag(f1[0] + f2[12], 243u);
    cand[13] = ctag(f1[0] + f2[13], 242u);
    cand[14] = ctag(f1[0] + f2[14], 241u);
    cand[15] = ctag(f1[0] + f2[15], 240u);
    cand[16] = ctag(f1[1] + f2[0], 239u);
    cand[17] = ctag(f1[1] + f2[1], 238u);
    cand[18] = ctag(f1[1] + f2[2], 237u);
    cand[19] = ctag(f1[1] + f2[3], 236u);
    cand[20] = ctag(f1[1] + f2[4], 235u);
    cand[21] = ctag(f1[1] + f2[5], 234u);
    cand[22] = ctag(f1[1] + f2[6], 233u);
    cand[23] = ctag(f1[1] + f2[7], 232u);
    cand[24] = ctag(f1[2] + f2[0], 223u);
    cand[25] = ctag(f1[2] + f2[1], 222u);
    cand[26] = ctag(f1[2] + f2[2], 221u);
    cand[27] = ctag(f1[2] + f2[3], 220u);
    cand[28] = ctag(f1[2] + f2[4], 219u);
    cand[29] = ctag(f1[3] + f2[0], 207u);
    cand[30] = ctag(f1[3] + f2[1], 206u);
    cand[31] = ctag(f1[3] + f2[2], 205u);
    cand[32] = ctag(f1[3] + f2[3], 204u);
    cand[33] = ctag(f1[4] + f2[0], 191u);
    cand[34] = ctag(f1[4] + f2[1], 190u);
    cand[35] = ctag(f1[4] + f2[2], 189u);
    cand[36] = ctag(f1[5] + f2[0], 175u);
    cand[37] = ctag(f1[5] + f2[1], 174u);
    cand[38] = ctag(f1[6] + f2[0], 159u);
    cand[39] = ctag(f1[6] + f2[1], 158u);
    cand[40] = ctag(f1[7] + f2[0], 143u);
    cand[41] = ctag(f1[7] + f2[1], 142u);
    cand[42] = ctag(f1[8] + f2[0], 127u);
    cand[43] = ctag(f1[9] + f2[0], 111u);
    cand[44] = ctag(f1[10] + f2[0], 95u);
    cand[45] = ctag(f1[11] + f2[0], 79u);
    cand[46] = ctag(f1[12] + f2[0], 63u);
    cand[47] = ctag(f1[13] + f2[0], 47u);
    cand[48] = ctag(f1[14] + f2[0], 31u);
    cand[49] = ctag(f1[15] + f2[0], 15u);
#pragma unroll
    for (int c = 50; c < 64; ++c) cand[c] = -INFINITY;
    top16_of_64(cand);
    float sc[16]; unsigned ex[16];
#pragma unroll
    for (int w = 0; w < 16; ++w) {
        const unsigned b = __float_as_uint(cand[w]), code = 255u - (b & 255u);
        sc[w] = __uint_as_float(b & 0xffffff00u);
        ex[w] = lut[(code >> 4) * 64 + lane] + lut[(16 + (code & 15u)) * 64 + lane];
    }
    float sum = 0.f; const float mx = sc[0];
#pragma unroll
    for (int w = 0; w < 16; ++w) { sc[w] = __expf(sc[w] - mx); sum += sc[w]; }
    const size_t o = ((size_t)t * 8 + h) * 16;
    const float inv = 1.f / sum;
#pragma unroll
    for (int i = 0; i < 4; ++i) { u32x4 w4 = {ex[4 * i], ex[4 * i + 1], ex[4 * i + 2], ex[4 * i + 3]}; *(u32x4*)(eidx + o + 4 * i) = w4; }
#pragma unroll
    for (int i = 0; i < 4; ++i) { f32x4 g4 = {sc[4 * i] * inv, sc[4 * i + 1] * inv, sc[4 * i + 2] * inv, sc[4 * i + 3] * inv}; *(f32x4*)(gate + o + 4 * i) = g4; }
}

typedef short v4i16_t __attribute__((ext_vector_type(4)));
constexpr int AT_K = 0, AT_V = 16384, AT_FK = 32768, AT_BIAS = AT_FK + 2 * 2048, AT_END = AT_BIAS + 4096,
              AT_FL = 73728, AT_DONE = AT_FL + 16, AT_QW = AT_FL + 48;
constexpr float AT_SKIP = 24.f;
__device__ __forceinline__ int crow(int r, int hh) { return (r & 3) + 8 * (r >> 2) + 4 * hh; }

__device__ __forceinline__ float at_max3(float a, float b, float c) { float r; asm("v_max3_f32 %0, %1, %2, %3" : "=v"(r) : "v"(a), "v"(b), "v"(c)); return r; }
__device__ __forceinline__ unsigned at_bf16(float x) { return cvt_pk_bf16(x, 0.f) & 0xffffu; }
__device__ __forceinline__ unsigned at_split3(float x, unsigned& d0) { const unsigned t1 = at_bf16(x); const float r1 = x - __uint_as_float(t1 << 16); const unsigned t2 = at_bf16(r1); const float r2 = r1 - __uint_as_float(t2 << 16); d0 = t1 | (t2 << 16); return at_bf16(r2); }
__device__ __forceinline__ bf16x8s at_mfrag(float m, int hh) { unsigned d0; const unsigned t3 = at_split3(-m, d0); u32x4 w = {0x3f803f80u, 0x3f80u | (d0 << 16), (d0 >> 16) | (t3 << 16), 0u}; if (hh) w = (u32x4){0u, 0u, 0u, 0u}; return __builtin_bit_cast(bf16x8s, w); }
constexpr float AT_THR = 6.f;
template <int MODE  >
__device__ __forceinline__ void attn_step(f32x16 (&o)[2], float& mhat, float& l, const bf16x8s (&qf)[4], const LAS unsigned char* Kt, const LAS unsigned char* Vt, const LAS unsigned char* AKt, bf16x8s& mfr,
                                          const LAS float* biasrow, int qg, int kv0, int lane, bool diag = false  ) {
    const int tl = lane & 31, hh = lane >> 5;
    const LAS unsigned char* kb = Kt + tl * 128; const int ksw = (tl >> 1) & 7;
    bf16x8s kf[2][4];
#pragma unroll
    for (int kvt = 0; kvt < 2; ++kvt)
#pragma unroll
        for (int ks = 0; ks < 4; ++ks) kf[kvt][ks] = *(const LAS bf16x8s*)(kb + kvt * 4096 + (((2 * ks + hh) ^ ksw) * 16));
    bf16x8s af[2];
    if (MODE < 2) {
#pragma unroll
        for (int kvt = 0; kvt < 2; ++kvt) af[kvt] = *(const LAS bf16x8s*)(AKt + (32 * kvt + tl) * 32 + hh * 16);
    } else {
        u32x4 w = {0u, 0x3f800000u, 0x3f803f80u, 0u}; if (hh) w = (u32x4){0u, 0u, 0u, 0u};
        af[0] = __builtin_bit_cast(bf16x8s, w); af[1] = af[0];
    }
    f32x16 p[2];
    const LAS unsigned char* vb = Vt + (4 * hh + ((lane & 15) >> 2)) * 64 + ((lane >> 4) & 1) * 32 + (lane & 3) * 8;
    bf16x8s vf[2][2][2];
#pragma unroll
    for (int kvt = 0; kvt < 2; ++kvt)
#pragma unroll
        for (int s = 0; s < 2; ++s)
#pragma unroll
            for (int d0 = 0; d0 < 2; ++d0) {
                const v4i16_t lo = __builtin_amdgcn_ds_read_tr16_b64_v4i16((LAS v4i16_t*)(vb + d0 * 4096 + kvt * 2048 + s * 1024));
                const v4i16_t hi = __builtin_amdgcn_ds_read_tr16_b64_v4i16((LAS v4i16_t*)(vb + d0 * 4096 + kvt * 2048 + s * 1024 + 512));
                vf[kvt][s][d0] = (bf16x8s){lo[0], lo[1], lo[2], lo[3], hi[0], hi[1], hi[2], hi[3]};
            }
    __builtin_amdgcn_sched_barrier(0);
#pragma unroll
    for (int kvt = 0; kvt < 2; ++kvt) {
        const f32x16 z = {0.f, 0.f, 0.f, 0.f, 0.f, 0.f, 0.f, 0.f, 0.f, 0.f, 0.f, 0.f, 0.f, 0.f, 0.f, 0.f};
        p[kvt] = __builtin_amdgcn_mfma_f32_32x32x16_bf16(af[kvt], mfr, z, 0, 0, 0);
#pragma unroll
        for (int ks = 0; ks < 4; ++ks) p[kvt] = __builtin_amdgcn_mfma_f32_32x32x16_bf16(kf[kvt][ks], qf[ks], p[kvt], 0, 0, 0);
    }
    if (MODE == 1 || (MODE == 0 && diag)) {
#pragma unroll
        for (int kvt = 0; kvt < 2; ++kvt)
#pragma unroll
            for (int r = 0; r < 16; ++r) { const int kv = kv0 + 32 * kvt + crow(r, hh); p[kvt][r] = (kv > qg) ? -INFINITY : p[kvt][r]; }
    }
    if (MODE == 2) {
        const LAS float* bp = biasrow + (191 - qg + kv0 + 4 * hh);
#pragma unroll
        for (int kvt = 0; kvt < 2; ++kvt)
#pragma unroll
            for (int r = 0; r < 16; ++r) {
                p[kvt][r] += bp[32 * kvt + crow(r, 0)];
            }
    }
    float mx = at_max3(p[0][0], p[1][0], p[0][1]), mx2 = at_max3(p[1][1], p[0][2], p[1][2]);
#pragma unroll
    for (int r = 3; r < 15; r += 2) { mx = at_max3(mx, p[0][r], p[1][r]); mx2 = at_max3(mx2, p[0][r + 1], p[1][r + 1]); }
    mx = at_max3(mx, p[0][15], p[1][15]); mx = __builtin_fmaxf(mx, mx2);
    { const auto rr = __builtin_amdgcn_permlane32_swap(__float_as_uint(mx), __float_as_uint(mx), false, false); mx = __builtin_fmaxf(__uint_as_float(rr[0]), __uint_as_float(rr[1])); }
    if (__any(mx > AT_THR)) {
        const float dl = __builtin_fmaxf(mx, 0.f), f = __builtin_amdgcn_exp2f(-dl);
        mhat += dl; l *= f; mfr = at_mfrag(mhat, hh);
#pragma unroll
        for (int kvt = 0; kvt < 2; ++kvt)
#pragma unroll
            for (int r = 0; r < 16; ++r) p[kvt][r] -= dl;
#pragma unroll
        for (int d0 = 0; d0 < 2; ++d0)
#pragma unroll
            for (int r = 0; r < 16; ++r) o[d0][r] *= f;
    }
    float sum = 0.f;
#pragma unroll
    for (int kvt = 0; kvt < 2; ++kvt)
#pragma unroll
        for (int r = 0; r < 16; ++r) { const float e = __builtin_amdgcn_exp2f(p[kvt][r]); p[kvt][r] = e; sum += e; }
    l += sum;
#pragma unroll
    for (int kvt = 0; kvt < 2; ++kvt)
#pragma unroll
        for (int s = 0; s < 2; ++s) {
            u32x4 pw;
#pragma unroll
            for (int i = 0; i < 4; ++i) pw[i] = cvt_pk_bf16(p[kvt][8 * s + 2 * i], p[kvt][8 * s + 2 * i + 1]);
            const bf16x8s pf = __builtin_bit_cast(bf16x8s, pw);
#pragma unroll
            for (int d0 = 0; d0 < 2; ++d0) o[d0] = __builtin_amdgcn_mfma_f32_32x32x16_bf16(vf[kvt][s][d0], pf, o[d0], 0, 0, 0);
        }
}

template <bool FOX>
__device__ __forceinline__ void attn_unit(LAS unsigned char* ldsl, int b, int hk, int qblk, const bf16_t* __restrict__ Q, const bf16_t* __restrict__ K, const bf16_t* __restrict__ V, int kvpitch,
                                          const float* __restrict__ F2, const float* __restrict__ sinks, bf16_t* __restrict__ MIX, int wave, int lane, unsigned serial, float sbound) {
    const int tid = threadIdx.x, tl = lane & 31, hh = lane >> 5;
    const size_t rowbase = (size_t)b * SEQ;
    int head, qw0, t_begin, t_end, wl;
    if (FOX) { head = hk; qw0 = qblk * 256 + 32 * wave; t_begin = 0; t_end = 4 * qblk + 4; wl = 4 * qblk + (wave >> 1); }
    else { head = hk * 4 + (wave >> 1); qw0 = qblk * 64 + 32 * (wave & 1); t_begin = qblk >= 2 ? qblk - 2 : 0; t_end = qblk + 1; wl = t_end; }
    const int qg = qw0 + tl;
    bf16x8s qf[4];
    { const bf16_t* qp = Q + (rowbase + qg) * 512 + head * 64 + 8 * hh;
#pragma unroll
      for (int ks = 0; ks < 4; ++ks) qf[ks] = *(const bf16x8s*)(qp + 16 * ks); }
    const float* Fr = F2 + ((size_t)b * 8 + head) * SEQ;
    float m, l;
    if (FOX) { m = 0.f; l = 0.f; } else { m = sinks[head] * LOG2E; l = hh == 0 ? 1.f : 0.f; }
    bf16x8s mfr = at_mfrag(m, hh);
    f32x16 o[2];
#pragma unroll
    for (int d0 = 0; d0 < 2; ++d0)
#pragma unroll
        for (int r = 0; r < 16; ++r) o[d0][r] = 0.f;
    const int skv = tid >> 3, sc = tid & 7;
    const bf16_t* kg = K + (rowbase + skv) * kvpitch + hk * 64 + sc * 8;
    const bf16_t* vg = V + (rowbase + skv) * kvpitch + hk * 64 + sc * 8;
    const int kwoff = skv * 128 + ((sc ^ ((skv >> 1) & 7)) * 16), vwoff = (sc >> 2) * 4096 + skv * 64 + (sc & 3) * 16;
    u32x4 kA, vA, kB, vB; float fA = 0.f, fB = 0.f;
#define AT_LOAD(t, KR, VR, FR) do { const int tt_ = (t) > t_begin ? (t) : t_begin; KR = *(const u32x4*)(kg + (size_t)tt_ * 64 * kvpitch); VR = *(const u32x4*)(vg + (size_t)tt_ * 64 * kvpitch); if (FOX) FR = Fr[tt_ * 64 + lane]; } while (0)
#define AT_WRITE(buf, KR, VR, FR) do { *(LAS u32x4*)(ldsl + AT_K + (buf) * 8192 + kwoff) = KR; *(LAS u32x4*)(ldsl + AT_V + (buf) * 8192 + vwoff) = VR; if (FOX && tid < 64) { unsigned d0_; const unsigned t3_ = at_split3(-FR, d0_); LAS u32x4* ak_ = (LAS u32x4*)(ldsl + AT_FK + (buf) * 2048 + tid * 32); ak_[0] = (u32x4){d0_, t3_ | 0x3f800000u, 0x3f803f80u, 0u}; ak_[1] = (u32x4){0u, 0u, 0u, 0u}; if (tid == 63) *(LAS float*)(ldsl + AT_FL + (buf) * 4) = -FR; } } while (0)
    AT_LOAD(t_end - 1, kA, vA, fA); AT_LOAD(t_end - 2, kB, vB, fB);
    AT_WRITE(0, kA, vA, fA);
    __syncthreads();
    const LAS float* biasrow = (const LAS float*)(ldsl + AT_BIAS) + head * 128;
#define AT_STEP(KL, VL, FL, KW, VW, FW) do { \
        const int cur = (t_end - 1 - t) & 1; \
        AT_LOAD(t - 2, KL, VL, FL); \
        const LAS unsigned char* Kt = ldsl + AT_K + cur * 8192; const LAS unsigned char* Vt = ldsl + AT_V + cur * 8192; const LAS unsigned char* Fk = ldsl + AT_FK + cur * 2048; \
        if (FOX) { \
            if (!wdone && t < wl) {     \
                const float fl_ = *(const LAS float*)(ldsl + AT_FL + cur * 4); \
                if (sbound + fl_ + wave_max_u(-m) < -AT_SKIP) { wdone = true; if (lane == 0) *(LAS unsigned*)(ldsl + AT_DONE + wave * 4) = serial; } \
            } \
            if (!wdone) { \
                if (t <= wl) attn_step<0>(o, m, l, qf, Kt, Vt, Fk, mfr, biasrow, qg, t * 64, lane, t == wl);     \
            } \
        } else attn_step<2>(o, m, l, qf, Kt, Vt, Fk, mfr, biasrow, qg, t * 64, lane); \
        if (t > t_begin) AT_WRITE(cur ^ 1, KW, VW, FW); \
        __syncthreads(); \
        if (FOX) { const bool d_ = lane < 8 ? (*(const LAS unsigned*)(ldsl + AT_DONE + lane * 4) == serial) : true; bdone = __all(d_); }     \
    } while (0)
    bool wdone = false, bdone = false;
    for (int t = t_end - 1;;) {
        AT_STEP(kA, vA, fA, kB, vB, fB); if (bdone || --t < t_begin) break;
        AT_STEP(kB, vB, fB, kA, vA, fA); if (bdone || --t < t_begin) break;
    }
#undef AT_STEP
#undef AT_LOAD
#undef AT_WRITE
    { const auto rr = __builtin_amdgcn_permlane32_swap(__float_as_uint(l), __float_as_uint(l), false, false); l = __uint_as_float(rr[0]) + __uint_as_float(rr[1]); }
    const float inv = 1.f / l;
    bf16_t* op = MIX + (rowbase + qg) * D + (FOX ? 512 : 0) + head * 64 + 4 * hh;
#pragma unroll
    for (int d0 = 0; d0 < 2; ++d0)
#pragma unroll
        for (int j = 0; j < 4; ++j) {
            u32x2 w; w.x = cvt_pk_bf16(o[d0][4 * j] * inv, o[d0][4 * j + 1] * inv); w.y = cvt_pk_bf16(o[d0][4 * j + 2] * inv, o[d0][4 * j + 3] * inv);
            *(u32x2*)(op + 32 * d0 + 8 * j) = w;
        }
}

constexpr int AT_SWA_V = 0, AT_SWA_K = 32768, AT_SWA_BIAS = 65536;
__device__ __forceinline__ void attn_swa_unit(LAS unsigned char* ldsl, int b, int kvh, int qb, const bf16_t* __restrict__ Q, const bf16_t* __restrict__ K, const bf16_t* __restrict__ V,
                                              const float* __restrict__ sinks, bf16_t* __restrict__ MIX, int wave, int lane) {
    const int tid = threadIdx.x, tl = lane & 31, hh = lane >> 5;
    const size_t rowbase = (size_t)b * SEQ;
    const int q0 = qb * 128, tbase = 2 * qb - 2;
    const int head = kvh * 4 + (wave >> 1);
    const int skv = tid >> 3, sc = tid & 7;
    const int kwoff = skv * 128 + ((sc ^ ((skv >> 1) & 7)) * 16), vwoff = (sc >> 2) * 4096 + skv * 64 + (sc & 3) * 16;
    u32x4 kr[4], vr[4];
#pragma unroll
    for (int sl = 0; sl < 4; ++sl) { const int tt = tbase + sl < 0 ? 0 : tbase + sl; const size_t off = (rowbase + (size_t)tt * 64 + skv) * 128 + kvh * 64 + sc * 8; kr[sl] = *(const u32x4*)(K + off); vr[sl] = *(const u32x4*)(V + off); }
#pragma unroll
    for (int sl = 0; sl < 4; ++sl) { *(LAS u32x4*)(ldsl + AT_SWA_K + sl * 8192 + kwoff) = kr[sl]; *(LAS u32x4*)(ldsl + AT_SWA_V + sl * 8192 + vwoff) = vr[sl]; }
    __syncthreads();
    const LAS float* biasrow = (const LAS float*)(ldsl + AT_SWA_BIAS) + head * 256;
    const float sink2 = sinks[head] * LOG2E;
#pragma unroll 1
    for (int ps = 0; ps < 2; ++ps) {
        const int qg = q0 + 64 * ps + 32 * (wave & 1) + tl;
        bf16x8s qf[4];
        { const bf16_t* qp = Q + (rowbase + qg) * 512 + head * 64 + 8 * hh;
#pragma unroll
          for (int ks = 0; ks < 4; ++ks) qf[ks] = *(const bf16x8s*)(qp + 16 * ks); }
        float m = sink2, l = hh == 0 ? 1.f : 0.f;
        bf16x8s mfr = at_mfrag(m, hh);
        f32x16 o[2];
#pragma unroll
        for (int d0 = 0; d0 < 2; ++d0)
#pragma unroll
            for (int r = 0; r < 16; ++r) o[d0][r] = 0.f;
#pragma unroll 1
        for (int j = 2; j >= 0; --j) {
            const int sl = ps + j, t = tbase + sl;
            if (t >= 0) attn_step<2>(o, m, l, qf, ldsl + AT_SWA_K + sl * 8192, ldsl + AT_SWA_V + sl * 8192, ldsl, mfr, biasrow, qg, t * 64, lane);
        }
        { const auto rr = __builtin_amdgcn_permlane32_swap(__float_as_uint(l), __float_as_uint(l), false, false); l = __uint_as_float(rr[0]) + __uint_as_float(rr[1]); }
        const float inv = 1.f / l;
        bf16_t* op = MIX + (rowbase + qg) * D + head * 64 + 4 * hh;
#pragma unroll
        for (int d0 = 0; d0 < 2; ++d0)
#pragma unroll
            for (int jj = 0; jj < 4; ++jj) {
                u32x2 w; w.x = cvt_pk_bf16(o[d0][4 * jj] * inv, o[d0][4 * jj + 1] * inv); w.y = cvt_pk_bf16(o[d0][4 * jj + 2] * inv, o[d0][4 * jj + 3] * inv);
                *(u32x2*)(op + 32 * d0 + 8 * jj) = w;
            }
    }
    __syncthreads();
}

__device__ __forceinline__ void attn_phase(LAS unsigned char* ldsl, const bf16_t* QA, const bf16_t* KA, const bf16_t* VA, const bf16_t* QB, const bf16_t* KB, const bf16_t* VB,
                                           const float* __restrict__ F2, const float* __restrict__ sinks, const float* __restrict__ relb, const float* __restrict__ gqb, const float* __restrict__ gkb,
                                           bf16_t* MIX, unsigned* qctr  , int G, int wave, int lane) {
    for (int i = threadIdx.x; i < 8 * 256; i += 512) { const int h = i >> 8, dist = 191 - (i & 255); ((LAS float*)(ldsl + AT_SWA_BIAS))[i] = (unsigned)dist < 128u ? relb[(int)T5B[dist & 127] * 8 + h] * LOG2E : -INFINITY; }
    if (threadIdx.x < 8) *(LAS unsigned*)(ldsl + AT_DONE + threadIdx.x * 4) = 0u;
    const float sbound = 64.f * C2 * 1.02f * wave_max_u(fabsf(gqb[lane])) * wave_max_u(fabsf(gkb[lane]));
    __syncthreads();
    unsigned serial = 0;
    for (;;) {
        if (threadIdx.x == 0) *(LAS unsigned*)(ldsl + AT_QW) = __hip_atomic_fetch_add(qctr, 1u, __ATOMIC_RELAXED, __HIP_MEMORY_SCOPE_AGENT);
        __syncthreads();
        const unsigned u = *(const LAS unsigned*)(ldsl + AT_QW);
        __syncthreads();
        if (u >= 768u) break;
        if (u < 512u) { const int bh = (int)(u & 31u), qb = 15 - (int)(u >> 5); ++serial;
            attn_unit<true>(ldsl, bh >> 3, bh & 7, qb, QB, KB, VB, 512, F2, sinks, MIX, wave, lane, serial, sbound); }
        else { const int us = (int)u - 512; attn_swa_unit(ldsl, us >> 6, (us >> 5) & 1, us & 31, QA, KA, VA, sinks, MIX, wave, lane); }
    }
}
#define RLX_AGENT __ATOMIC_RELAXED, __HIP_MEMORY_SCOPE_AGENT
#define XB_TMO      128
#define XB_XCNT(j)  (256  + 64 * (j))
#define XB_XSUB(j)  (1280 + 64 * (j))
#define XB_XGEN(j)  (2304 + 64 * (j))
#define XB_TOP      3328
#define XB_TOPGEN   3392
#define XCD_BAR_WORDS 3456
#define XB_SPIN_CAP (1u << 22)

__device__ __forceinline__ unsigned xb_ld(unsigned* p)              { return __hip_atomic_load(p, __ATOMIC_RELAXED, __HIP_MEMORY_SCOPE_AGENT); }
__device__ __forceinline__ unsigned xb_add(unsigned* p, unsigned v) { return __hip_atomic_fetch_add(p, v, __ATOMIC_RELAXED, __HIP_MEMORY_SCOPE_AGENT); }
__device__ __forceinline__ unsigned xb_xcc_id() { return (unsigned)__builtin_amdgcn_s_getreg((3 << 11) | 20) & 0xFu; }
#define XB_SPIN(cond, bar) do { unsigned _sp = 0; while (cond) { __builtin_amdgcn_s_sleep(1); \
    if ((++_sp & 255u) == 0u) { if (xb_ld(&(bar)[XB_TMO])) break; if (_sp > XB_SPIN_CAP) { atomicAdd(&(bar)[XB_TMO], 1u); break; } } } } while (0)

struct XcdBarrier {
    unsigned* bar; unsigned x;
    volatile LAS unsigned* st;
};

__device__ __forceinline__ XcdBarrier xcd_barrier_post(unsigned* bar, volatile LAS unsigned* st) {
    XcdBarrier b; b.bar = bar; b.x = xb_xcc_id(); b.st = st;
    if (threadIdx.x == 0) (void)xb_add(&bar[XB_XCNT(b.x)], 1u);
    return b;
}
__device__ __forceinline__ void xcd_barrier_complete(unsigned* bar, unsigned x, unsigned& nloc, unsigned& nx) {
    const unsigned G = gridDim.x * gridDim.y * gridDim.z;
    unsigned sum, cnt, mine, sp = 0u;
    for (;;) {
        sum = 0u; cnt = 0u; mine = 0u;
#pragma unroll
        for (unsigned j = 0; j < 16; ++j) { const unsigned c = xb_ld(&bar[XB_XCNT(j)]); sum += c; cnt += (c > 0u) ? 1u : 0u; mine = (j == x) ? c : mine; }
        if (sum == G) break;
        __builtin_amdgcn_s_sleep(1);
        if ((++sp & 255u) == 0u) { if (xb_ld(&bar[XB_TMO])) break; if (sp > XB_SPIN_CAP) { atomicAdd(&bar[XB_TMO], 1u); break; } }
    }
    nloc = mine > 0u ? mine : 1u; nx = cnt > 0u ? cnt : 1u;
}

__device__ __forceinline__ void xcd_barrier(const XcdBarrier& b) {
    asm volatile("s_waitcnt vmcnt(0)" ::: "memory");
    __syncthreads();
    if (threadIdx.x == 0) {
        unsigned* bar = b.bar;
        __builtin_amdgcn_s_waitcnt(0);
        unsigned nloc = b.st[0], nx = b.st[1];
        if (nloc == 0u) { xcd_barrier_complete(bar, b.x, nloc, nx); b.st[0] = nloc; b.st[1] = nx; }
        const unsigned old = xb_add(&bar[XB_XSUB(b.x)], 1u);
        const unsigned gen = old / nloc;
        if (old + 1u == (gen + 1u) * nloc) {
            __builtin_amdgcn_fence(__ATOMIC_RELEASE, "agent");
            asm volatile("s_waitcnt vmcnt(0)" ::: "memory");
            const unsigned og = xb_add(&bar[XB_TOP], 1u);
            const unsigned tg = og / nx;
            if (og + 1u == (tg + 1u) * nx) xb_add(&bar[XB_TOPGEN], 1u);
            else XB_SPIN(xb_ld(&bar[XB_TOPGEN]) == tg, bar);
            __builtin_amdgcn_fence(__ATOMIC_ACQUIRE, "agent");
            xb_add(&bar[XB_XGEN(b.x)], 1u);
            asm volatile("s_waitcnt vmcnt(0)" ::: "memory");
        } else {
            XB_SPIN(xb_ld(&bar[XB_XGEN(b.x)]) == gen, bar);
            __builtin_amdgcn_fence(__ATOMIC_ACQUIRE, "agent");
            asm volatile("s_waitcnt vmcnt(0)" ::: "memory");
        }
    }
    __syncthreads();
}
constexpr int LDS_BYTES = 147456;
struct Params { const float* in[17]; float* out; unsigned char* ws; };

__global__ void __launch_bounds__(512, 2) mega(Params p) {
    extern __shared__ __attribute__((aligned(16))) unsigned char lds[];
    const float* x = p.in[0]; const float* relb = p.in[1]; const float* norm_mix = p.in[2]; const float* w_in = p.in[3];
    const float* gqa = p.in[4]; const float* gka = p.in[5]; const float* gqb = p.in[6]; const float* gkb = p.in[7];
    const float* bforget = p.in[8]; const float* sinks = p.in[9]; const float* w_out = p.in[10]; const float* norm_ffn = p.in[11];
    const float* w_query = p.in[12]; const float* sk1 = p.in[13]; const float* sk2 = p.in[14]; const float* eu = p.in[15]; const float* ev = p.in[16];
    float* out = p.out; unsigned char* ws = p.ws;
    bf16_t* WTIN = (bf16_t*)(ws + WS_WTIN); bf16_t* WTOUT = (bf16_t*)(ws + WS_WTOUT); bf16_t* WTQ = (bf16_t*)(ws + WS_WTQ);
    float* LOGF = (float*)(ws + WS_LOGF); float* F2 = (float*)(ws + WS_F2); float* SSQ = (float*)(ws + WS_SSQ);
    int* EIDX = (int*)(ws + WS_EIDX); float* GATE = (float*)(ws + WS_GATE);
    bf16_t* XN = (bf16_t*)(ws + WS_XN); bf16_t* AP = XN;
    bf16_t* QA = (bf16_t*)(ws + WS_QA); bf16_t* KA = (bf16_t*)(ws + WS_KA); bf16_t* VA = (bf16_t*)(ws + WS_VA);
    bf16_t* QB = (bf16_t*)(ws + WS_QB); bf16_t* KB = (bf16_t*)(ws + WS_KB); bf16_t* VB = (bf16_t*)(ws + WS_VB);
    bf16_t* MIX = (bf16_t*)(ws + WS_MIX); bf16_t* QV = (bf16_t*)(ws + WS_QV);

    unsigned char* EU8 = ws + WS_EU8; unsigned char* EV8 = ws + WS_EV8; float* SU = (float*)(ws + WS_SU); float* SV = (float*)(ws + WS_SV); float* RR = (float*)(ws + WS_RR);
    const int tid = threadIdx.x, lane = tid & 63, wave = __builtin_amdgcn_readfirstlane(tid >> 6);
    const int G = gridDim.x, gw = blockIdx.x * 8 + wave, NGW = G * 8;
    LAS unsigned char* ldsl = (LAS unsigned char*)lds;
    if (tid < 4) ((LAS unsigned*)(ldsl + LDS_BYTES - 16))[tid] = 0u;
    __syncthreads();
    const XcdBarrier xbar = xcd_barrier_post((unsigned*)(ws + WS_CTL), (volatile LAS unsigned*)(ldsl + LDS_BYTES - 16));

    {
        LAS float* scr = (LAS float*)(ldsl + wave * 16384);
        constexpr int I_IN = 16 * (NQKV / 32), I_OUT = 16 * (D / 32), I_Q = 16 * 32 * 4;
        for (int it = gw; it < I_IN + I_OUT + I_Q; it += NGW) {
            int r = it;
            if (r < I_Q) { p0_keyfold_item(w_query, sk1, sk2, norm_ffn, WTQ, r, lane); continue; } r -= I_Q;
            if (r < I_IN) { p0_transpose_item<true, true>(w_in, INW, D, NQKV / 32, WTIN, scr, r, lane, norm_mix); continue; } r -= I_IN;
            p0_transpose_item<false>(w_out, D, D, D / 32, WTOUT, scr, r, lane);
        }
        p0_rows(x, norm_mix, w_in, bforget, XN, RR, LOGF, gw, NGW, lane);
    }
    xcd_barrier(xbar);
    {
        { const int cb = G >= 128 ? (int)blockIdx.x - (G - 32) : (int)blockIdx.x;
          if (cb >= 0 && cb < 32) p1_cumsum(cb, (LAS float*)ldsl, LOGF, F2); }
        pg8::Gemm g{XN, WTIN, M, NQKV, D}; pg8::StaticOrder S; S.init(M, NQKV, G, (int)blockIdx.x);
        EpiQKV E{QA, KA, VA, QB, KB, VB, gqa, gka, gqb, gkb, RR};
        pg8::gemm_phase<EpiQKV, pg8::StaticOrder, true, true>(ldsl, g, S, E);
        { const int nfull = (M / 256) * (NQKV / 256) - 2 * G;
          if (nfull > 0 && nfull < G) { if ((int)blockIdx.x >= nfull) { const int qw = ((int)blockIdx.x - nfull) * 8 + wave, NQW = (G - nfull) * 8; p0_quant4_rows<1>(eu, EU8, SU, qw, NQW, lane); p0_quant4_rows<2>(ev, EV8, SV, qw, NQW, lane); } }
          else { p0_quant4_rows<1>(eu, EU8, SU, gw, NGW, lane); p0_quant4_rows<2>(ev, EV8, SV, gw, NGW, lane); } }
    }
    xcd_barrier(xbar);
    attn_phase(ldsl, QA, KA, VA, QB, KB, VB, F2, sinks, relb, gqb, gkb, MIX, (unsigned*)(ws + WS_CTL) + 3584, G, wave, lane);
    xcd_barrier(xbar);
    {
        pg8::Gemm g{MIX, WTOUT, M, D, D}; pg8::StaticOrder S; S.init(M, D, G, (int)blockIdx.x);
        EpiOut E{AP, SSQ};
        pg8::gemm_phase<EpiOut, pg8::StaticOrder, true, true>(ldsl, g, S, E);
    }
    xcd_barrier(xbar);
    {
        pg8::Gemm g{AP, WTQ, M, NQ, D}; pg8::StaticOrder S; S.init(M, NQ, G, (int)blockIdx.x);
        EpiQV E{QV, SSQ};
        pg8::gemm_phase<EpiQV, pg8::StaticOrder, true, true>(ldsl, g, S, E);
    }
    xcd_barrier(xbar);
    {
        LAS unsigned* lut = (LAS unsigned*)(ldsl + TK_LUT_OFF + wave * 8192);
        for (int task = gw; task < (M / 32) * 4; task += NGW) topk_task(task >> 2, task & 3, QV, lut, EIDX, GATE, lane);
    }
    const bool p6local = NGW == (M / 32) * 4 && NGW * 8 == M;
    if (p6local) { __builtin_amdgcn_fence(__ATOMIC_RELEASE, "workgroup"); __syncthreads(); __builtin_amdgcn_fence(__ATOMIC_ACQUIRE, "workgroup"); }
    else xcd_barrier(xbar);
    { auto gbar = [&]() { xcd_barrier(xbar); };
      const int tfirst = p6local ? 64 * (int)blockIdx.x + 8 * wave : gw, tstep = 8 * NGW, tstride = p6local ? 1 : NGW, ntb = p6local ? 1 : (M + 8 * NGW - 1) / (8 * NGW);
      gather_chunked(AP, SSQ, norm_ffn, EIDX, GATE, EU8, EV8, SU, SV, out, ldsl + wave * GQ_WAVE, tfirst, tstep, tstride, ntb, lane, gbar); }
}
}

extern "C" void kernel_launch(void* const* d_in, const int* in_sizes, int n_in, void* d_out, int out_size, void* d_ws, size_t ws_size, hipStream_t stream) {
    static int grid_blocks = 0;
    if (!grid_blocks) {
        int dev = 0, cus = 0, per_cu = 0;
        (void)hipGetDevice(&dev);
        (void)hipDeviceGetAttribute(&cus, hipDeviceAttributeMultiprocessorCount, dev);
        (void)hipFuncSetAttribute((const void*)mk::mega, hipFuncAttributeMaxDynamicSharedMemorySize, mk::LDS_BYTES);
        (void)hipOccupancyMaxActiveBlocksPerMultiprocessor(&per_cu, (const void*)mk::mega, 512, (size_t)mk::LDS_BYTES);
        if (per_cu < 1) fprintf(stderr, "occupancy query says %d blocks/CU\n", per_cu);
        grid_blocks = cus;
    }
    (void)hipMemsetAsync(d_ws, 0, 16384, stream);
    mk::Params p{};
    for (int i = 0; i < 17; ++i) p.in[i] = (const float*)d_in[i];
    p.out = (float*)d_out; p.ws = (unsigned char*)d_ws;
    void* args[] = {&p};
    hipError_t e = hipLaunchCooperativeKernel((void*)mk::mega, dim3(grid_blocks), dim3(512), args, (size_t)mk::LDS_BYTES, stream);
    if (e != hipSuccess) fprintf(stderr, "cooperative launch failed: %s (grid %d)\n", hipGetErrorString(e), grid_blocks);
}
```

```cpp
#include <hip/hip_runtime.h>
#include <cstdint>
#include <cstdio>
namespace pg8 {
#define PG8_LAS __attribute__((address_space(3)))
typedef unsigned short bf16_t;
typedef short bf16x8 __attribute__((ext_vector_type(8)));
typedef float f32x4 __attribute__((ext_vector_type(4)));
typedef unsigned u32x4 __attribute__((ext_vector_type(4)));
constexpr int BM = 256, BK = 64, HALF = 128, HTB = HALF * BK * 2  , STAGE_BYTES = 8 * HTB, NXCD = 8, WGM = 8;

__host__ __device__ __forceinline__ int lds_byte(int r, int c) { const int st = (r >> 4) * 2 + (c >> 5), rr = r & 15, cc = c & 31, ob = rr * 64 + cc * 2; return st * 1024 + (ob ^ (((ob >> 9) & 1) << 5)); }
__host__ __device__ __forceinline__ void stage_rc(int b, int& R, int& C) { const int st = b / 1024, sb = b % 1024, swz = sb ^ (((sb >> 9) & 1) << 5); R = (st >> 1) * 16 + swz / 64; C = (st & 1) * 32 + (swz % 64) / 2; }
__host__ __device__ __forceinline__ int perm32(int rho) { const int n = rho >> 4, i = rho & 15; return 8 * (i >> 2) + 4 * n + (i & 3); }

struct Unit { int pm, pn; };
struct Gemm { const bf16_t* A; const bf16_t* Bt; int M, N, K; };

struct StaticOrder {
    int nM, nN, nwg, G, c;
    __host__ __device__ void init(int M, int N, int G_, int c_) { nM = M / BM; nN = N / BM; nwg = nM * nN; G = G_; c = c_; }
    __host__ __device__ bool next(int i, Unit& u) const {
        const long L = (long)i * G + c; if (L >= nwg) return false;
        int wgid = (int)L; { const int q = nwg / NXCD, r = nwg % NXCD, xcd = wgid % NXCD, off = wgid / NXCD; wgid = (xcd < r ? xcd * (q + 1) : r * (q + 1) + (xcd - r) * q) + off; }
        const int nig = WGM * nN, gid = wgid / nig, fm = gid * WGM, gsz = (nM - fm) < WGM ? (nM - fm) : WGM;
        u.pm = fm + ((wgid % nig) % gsz); u.pn = (wgid % nig) / gsz; return true;
    }
    __device__ __forceinline__ void a_ready(const Unit&) const {}
    __device__ __forceinline__ void done(const Unit&) const {}
};

__device__ __forceinline__ unsigned cvt_pk_bf16(float lo, float hi) { unsigned r; asm volatile("v_cvt_pk_bf16_f32 %0, %1, %2" : "=v"(r) : "v"(lo), "v"(hi)); return r; }
typedef float f32x2 __attribute__((ext_vector_type(2)));
template <class Epi, class Sched, bool ALIGN_EPI = false, bool SP2 = false>
__device__ __forceinline__ void gemm_phase(PG8_LAS unsigned char* lds, const Gemm g, const Sched& S, const Epi& E) {
    int tid_ = threadIdx.x; asm volatile("" : "+v"(tid_));
    const int tid = tid_, wid = __builtin_amdgcn_readfirstlane(tid >> 6), lane = tid & 63, wr = wid >> 2, wc = wid & 3, fr = lane & 15, fq = lane >> 4;
    const int K = g.K, nt = K / BK;
    unsigned voffA[2], voffB[2];
#pragma unroll
    for (int i = 0; i < 2; ++i) { int R, C; stage_rc(tid * 16 + i * 8192, R, C); const int Rb = Epi::PERM ? ((R & ~31) + perm32(R & 31)) : R;
        voffA[i] = (unsigned)(R * K + C) * 2u; voffB[i] = (unsigned)(Rb * K + C) * 2u; }
    const size_t kstep = (size_t)(BK * 2);
    const size_t hstep = (size_t)HALF * K * 2;
    const size_t tstep = 2 * hstep;
    const unsigned ldsw = (unsigned)wid * 1024u;
    const int aoff = lds_byte(wr * 64 + fr, fq * 8), boff = lds_byte(wc * 32 + fr, fq * 8);
#define PG8_SA(b, h) (((b) * 2 + (h)) * HTB)
#define PG8_SB(b, h) ((4 + (b) * 2 + (h)) * HTB)
#define PG8_STAGE(bufoff, gbase, voff) do { _Pragma("unroll") for (int _i = 0; _i < 2; ++_i) \
        __builtin_amdgcn_global_load_lds((const unsigned*)((const char*)(gbase) + (voff)[_i]), (PG8_LAS unsigned*)(lds + (bufoff) + ldsw + _i * 8192), 16, 0, 0); } while (0)
#define PG8_LDA(dst, b, h) do { _Pragma("unroll") for (int m = 0; m < 4; ++m) _Pragma("unroll") for (int k = 0; k < 2; ++k) dst[m][k] = *(const PG8_LAS bf16x8*)(lds + PG8_SA(b, h) + aoff + m * 2048 + k * 1024); } while (0)
#define PG8_LDB(dst, b, h) do { _Pragma("unroll") for (int n = 0; n < 2; ++n) _Pragma("unroll") for (int k = 0; k < 2; ++k) dst[n][k] = *(const PG8_LAS bf16x8*)(lds + PG8_SB(b, h) + boff + n * 2048 + k * 1024); } while (0)
#define PG8_MMA(ai, bj, At, Bt) do { __builtin_amdgcn_s_setprio(1); _Pragma("unroll") for (int m = 0; m < 4; ++m) _Pragma("unroll") for (int n = 0; n < 2; ++n) _Pragma("unroll") for (int k = 0; k < 2; ++k) \
        acc[ai][bj][m][n] = __builtin_amdgcn_mfma_f32_16x16x32_bf16(Bt[n][k], At[m][k], acc[ai][bj][m][n], 0, 0, 0); __builtin_amdgcn_s_setprio(0); } while (0)
#define PG8_WAIT_V(n) asm volatile("s_waitcnt vmcnt(" #n ")" ::: "memory")
#define PG8_WAIT_L(n) asm volatile("s_waitcnt lgkmcnt(" #n ")" ::: "memory")
#define PG8_BAR __builtin_amdgcn_s_barrier()
#define PG8_SCHED __builtin_amdgcn_sched_barrier(0)
    Unit cur, nxt; int ui = 0;
    if (!S.next(0, cur)) return;
    f32x4 acc[2][2][4][2];
#pragma unroll
    for (int a = 0; a < 2; ++a)
#pragma unroll
        for (int b = 0; b < 2; ++b)
#pragma unroll
            for (int m = 0; m < 4; ++m)
#pragma unroll
                for (int n = 0; n < 2; ++n) acc[a][b][m][n] = (f32x4){0.f, 0.f, 0.f, 0.f};
    bf16x8 At[4][2], B0[2][2], B1[2][2];
    const char* cA = (const char*)g.A + (size_t)cur.pm * tstep; const char* cB = (const char*)g.Bt + (size_t)cur.pn * tstep;
    S.a_ready(cur);
    if constexpr (SP2) {
        PG8_STAGE(PG8_SB(0, 0), cB, voffB); PG8_STAGE(PG8_SB(0, 1), cB + hstep, voffB); PG8_STAGE(PG8_SA(0, 0), cA, voffA); PG8_STAGE(PG8_SA(0, 1), cA + hstep, voffA);
        if (wr == 1) PG8_BAR;
        PG8_WAIT_V(2); PG8_BAR;
        PG8_STAGE(PG8_SB(1, 0), cB + kstep, voffB); PG8_STAGE(PG8_SA(1, 0), cA + kstep, voffA); PG8_STAGE(PG8_SB(1, 1), cB + hstep + kstep, voffB);
        PG8_WAIT_V(6); PG8_BAR;
    } else {
        PG8_STAGE(PG8_SB(0, 0), cB, voffB); PG8_STAGE(PG8_SA(0, 0), cA, voffA); PG8_STAGE(PG8_SB(0, 1), cB + hstep, voffB); PG8_STAGE(PG8_SA(0, 1), cA + hstep, voffA);
        if (wr == 1) PG8_BAR;
        PG8_WAIT_V(4); PG8_BAR;
        PG8_STAGE(PG8_SB(1, 0), cB + kstep, voffB); PG8_STAGE(PG8_SA(1, 0), cA + kstep, voffA); PG8_STAGE(PG8_SB(1, 1), cB + hstep + kstep, voffB);
        PG8_WAIT_V(6); PG8_BAR;
    }
    for (;;) {
        const bool has_next = S.next(ui + 1, nxt);
        const char* nA = has_next ? (const char*)g.A + (size_t)nxt.pm * tstep : cA; const char* nB = has_next ? (const char*)g.Bt + (size_t)nxt.pn * tstep : cB;
        for (int t = 0; t < nt; t += 2) {
            const bool last = (t == nt - 2);
            const char* a1 = cA + (size_t)(t + 1) * kstep;
            const char* a2 = last ? nA : cA + (size_t)(t + 2) * kstep; const char* b2 = last ? nB : cB + (size_t)(t + 2) * kstep;
            const char* a3 = a2 + kstep; const char* b3 = b2 + kstep;
            if (last && has_next) S.a_ready(nxt);
            if constexpr (SP2) {
            PG8_LDB(B0, 0, 0); PG8_LDB(B1, 0, 1); PG8_SCHED; PG8_LDA(At, 0, 0); PG8_STAGE(PG8_SA(1, 1), a1 + hstep, voffA);
            PG8_WAIT_V(8); PG8_WAIT_L(0); PG8_BAR; PG8_MMA(0, 0, At, B0); PG8_MMA(0, 1, At, B1); PG8_BAR; PG8_SCHED;
            PG8_LDA(At, 0, 1); PG8_STAGE(PG8_SB(0, 0), b2, voffB); PG8_STAGE(PG8_SB(0, 1), b2 + hstep, voffB); PG8_STAGE(PG8_SA(0, 0), a2, voffA);
            PG8_WAIT_V(8); PG8_WAIT_L(0); PG8_BAR; PG8_MMA(1, 0, At, B0); PG8_MMA(1, 1, At, B1); PG8_BAR; PG8_SCHED;
            PG8_LDB(B0, 1, 0); PG8_LDB(B1, 1, 1); PG8_SCHED; PG8_LDA(At, 1, 0); PG8_STAGE(PG8_SA(0, 1), a2 + hstep, voffA);
            PG8_WAIT_V(8); PG8_WAIT_L(0); PG8_BAR; PG8_MMA(0, 0, At, B0); PG8_MMA(0, 1, At, B1); PG8_BAR; PG8_SCHED;
            PG8_LDA(At, 1, 1); PG8_STAGE(PG8_SB(1, 0), b3, voffB); PG8_STAGE(PG8_SB(1, 1), b3 + hstep, voffB); PG8_STAGE(PG8_SA(1, 0), a3, voffA);
            PG8_WAIT_V(8); PG8_WAIT_L(0); PG8_BAR; PG8_MMA(1, 0, At, B0); PG8_MMA(1, 1, At, B1); PG8_BAR; PG8_SCHED;
            } else {
            PG8_LDB(B0, 0, 0); PG8_SCHED; PG8_LDA(At, 0, 0); PG8_STAGE(PG8_SA(1, 1), a1 + hstep, voffA);
            PG8_WAIT_L(8); PG8_BAR; PG8_WAIT_L(0); PG8_MMA(0, 0, At, B0); PG8_BAR; PG8_SCHED;
            PG8_LDB(B1, 0, 1); PG8_STAGE(PG8_SB(0, 0), b2, voffB);
            PG8_BAR; PG8_WAIT_L(0); PG8_MMA(0, 1, At, B1); PG8_BAR;
            PG8_LDA(At, 0, 1); PG8_STAGE(PG8_SA(0, 0), a2, voffA);
            PG8_BAR; PG8_WAIT_L(0); PG8_MMA(1, 0, At, B0); PG8_BAR; PG8_SCHED;
            PG8_STAGE(PG8_SB(0, 1), b2 + hstep, voffB);
            PG8_WAIT_V(6); PG8_BAR; PG8_MMA(1, 1, At, B1); PG8_BAR;
            PG8_LDB(B0, 1, 0); PG8_SCHED; PG8_LDA(At, 1, 0); PG8_STAGE(PG8_SA(0, 1), a2 + hstep, voffA);
            PG8_WAIT_L(8); PG8_BAR; PG8_WAIT_L(0); PG8_MMA(0, 0, At, B0); PG8_BAR; PG8_SCHED;
            PG8_LDB(B1, 1, 1); PG8_STAGE(PG8_SB(1, 0), b3, voffB);
            PG8_BAR; PG8_WAIT_L(0); PG8_MMA(0, 1, At, B1); PG8_BAR;
            PG8_LDA(At, 1, 1); PG8_STAGE(PG8_SA(1, 0), a3, voffA);
            PG8_BAR; PG8_WAIT_L(0); PG8_MMA(1, 0, At, B0); PG8_BAR; PG8_SCHED;
            PG8_STAGE(PG8_SB(1, 1), b3 + hstep, voffB);
            PG8_WAIT_V(6); PG8_BAR; PG8_MMA(1, 1, At, B1); PG8_BAR;
            }
        }
        if constexpr (ALIGN_EPI) { if (wr == 0) PG8_BAR; }
        if constexpr (!Epi::AFTER_DRAIN) { E(acc, cur, wr, wc, fr, fq); S.done(cur); }
        if (!has_next) break;
#pragma unroll
        for (int a = 0; a < 2; ++a)
#pragma unroll
            for (int b = 0; b < 2; ++b)
#pragma unroll
                for (int m = 0; m < 4; ++m)
#pragma unroll
                    for (int n = 0; n < 2; ++n) acc[a][b][m][n] = (f32x4){0.f, 0.f, 0.f, 0.f};
        cur = nxt; cA = nA; cB = nB; ++ui;
        if constexpr (ALIGN_EPI) { if (wr == 1) PG8_BAR; }
    }
    PG8_WAIT_V(0);
    if constexpr (!ALIGN_EPI) { if (wr == 0) PG8_BAR; }
    PG8_BAR;
    if constexpr (Epi::AFTER_DRAIN) { E.fused(acc, cur, wr, wc, fr, fq, lds, wid, lane); S.done(cur); }
#undef PG8_SA
#undef PG8_SB
#undef PG8_STAGE
#undef PG8_LDA
#undef PG8_LDB
#undef PG8_MMA
#undef PG8_WAIT_V
#undef PG8_WAIT_L
#undef PG8_BAR
#undef PG8_SCHED
}
}
namespace mk {
using pg8::bf16_t; using pg8::f32x4; using pg8::u32x4; using pg8::Unit; using pg8::cvt_pk_bf16;
typedef unsigned u32x2 __attribute__((ext_vector_type(2)));
#define LAS __attribute__((address_space(3)))
constexpr int D = 1024, BATCH = 4, SEQ = 4096, M = BATCH * SEQ;
constexpr int INW = 2312, NQKV = 2304, NQ = 2048, NEXP = 16384;
constexpr float EPS = 1e-6f, LOG2E = 1.4426950408889634f, C2 = 0.125f * LOG2E;
constexpr size_t MiB = 1u << 20;
constexpr size_t WS_CTL = 0, WS_WTIN = 1 * MiB, WS_WTOUT = 6 * MiB, WS_WTQ = 8 * MiB, WS_SK = 12 * MiB, WS_LOGF = 13 * MiB, WS_F2 = 13 * MiB + 512 * 1024, WS_SSQ = 14 * MiB,
                 WS_EIDX = 16 * MiB, WS_GATE = 24 * MiB, WS_XN = 32 * MiB, WS_QA = 64 * MiB, WS_KA = 80 * MiB, WS_VA = 84 * MiB, WS_QB = 88 * MiB, WS_KB = 104 * MiB, WS_VB = 120 * MiB,
                 WS_MIX = 136 * MiB, WS_QV = 64 * MiB, WS_EU8 = 168 * MiB, WS_EV8 = 184 * MiB, WS_X1 = 192 * MiB, WS_COEF = 136 * MiB, WS_CSUM = 144 * MiB, WS_SU = 15 * MiB, WS_SV = 15 * MiB + 65536, WS_RR = 15 * MiB + 131072;

__device__ __constant__ unsigned char T5B[128] = {0, 1, 2, 3, 4, 5, 6, 7, 8, 9, 10, 11, 12, 13, 14, 15, 16, 16, 16, 17, 17, 18, 18, 18, 19, 19, 19, 20, 20, 20, 20, 21, 21, 21, 21, 22, 22, 22, 22, 22, 23, 23, 23, 23, 23, 23, 24, 24, 24, 24, 24, 24, 25, 25, 25, 25, 25, 25, 25, 26, 26, 26, 26, 26, 26, 26, 26, 27, 27, 27, 27, 27, 27, 27, 27, 27, 27, 28, 28, 28, 28, 28, 28, 28, 28, 28, 28, 29, 29, 29, 29, 29, 29, 29, 29, 29, 29, 29, 29, 30, 30, 30, 30, 30, 30, 30, 30, 30, 30, 30, 30, 30, 30, 31, 31, 31, 31, 31, 31, 31, 31, 31, 31, 31, 31, 31, 31, 31};

__device__ __forceinline__ float wave_sum(float v) {
#pragma unroll
    for (int o = 1; o < 64; o <<= 1) v += __shfl_xor(v, o);
    return v;
}
__device__ __forceinline__ float bf_lo(unsigned w) { return __uint_as_float(w << 16); }
__device__ __forceinline__ float bf_hi(unsigned w) { return __uint_as_float(w & 0xffff0000u); }

struct EpiQKV {
    static constexpr bool PERM = true, AFTER_DRAIN = false;
    bf16_t *QA, *KA, *VA, *QB, *KB, *VB; const float *gqa, *gka, *gqb, *gkb; const float* rr;
    __device__ __forceinline__ void operator()(const f32x4 (&acc)[2][2][4][2], const Unit& u, int wr, int wc, int fr, int fq) const {
        const int s = u.pn * 4 + wc;
        bf16_t* dst; int pitch; const float* g; float sc = 1.f;
        if (s < 8) { dst = QA + 64 * s; pitch = 512; g = gqa; sc = C2; }
        else if (s < 10) { dst = KA + 64 * (s - 8); pitch = 128; g = gka; }
        else if (s < 12) { dst = VA + 64 * (s - 10); pitch = 128; g = nullptr; }
        else if (s < 20) { dst = QB + 64 * (s - 12); pitch = 512; g = gqb; sc = C2; }
        else if (s < 28) { dst = KB + 64 * (s - 20); pitch = 512; g = gkb; }
        else { dst = VB + 64 * (s - 28); pitch = 512; g = nullptr; }
        f32x4 gv[2][2];
#pragma unroll
        for (int bj = 0; bj < 2; ++bj)
#pragma unroll
            for (int n = 0; n < 2; ++n) gv[bj][n] = g ? *(const f32x4*)(g + 32 * bj + 8 * fq + 4 * n) * sc : (f32x4){1.f, 1.f, 1.f, 1.f};
        const int row0 = u.pm * 256 + wr * 64 + fr;
        float rw[2][4];
#pragma unroll
        for (int ai = 0; ai < 2; ++ai)
#pragma unroll
            for (int m = 0; m < 4; ++m) rw[ai][m] = rr[row0 + ai * 128 + m * 16];
#pragma unroll
        for (int ai = 0; ai < 2; ++ai)
#pragma unroll
            for (int m = 0; m < 4; ++m) {
                float ss = 0.f;
#pragma unroll
                for (int bj = 0; bj < 2; ++bj)
#pragma unroll
                    for (int n = 0; n < 2; ++n) { const f32x4 v = acc[ai][bj][m][n]; ss += (v[0] * v[0] + v[1] * v[1]) + (v[2] * v[2] + v[3] * v[3]); }
                ss += __shfl_xor(ss, 16); ss += __shfl_xor(ss, 32);
                const float rx = rw[ai][m]; const float rs = g ? rsqrtf(ss * (rx * rx) * (1.f / 64.f) + EPS) * rx : rx;
                bf16_t* rowp = dst + (size_t)(row0 + ai * 128 + m * 16) * pitch + 8 * fq;
#pragma unroll
                for (int bj = 0; bj < 2; ++bj) {
                    const f32x4 v0 = acc[ai][bj][m][0] * rs * gv[bj][0], v1 = acc[ai][bj][m][1] * rs * gv[bj][1];
                    u32x4 w; w.x = cvt_pk_bf16(v0[0], v0[1]); w.y = cvt_pk_bf16(v0[2], v0[3]); w.z = cvt_pk_bf16(v1[0], v1[1]); w.w = cvt_pk_bf16(v1[2], v1[3]);
                    *(u32x4*)(rowp + 32 * bj) = w;
                }
            }
    }
};
struct EpiOut {
    static constexpr bool PERM = false, AFTER_DRAIN = false;
    bf16_t* ap; float* ssq;
    __device__ __forceinline__ void operator()(const f32x4 (&acc)[2][2][4][2], const Unit& u, int wr, int wc, int fr, int fq) const {
        const int col0 = u.pn * 256 + wc * 32 + 4 * fq;
        const int row0 = u.pm * 256 + wr * 64 + fr;
#pragma unroll
        for (int ai = 0; ai < 2; ++ai) {
            u32x2 xc[4][2][2];
#pragma unroll
            for (int m = 0; m < 4; ++m)
#pragma unroll
                for (int bj = 0; bj < 2; ++bj)
#pragma unroll
                    for (int n = 0; n < 2; ++n) xc[m][bj][n] = *(const u32x2*)(ap + (size_t)(row0 + ai * 128 + m * 16) * D + col0 + bj * 128 + n * 16);
            __builtin_amdgcn_sched_barrier(0);
#pragma unroll
            for (int m = 0; m < 4; ++m) {
                const int row = row0 + ai * 128 + m * 16; const size_t off = (size_t)row * D + col0; float ss = 0.f;
#pragma unroll
                for (int bj = 0; bj < 2; ++bj)
#pragma unroll
                    for (int n = 0; n < 2; ++n) {
                        const size_t o2 = off + bj * 128 + n * 16;
                        const u32x2 xw = xc[m][bj][n]; const f32x4 v = acc[ai][bj][m][n] + (f32x4){bf_lo(xw.x), bf_hi(xw.x), bf_lo(xw.y), bf_hi(xw.y)};
                        ss += (v[0] * v[0] + v[1] * v[1]) + (v[2] * v[2] + v[3] * v[3]);
                        u32x2 w; w.x = cvt_pk_bf16(v[0], v[1]); w.y = cvt_pk_bf16(v[2], v[3]);
                        *(u32x2*)(ap + o2) = w;
                    }
                ss += __shfl_xor(ss, 16); ss += __shfl_xor(ss, 32);
                if (fq == 0) ssq[(size_t)row * 16 + u.pn * 4 + wc] = ss;
            }
        }
    }
};
struct EpiQV {
    static constexpr bool PERM = true, AFTER_DRAIN = false;
    bf16_t* qv; const float* ssq;
    __device__ __forceinline__ void operator()(const f32x4 (&acc)[2][2][4][2], const Unit& u, int wr, int wc, int fr, int fq) const {
        const int row0 = u.pm * 256 + wr * 64 + fr, col0 = u.pn * 256 + wc * 32 + 8 * fq;
#pragma unroll
        for (int ai = 0; ai < 2; ++ai)
#pragma unroll
            for (int m = 0; m < 4; ++m) {
                const int row = row0 + ai * 128 + m * 16;
                const f32x4* sp = (const f32x4*)(ssq + (size_t)row * 16);
                const f32x4 s0 = sp[0], s1 = sp[1], s2 = sp[2], s3 = sp[3];
                const float tot = ((s0[0] + s0[1]) + (s0[2] + s0[3])) + ((s1[0] + s1[1]) + (s1[2] + s1[3])) + ((s2[0] + s2[1]) + (s2[2] + s2[3])) + ((s3[0] + s3[1]) + (s3[2] + s3[3]));
                const float rs = rsqrtf(tot * (1.f / D) + EPS);
                bf16_t* rowp = qv + (size_t)row * NQ + col0;
#pragma unroll
                for (int bj = 0; bj < 2; ++bj) {
                    const f32x4 v0 = acc[ai][bj][m][0] * rs, v1 = acc[ai][bj][m][1] * rs;
                    u32x4 w; w.x = cvt_pk_bf16(v0[0], v0[1]); w.y = cvt_pk_bf16(v0[2], v0[3]); w.z = cvt_pk_bf16(v1[0], v1[1]); w.w = cvt_pk_bf16(v1[2], v1[3]);
                    *(u32x4*)(rowp + 128 * bj) = w;
                }
            }
    }
};

__device__ __forceinline__ int rowmap_in(int n0) { const int s = n0 >> 6, bj = (n0 >> 5) & 1; return 256 * (s >> 2) + 128 * bj + 32 * (s & 3); }
template <bool MAPIN, bool SCALE = false  >
__device__ __forceinline__ void p0_transpose_item(const float* __restrict__ W, int ldw, int K, int nblk, bf16_t* __restrict__ WT, LAS float* scr, int item, int lane, const float* __restrict__ rsc = nullptr) {
    const int kb = item / nblk, nb = item % nblk, k0 = 64 * kb, n0 = 32 * nb;
    const int r0 = MAPIN ? rowmap_in(n0) : n0;
#pragma unroll 8
    for (int i = 0; i < 32; ++i) { const int kk = 2 * i + (lane >> 5); scr[kk * 33 + (lane & 31)] = W[(size_t)(k0 + kk) * ldw + n0 + (lane & 31)] * (SCALE ? rsc[k0 + kk] : 1.f); }
    asm volatile("s_waitcnt lgkmcnt(0)" ::: "memory");
    const int c = lane & 7;
#pragma unroll
    for (int j = 0; j < 4; ++j) { const int n = (lane >> 3) + 8 * j; const LAS float* s = scr + (8 * c) * 33 + n;
        u32x4 o; o.x = cvt_pk_bf16(s[0 * 33], s[1 * 33]); o.y = cvt_pk_bf16(s[2 * 33], s[3 * 33]); o.z = cvt_pk_bf16(s[4 * 33], s[5 * 33]); o.w = cvt_pk_bf16(s[6 * 33], s[7 * 33]);
        *(u32x4*)(WT + (size_t)(r0 + n) * K + k0 + 8 * c) = o; }
    asm volatile("s_waitcnt lgkmcnt(0)" ::: "memory");
}
__device__ __forceinline__ void p0_keyfold_item(const float* __restrict__ wq, const float* __restrict__ sk1, const float* __restrict__ sk2, const float* __restrict__ g, bf16_t* __restrict__ WT, int item, int lane) {
    typedef short bf16x8s_ __attribute__((ext_vector_type(8)));
    typedef float f32x16_ __attribute__((ext_vector_type(16)));
    const int tile = item & 3, k0 = 32 * ((item >> 2) & 31), hh2 = item >> 7, tl = lane & 31, dg = lane >> 5;
    const float* sp = ((hh2 & 1) ? sk2 : sk1) + (size_t)(32 * tile + tl) * 128 + dg * 8;
    const float* wrow = wq + (size_t)(k0 + tl) * NQ + hh2 * 128 + dg * 8;
    const float gk = g[k0 + tl];
    f32x4 a0[8], a1[8], b0[8], b1[8];
#pragma unroll
    for (int ds = 0; ds < 8; ++ds) { b0[ds] = *(const f32x4*)(wrow + ds * 16); b1[ds] = *(const f32x4*)(wrow + ds * 16 + 4); a0[ds] = *(const f32x4*)(sp + ds * 16); a1[ds] = *(const f32x4*)(sp + ds * 16 + 4); }
    f32x16_ acc;
#pragma unroll
    for (int r = 0; r < 16; ++r) acc[r] = 0.f;
#pragma unroll
    for (int ds = 0; ds < 8; ++ds) {
        const f32x4 p0 = b0[ds] * gk, p1 = b1[ds] * gk;
        const u32x4 bw = {cvt_pk_bf16(p0[0], p0[1]), cvt_pk_bf16(p0[2], p0[3]), cvt_pk_bf16(p1[0], p1[1]), cvt_pk_bf16(p1[2], p1[3])};
        const u32x4 aw = {cvt_pk_bf16(a0[ds][0], a0[ds][1]), cvt_pk_bf16(a0[ds][2], a0[ds][3]), cvt_pk_bf16(a1[ds][0], a1[ds][1]), cvt_pk_bf16(a1[ds][2], a1[ds][3])};
        acc = __builtin_amdgcn_mfma_f32_32x32x16_bf16(__builtin_bit_cast(bf16x8s_, aw), __builtin_bit_cast(bf16x8s_, bw), acc, 0, 0, 0);
    }
    const int odd = tl & 1;
#pragma unroll
    for (int r = 0; r < 16; r += 2) {
        const float own0 = acc[r], own1 = acc[r + 1];
        const float recv = __shfl_xor(odd ? own0 : own1, 1);
        const int n = 32 * tile + ((r + odd) & 3) + 8 * ((r + odd) >> 2) + 4 * dg;
        const unsigned w = odd ? cvt_pk_bf16(recv, own1) : cvt_pk_bf16(own0, recv);
        *(unsigned*)(WT + (size_t)(hh2 * 128 + n) * D + k0 + (tl & ~1)) = w;
    }
}
__device__ __forceinline__ void p0_convert(const float* __restrict__ src, bf16_t* __restrict__ dst, size_t n8, int gw, int NGW, int lane) {
    for (size_t i = (size_t)gw * 64 + lane; i < n8; i += (size_t)NGW * 64) {
        const f32x4 a = ((const f32x4*)src)[2 * i], b = ((const f32x4*)src)[2 * i + 1];
        u32x4 w; w.x = cvt_pk_bf16(a[0], a[1]); w.y = cvt_pk_bf16(a[2], a[3]); w.z = cvt_pk_bf16(b[0], b[1]); w.w = cvt_pk_bf16(b[2], b[3]);
        ((u32x4*)dst)[i] = w;
    }
}
__device__ __forceinline__ void p0_rows(const float* __restrict__ x, const float* __restrict__ g, const float* __restrict__ w_in, const float* __restrict__ bforget, bf16_t* __restrict__ XN, float* __restrict__ RR, float* __restrict__ logf, int gw, int NGW, int lane) {
    f32x4 wa[16], wb[16];
#pragma unroll
    for (int jj = 0; jj < 4; ++jj)
#pragma unroll
        for (int e = 0; e < 4; ++e) { const f32x4* wp = (const f32x4*)(w_in + (size_t)(256 * jj + 4 * lane + e) * INW + NQKV); wa[jj * 4 + e] = wp[0]; wb[jj * 4 + e] = wp[1]; }
    const float bl = bforget[lane & 7];
#pragma unroll 1
    for (int rowb = gw; rowb < M; rowb += 4 * NGW) {
        f32x4 v4[4][4];
#pragma unroll
        for (int r = 0; r < 4; ++r) { const int row = rowb + r * NGW < M ? rowb + r * NGW : rowb; const f32x4* xr = (const f32x4*)(x + (size_t)row * D);
#pragma unroll
            for (int jj = 0; jj < 4; ++jj) v4[r][jj] = __builtin_nontemporal_load(xr + lane + 64 * jj); }
#pragma unroll
        for (int r = 0; r < 4; ++r) {
            const int row = rowb + r * NGW;
            if (row < M) {
                float s = 0.f;
#pragma unroll
                for (int jj = 0; jj < 4; ++jj) { const f32x4 v = v4[r][jj]; s += (v[0] * v[0] + v[1] * v[1]) + (v[2] * v[2] + v[3] * v[3]); }
                s = wave_sum(s);
                const float rs = rsqrtf(s * (1.f / D) + EPS);
                f32x4 pa = {0.f, 0.f, 0.f, 0.f}, pb = {0.f, 0.f, 0.f, 0.f};
#pragma unroll
                for (int jj = 0; jj < 4; ++jj) {
                    const f32x4 v = v4[r][jj]; const f32x4 h = v * rs * ((const f32x4*)g)[lane + 64 * jj];
                    u32x2 w; w.x = cvt_pk_bf16(v[0], v[1]); w.y = cvt_pk_bf16(v[2], v[3]);
                    *(u32x2*)(XN + (size_t)row * D + 256 * jj + 4 * lane) = w;
#pragma unroll
                    for (int e = 0; e < 4; ++e) { pa += wa[jj * 4 + e] * h[e]; pb += wb[jj * 4 + e] * h[e]; }
                }
                float z = 0.f;
#pragma unroll
                for (int j = 0; j < 4; ++j) { const float sa = wave_sum(pa[j]), sb = wave_sum(pb[j]); if (lane == j) z = sa; if (lane == 4 + j) z = sb; }
                if (lane == 8) RR[row] = rs;
                if (lane < 8) { z += bl; logf[(size_t)row * 8 + lane] = fminf(z, 0.f) - log1pf(expf(-fabsf(z))); }
            }
        }
    }
}
__device__ __forceinline__ void p1_cumsum(int bh, LAS float* part, const float* __restrict__ logf, float* __restrict__ F2) {
    const int b = bh >> 3, h = bh & 7, tid = threadIdx.x, lane = tid & 63, wv = tid >> 6;
    float v[8]; float s = 0.f;
#pragma unroll
    for (int i = 0; i < 8; ++i) { s += logf[((size_t)b * SEQ + tid * 8 + i) * 8 + h]; v[i] = s; }
    float inc = s;
#pragma unroll
    for (int o = 1; o < 64; o <<= 1) { const float t = __shfl_up(inc, o); if (lane >= o) inc += t; }
    if (lane == 63) part[wv] = inc;
    __syncthreads();
    float base = inc - s;
    for (int w = 0; w < wv; ++w) base += part[w];
#pragma unroll
    for (int i = 0; i < 8; ++i) F2[(size_t)bh * SEQ + tid * 8 + i] = (base + v[i]) * LOG2E;
    __syncthreads();
}
__device__ __forceinline__ float wave_max(float v) {
#pragma unroll
    for (int o = 1; o < 64; o <<= 1) v = fmaxf(v, __shfl_xor(v, o));
    return v;
}
template <int SIGNED  >
__device__ __forceinline__ void p0_quant4_rows(const float* __restrict__ T, unsigned char* __restrict__ T4, float* __restrict__ SC, int gw, int NGW, int lane) {
    for (int row = gw; row < NEXP; row += NGW) {
        const f32x4* tr = (const f32x4*)(T + (size_t)row * D + 16 * lane);
        f32x4 v[4]; float ss = 0.f;
#pragma unroll
        for (int j = 0; j < 4; ++j) { v[j] = __builtin_nontemporal_load(tr + j); ss += (v[j][0] * v[j][0] + v[j][1] * v[j][1]) + (v[j][2] * v[j][2] + v[j][3] * v[j][3]); }
        ss = wave_sum(ss);
        const float s = fmaxf(0.3352f * sqrtf(ss * (1.f / D)), 1e-30f), inv = 1.f / s;
        u32x2 w;
#pragma unroll
        for (int j2 = 0; j2 < 2; ++j2) {
            unsigned p = 0;
#pragma unroll
            for (int e = 0; e < 4; ++e) {
                const int lo = ((int)fminf(fmaxf(floorf(v[2 * j2][e] * inv), -8.f), 7.f) + (SIGNED == 1 ? 0 : 8)) & 15, hi = (int)fminf(fmaxf(floorf(v[2 * j2 + 1][e] * inv), -8.f), 7.f) & 15;
                p |= ((unsigned)lo | ((unsigned)hi << 4)) << (8 * e);
            }
            w[j2] = p;
        }
        *(u32x2*)(T4 + (size_t)row * 512 + 8 * lane) = w;
        if (lane == 0) SC[row] = s;
    }
}

__device__ __forceinline__ int row16_sum_i(int v) {
    v += __builtin_amdgcn_update_dpp(0, v, 0xB1, 0xf, 0xf, false);
    v += __builtin_amdgcn_update_dpp(0, v, 0x4E, 0xf, 0xf, false);
    v += __builtin_amdgcn_update_dpp(0, v, 0x141, 0xf, 0xf, false);
    v += __builtin_amdgcn_update_dpp(0, v, 0x140, 0xf, 0xf, false);
    return v;
}
typedef int i32x4 __attribute__((ext_vector_type(4)));
typedef float f32x2 __attribute__((ext_vector_type(2)));
__device__ __forceinline__ float ub(unsigned w, int k) { return (float)((w >> (8 * k)) & 0xffu); }

constexpr int GQ_DOT = 0, GQ_TOKC = 4096, GQ_PKL = 4352, GQ_UN = 5376, GQ_H2Q = GQ_UN, GQ_UIMG = GQ_UN + 8192, GQ_VIMG = GQ_UN, GQ_WAVE = 17920;
constexpr int GQ_UROW = 68, GQ_VROW = 36;
static_assert(GQ_UIMG + 16 * GQ_UROW * 4 <= GQ_WAVE && GQ_VIMG + 64 * GQ_VROW * 4 <= GQ_WAVE && 8 * GQ_WAVE <= 147440, "gather LDS");
#define GT_DPP(v, ctrl) __uint_as_float((unsigned)__builtin_amdgcn_update_dpp(0, (int)__float_as_uint(v), ctrl, 0xf, 0xf, false))
__device__ __forceinline__ float wave_max_u(float v) {
    v = fmaxf(v, GT_DPP(v, 0xB1)); v = fmaxf(v, GT_DPP(v, 0x4E)); v = fmaxf(v, GT_DPP(v, 0x141)); v = fmaxf(v, GT_DPP(v, 0x140));
    const int iv = (int)__float_as_uint(v);
    const float a = __uint_as_float((unsigned)__builtin_amdgcn_readlane(iv, 0)), b = __uint_as_float((unsigned)__builtin_amdgcn_readlane(iv, 16)), c = __uint_as_float((unsigned)__builtin_amdgcn_readlane(iv, 32)), d = __uint_as_float((unsigned)__builtin_amdgcn_readlane(iv, 48));
    return fmaxf(fmaxf(a, b), fmaxf(c, d));
}
__device__ __forceinline__ int wave_sum_iu(int v) { v = row16_sum_i(v); return (__builtin_amdgcn_readlane(v, 0) + __builtin_amdgcn_readlane(v, 16)) + (__builtin_amdgcn_readlane(v, 32) + __builtin_amdgcn_readlane(v, 48)); }

template <class Bar>
__device__ __forceinline__ void gather_chunked(const bf16_t* __restrict__ ap, const float* __restrict__ ssq, const float* __restrict__ gffn, const int* __restrict__ eidx, const float* __restrict__ gate,
                                               const unsigned char* __restrict__ EU4, const unsigned char* __restrict__ EV4, const float* __restrict__ SU, const float* __restrict__ SV,
                                               float* __restrict__ out, LAS unsigned char* wl, int tfirst, int tstep, int tstride, int ntb  , int lane, const Bar& bar) {
    const int g8 = lane >> 3, pc = lane & 7, g84 = 4 * g8;
    const unsigned pc16 = (unsigned)pc * 16u;
    LAS int* DOT = (LAS int*)(wl + GQ_DOT); LAS float* TOKC = (LAS float*)(wl + GQ_TOKC); LAS unsigned* PKL = (LAS unsigned*)(wl + GQ_PKL);
    LAS unsigned char* H2Q = wl + GQ_H2Q; LAS int* UIMG = (LAS int*)(wl + GQ_UIMG); LAS int* VIMG = (LAS int*)(wl + GQ_VIMG);
#pragma unroll 1
    for (int tb = 0; tb < ntb; ++tb) {
        const int t0 = tfirst + tb * tstep;
        int ntok = 0; if (t0 < M) { ntok = (M - t0 + tstride - 1) / tstride; ntok = ntok > 8 ? 8 : ntok; }
#pragma unroll 1
        for (int i = 0; i < ntok; ++i) {
            const int t = t0 + i * tstride;
            float rs;
            { const f32x4* sp = (const f32x4*)(ssq + (size_t)t * 16); const f32x4 a = sp[0], b = sp[1], c = sp[2], d = sp[3];
              const float tot = ((a[0] + a[1]) + (a[2] + a[3])) + ((b[0] + b[1]) + (b[2] + b[3])) + ((c[0] + c[1]) + (c[2] + c[3])) + ((d[0] + d[1]) + (d[2] + d[3]));
              rs = rsqrtf(tot * (1.f / D) + EPS); }
            const u32x4* hp = (const u32x4*)(ap + (size_t)t * D + 16 * lane); const u32x4 w0 = hp[0], w1 = hp[1];
            float h[16];
#pragma unroll
            for (int k = 0; k < 4; ++k) { h[2 * k] = bf_lo(w0[k]); h[2 * k + 1] = bf_hi(w0[k]); h[8 + 2 * k] = bf_lo(w1[k]); h[8 + 2 * k + 1] = bf_hi(w1[k]); }
#pragma unroll
            for (int k = 0; k < 4; ++k) { const f32x4 gk = ((const f32x4*)(gffn + 16 * lane))[k]; h[4 * k] *= gk[0]; h[4 * k + 1] *= gk[1]; h[4 * k + 2] *= gk[2]; h[4 * k + 3] *= gk[3]; }
            float am = 0.f;
#pragma unroll
            for (int k = 0; k < 16; ++k) am = fmaxf(am, fabsf(h[k]));
            am = wave_max_u(am);
            const float hinv = am > 0.f ? 119.f / am : 0.f;
            u32x4 qw; int hs = -128;
#pragma unroll
            for (int d = 0; d < 2; ++d) {
                unsigned u[8];
#pragma unroll
                for (int j = 0; j < 8; ++j) u[j] = __float_as_uint(__builtin_fmaf(h[8 * d + j], hinv, 12582920.f));
                const unsigned ba = __builtin_amdgcn_perm(__builtin_amdgcn_perm(u[3], u[2], 0x0c0c0400u), __builtin_amdgcn_perm(u[1], u[0], 0x0c0c0400u), 0x05040100u);
                const unsigned bb = __builtin_amdgcn_perm(__builtin_amdgcn_perm(u[7], u[6], 0x0c0c0400u), __builtin_amdgcn_perm(u[5], u[4], 0x0c0c0400u), 0x05040100u);
                hs = __builtin_amdgcn_sdot4((int)ba, 0x01010101, hs, false); hs = __builtin_amdgcn_sdot4((int)bb, 0x01010101, hs, false);
                qw[2 * d] = ((ba >> 4) & 0x0f0f0f0fu) | (((bb >> 4) & 0x0f0f0f0fu) << 4);
                qw[2 * d + 1] = ((ba & 0x0f0f0f0fu) ^ 0x08080808u) | (((bb & 0x0f0f0f0fu) ^ 0x08080808u) << 4);
            }
            *(LAS u32x4*)(H2Q + i * 1024 + 16 * lane) = qw;
            hs = wave_sum_iu(hs);
            if (lane == 0) { TOKC[i * 8 + 0] = am * (1.f / 119.f) * rs; TOKC[i * 8 + 1] = (float)hs; }
            DOT[i * 128 + lane] = 0; DOT[i * 128 + 64 + lane] = 0;
        }
        u32x4 r[16];
        {
            const int nit = 4 * ntok;
            int e0 = 0, e1 = 0, en0 = 0, en1 = 0;
            if (ntok > 0) { e0 = eidx[(size_t)t0 * 128 + lane]; e1 = eidx[(size_t)t0 * 128 + 64 + lane]; }
            if (nit > 1) { const int tn = t0 + (1 % ntok) * tstride; en0 = eidx[(size_t)tn * 128 + lane]; en1 = eidx[(size_t)tn * 128 + 64 + lane]; }
            if (nit > 0) {
#pragma unroll
                for (int s_ = 0; s_ < 16; ++s_) { const unsigned e = (unsigned)__builtin_amdgcn_ds_bpermute(g84 + 32 * (s_ & 7), s_ < 8 ? e0 : e1); r[s_] = *(const u32x4*)(EU4 + (e * 512u + pc16)); }
            }
#pragma unroll 1
            for (int n = 0; n < nit; ++n) {
                const int c = n / ntok, i = n - c * ntok;
                const int n1 = n + 1; const bool more = n1 < nit; const int c1 = more ? n1 / ntok : 0;
                int ef0 = 0, ef1 = 0;
                { const int n2 = n + 2; const int i2 = n2 % ntok; const int tn = t0 + i2 * tstride; ef0 = eidx[(size_t)tn * 128 + lane]; ef1 = eidx[(size_t)tn * 128 + 64 + lane]; }
                int hq[8];
                { const LAS i32x4* hp = (const LAS i32x4*)(H2Q + i * 1024 + 256 * c + 32 * pc); const i32x4 a = hp[0], b = hp[1];
                  hq[0] = a[0]; hq[1] = a[1]; hq[2] = a[2]; hq[3] = a[3]; hq[4] = b[0]; hq[5] = b[1]; hq[6] = b[2]; hq[7] = b[3]; }
                const unsigned noff = (unsigned)c1 * 128u + pc16;
                unsigned enx = (unsigned)__builtin_amdgcn_ds_bpermute(g84, en0);
#pragma unroll
                for (int s_ = 0; s_ < 16; ++s_) {
                    const unsigned ecur = enx;
                    if (s_ + 1 < 16) enx = (unsigned)__builtin_amdgcn_ds_bpermute(g84 + 32 * ((s_ + 1) & 7), (s_ + 1) < 8 ? en0 : en1);
                    int ah, al;
                    { const int w = (int)r[s_][0]; asm("v_dot8_i32_i4 %0, %1, %2, 0" : "=v"(ah) : "v"(w), "v"(hq[0])); asm("v_dot8_i32_i4 %0, %1, %2, 0" : "=v"(al) : "v"(w), "v"(hq[1])); }
#pragma unroll
                    for (int q = 1; q < 4; ++q) { const int w = (int)r[s_][q]; ah = __builtin_amdgcn_sdot8(w, hq[2 * q], ah, false); al = __builtin_amdgcn_sdot8(w, hq[2 * q + 1], al, false); }
                    UIMG[s_ * GQ_UROW + lane] = 16 * ah + al;
                    r[s_] = *(const u32x4*)(EU4 + (ecur * 512u + noff));
                    __builtin_amdgcn_sched_barrier(0);
                }
                { const LAS int* rp = UIMG + (lane >> 3) * GQ_UROW + 8 * (lane & 7);
                  const i32x4 a0 = *(const LAS i32x4*)(rp), a1 = *(const LAS i32x4*)(rp + 4), b0 = *(const LAS i32x4*)(rp + 8 * GQ_UROW), b1 = *(const LAS i32x4*)(rp + 8 * GQ_UROW + 4);
                  DOT[i * 128 + lane] += ((a0[0] + a0[1]) + (a0[2] + a0[3])) + ((a1[0] + a1[1]) + (a1[2] + a1[3]));
                  DOT[i * 128 + 64 + lane] += ((b0[0] + b0[1]) + (b0[2] + b0[3])) + ((b1[0] + b1[1]) + (b1[2] + b1[3])); }
                en0 = ef0; en1 = ef1;
            }
        }
#pragma unroll 1
        for (int i = 0; i < ntok; ++i) {
            const int t = t0 + i * tstride;
            const int e0 = eidx[(size_t)t * 128 + lane], e1 = eidx[(size_t)t * 128 + 64 + lane];
            const float g0 = gate[(size_t)t * 128 + lane], g1 = gate[(size_t)t * 128 + 64 + lane];
            const float su0 = SU[e0], su1 = SU[e1], sv0 = SV[e0], sv1 = SV[e1];
            const float sh = TOKC[i * 8 + 0], hoff = 0.5f * TOKC[i * 8 + 1];
            const float p0 = ((float)DOT[i * 128 + lane] + hoff) * su0 * sh, p1 = ((float)DOT[i * 128 + 64 + lane] + hoff) * su1 * sh;
            const float c0 = g0 * 0.5f * p0 * (1.f + erff(p0 * 0.70710678118654752f)) * sv0, c1 = g1 * 0.5f * p1 * (1.f + erff(p1 * 0.70710678118654752f)) * sv1;
            const float cmax = wave_max_u(fmaxf(fabsf(c0), fabsf(c1)));
            const float cinv = cmax > 0.f ? 127.f / cmax : 0.f;
            const int cq0 = __float2int_rn(c0 * cinv), cq1 = __float2int_rn(c1 * cinv);
            const int csq = wave_sum_iu(cq0 + cq1);
            unsigned pk = 0;
            { const int G = (lane >> 3) & 3, gl = lane & 7;
#pragma unroll
              for (int m = 0; m < 4; ++m) { const int slot = 32 * G + gl + 8 * m; const int a = __builtin_amdgcn_ds_bpermute(4 * (slot & 63), cq0), b = __builtin_amdgcn_ds_bpermute(4 * (slot & 63), cq1);
                  pk |= ((unsigned)(G < 2 ? a : b) & 0xffu) << (8 * m); } }
            if (lane < 32) PKL[i * 32 + lane] = pk;
            if (lane == 0) { TOKC[i * 8 + 2] = cmax * (1.f / 127.f); TOKC[i * 8 + 3] = (float)csq; }
        }
        {
            const int nit = 4 * ntok;
            int e0 = 0, e1 = 0, en0 = 0, en1 = 0;
            if (ntok > 0) { e0 = eidx[(size_t)t0 * 128 + lane]; e1 = eidx[(size_t)t0 * 128 + 64 + lane]; }
            if (nit > 1) { const int tn = t0 + (1 % ntok) * tstride; en0 = eidx[(size_t)tn * 128 + lane]; en1 = eidx[(size_t)tn * 128 + 64 + lane]; }
            if (nit > 0) {
#pragma unroll
                for (int s_ = 0; s_ < 16; ++s_) { const unsigned e = (unsigned)__builtin_amdgcn_ds_bpermute(g84 + 32 * (s_ & 7), s_ < 8 ? e0 : e1); r[s_] = *(const u32x4*)(EV4 + (e * 512u + pc16)); }
            }
#pragma unroll 1
            for (int n = 0; n < nit; ++n) {
                const int c = n / ntok, i = n - c * ntok;
                const int n1 = n + 1; const bool more = n1 < nit; const int c1 = more ? n1 / ntok : 0;
                const int t = t0 + i * tstride;
                int ef0 = 0, ef1 = 0;
                { const int n2 = n + 2; const int i2 = n2 % ntok; const int tn = t0 + i2 * tstride; ef0 = eidx[(size_t)tn * 128 + lane]; ef1 = eidx[(size_t)tn * 128 + 64 + lane]; }
                const u32x2 xrw = *(const u32x2*)(ap + (size_t)t * D + 256 * c + 4 * lane); const f32x4 xres = {bf_lo(xrw.x), bf_hi(xrw.x), bf_lo(xrw.y), bf_hi(xrw.y)};
                const unsigned noff = (unsigned)c1 * 128u + pc16;
                int accl[16], accf[16];
#pragma unroll
                for (int G = 0; G < 4; ++G) {
                    const int cp = (int)PKL[i * 32 + 8 * G + g8];
                    unsigned en[4];
#pragma unroll
                    for (int m = 0; m < 4; ++m) { const int s_ = 4 * G + m; en[m] = (unsigned)__builtin_amdgcn_ds_bpermute(g84 + 32 * (s_ & 7), s_ < 8 ? en0 : en1); }
#pragma unroll
                    for (int q = 0; q < 4; ++q) {
                        const unsigned x0 = r[4 * G][q], x1_ = r[4 * G + 1][q], x2 = r[4 * G + 2][q], x3 = r[4 * G + 3][q];
                        const unsigned t0_ = __builtin_amdgcn_perm(x1_, x0, 0x05010400u), t1_ = __builtin_amdgcn_perm(x1_, x0, 0x07030602u);
                        const unsigned t2_ = __builtin_amdgcn_perm(x3, x2, 0x05010400u), t3_ = __builtin_amdgcn_perm(x3, x2, 0x07030602u);
                        unsigned y[4];
                        y[0] = __builtin_amdgcn_perm(t2_, t0_, 0x05040100u); y[1] = __builtin_amdgcn_perm(t2_, t0_, 0x07060302u);
                        y[2] = __builtin_amdgcn_perm(t3_, t1_, 0x05040100u); y[3] = __builtin_amdgcn_perm(t3_, t1_, 0x07060302u);
#pragma unroll
                        for (int cI = 0; cI < 4; ++cI) {
                            const int yl = (int)(y[cI] & 0x0f0f0f0fu), yf = (int)y[cI];
                            if (G == 0) { asm("v_dot4_i32_i8 %0, %1, %2, 0" : "=v"(accl[4 * q + cI]) : "v"(yl), "v"(cp)); asm("v_dot4_i32_i8 %0, %1, %2, 0" : "=v"(accf[4 * q + cI]) : "v"(yf), "v"(cp)); }
                            else { accl[4 * q + cI] = __builtin_amdgcn_sdot4(yl, cp, accl[4 * q + cI], false); accf[4 * q + cI] = __builtin_amdgcn_sdot4(yf, cp, accf[4 * q + cI], false); }
                        }
                    }
#pragma unroll
                    for (int m = 0; m < 4; ++m) r[4 * G + m] = *(const u32x4*)(EV4 + (en[m] * 512u + noff));
                    __builtin_amdgcn_sched_barrier(0);
                }
#pragma unroll
                for (int q = 0; q < 4; ++q) {
                    *(LAS i32x4*)(VIMG + lane * GQ_VROW + 8 * q) = (i32x4){accl[4 * q], accl[4 * q + 1], accl[4 * q + 2], accl[4 * q + 3]};
                    *(LAS i32x4*)(VIMG + lane * GQ_VROW + 8 * q + 4) = (i32x4){accf[4 * q] - accl[4 * q], accf[4 * q + 1] - accl[4 * q + 1], accf[4 * q + 2] - accl[4 * q + 2], accf[4 * q + 3] - accl[4 * q + 3]};
                }
                i32x4 sm = {0, 0, 0, 0};
#pragma unroll
                for (int gl = 0; gl < 8; ++gl) sm += *(const LAS i32x4*)(VIMG + (8 * gl + (lane >> 3)) * GQ_VROW + 4 * (lane & 7));
                const float csc0 = TOKC[i * 8 + 2], csc = (lane & 1) ? csc0 * 0.0625f : csc0, off = ((lane & 1) ? 0.5f : -7.5f) * csc0 * TOKC[i * 8 + 3];
                f32x4 o; o[0] = xres[0] + (float)sm[0] * csc + off; o[1] = xres[1] + (float)sm[1] * csc + off; o[2] = xres[2] + (float)sm[2] * csc + off; o[3] = xres[3] + (float)sm[3] * csc + off;
                *(f32x4*)(out + (size_t)t * D + 256 * c + 4 * lane) = o;
                en0 = ef0; en1 = ef1;
            }
        }
    }
}
#define CE(a, b) do { const float _h = __builtin_fmaxf(a, b), _l = __builtin_fminf(a, b); a = _h; b = _l; } while (0)
#define SORT16(K, B) do { \
    CE(K[(B)+0], K[(B)+1]); CE(K[(B)+2], K[(B)+3]); CE(K[(B)+0], K[(B)+2]); CE(K[(B)+1], K[(B)+3]); \
    CE(K[(B)+1], K[(B)+2]); CE(K[(B)+4], K[(B)+5]); CE(K[(B)+6], K[(B)+7]); CE(K[(B)+4], K[(B)+6]); \
    CE(K[(B)+5], K[(B)+7]); CE(K[(B)+5], K[(B)+6]); CE(K[(B)+0], K[(B)+4]); CE(K[(B)+2], K[(B)+6]); \
    CE(K[(B)+2], K[(B)+4]); CE(K[(B)+1], K[(B)+5]); CE(K[(B)+3], K[(B)+7]); CE(K[(B)+3], K[(B)+5]); \
    CE(K[(B)+1], K[(B)+2]); CE(K[(B)+3], K[(B)+4]); CE(K[(B)+5], K[(B)+6]); CE(K[(B)+8], K[(B)+9]); \
    CE(K[(B)+10], K[(B)+11]); CE(K[(B)+8], K[(B)+10]); CE(K[(B)+9], K[(B)+11]); CE(K[(B)+9], K[(B)+10]); \
    CE(K[(B)+12], K[(B)+13]); CE(K[(B)+14], K[(B)+15]); CE(K[(B)+12], K[(B)+14]); CE(K[(B)+13], K[(B)+15]); \
    CE(K[(B)+13], K[(B)+14]); CE(K[(B)+8], K[(B)+12]); CE(K[(B)+10], K[(B)+14]); CE(K[(B)+10], K[(B)+12]); \
    CE(K[(B)+9], K[(B)+13]); CE(K[(B)+11], K[(B)+15]); CE(K[(B)+11], K[(B)+13]); CE(K[(B)+9], K[(B)+10]); \
    CE(K[(B)+11], K[(B)+12]); CE(K[(B)+13], K[(B)+14]); CE(K[(B)+0], K[(B)+8]); CE(K[(B)+4], K[(B)+12]); \
    CE(K[(B)+4], K[(B)+8]); CE(K[(B)+2], K[(B)+10]); CE(K[(B)+6], K[(B)+14]); CE(K[(B)+6], K[(B)+10]); \
    CE(K[(B)+2], K[(B)+4]); CE(K[(B)+6], K[(B)+8]); CE(K[(B)+10], K[(B)+12]); CE(K[(B)+1], K[(B)+9]); \
    CE(K[(B)+5], K[(B)+13]); CE(K[(B)+5], K[(B)+9]); CE(K[(B)+3], K[(B)+11]); CE(K[(B)+7], K[(B)+15]); \
    CE(K[(B)+7], K[(B)+11]); CE(K[(B)+3], K[(B)+5]); CE(K[(B)+7], K[(B)+9]); CE(K[(B)+11], K[(B)+13]); \
    CE(K[(B)+1], K[(B)+2]); CE(K[(B)+3], K[(B)+4]); CE(K[(B)+5], K[(B)+6]); CE(K[(B)+7], K[(B)+8]); \
    CE(K[(B)+9], K[(B)+10]); CE(K[(B)+11], K[(B)+12]); CE(K[(B)+13], K[(B)+14]); \
} while (0)
#define BMERGE16(K, B) do { \
    CE(K[(B)+0], K[(B)+8]); CE(K[(B)+1], K[(B)+9]); CE(K[(B)+2], K[(B)+10]); CE(K[(B)+3], K[(B)+11]); \
    CE(K[(B)+4], K[(B)+12]); CE(K[(B)+5], K[(B)+13]); CE(K[(B)+6], K[(B)+14]); CE(K[(B)+7], K[(B)+15]); \
    CE(K[(B)+0], K[(B)+4]); CE(K[(B)+1], K[(B)+5]); CE(K[(B)+2], K[(B)+6]); CE(K[(B)+3], K[(B)+7]); \
    CE(K[(B)+8], K[(B)+12]); CE(K[(B)+9], K[(B)+13]); CE(K[(B)+10], K[(B)+14]); CE(K[(B)+11], K[(B)+15]); \
    CE(K[(B)+0], K[(B)+2]); CE(K[(B)+1], K[(B)+3]); CE(K[(B)+4], K[(B)+6]); CE(K[(B)+5], K[(B)+7]); \
    CE(K[(B)+8], K[(B)+10]); CE(K[(B)+9], K[(B)+11]); CE(K[(B)+12], K[(B)+14]); CE(K[(B)+13], K[(B)+15]); \
    CE(K[(B)+0], K[(B)+1]); CE(K[(B)+2], K[(B)+3]); CE(K[(B)+4], K[(B)+5]); CE(K[(B)+6], K[(B)+7]); \
    CE(K[(B)+8], K[(B)+9]); CE(K[(B)+10], K[(B)+11]); CE(K[(B)+12], K[(B)+13]); CE(K[(B)+14], K[(B)+15]); \
} while (0)
typedef short bf16x8s __attribute__((ext_vector_type(8)));
typedef float f32x16 __attribute__((ext_vector_type(16)));
constexpr int TK_LUT_OFF = 0, TK_LDS_END = TK_LUT_OFF + 8 * 8192;
__device__ __forceinline__ void top16_of_64(float (&k)[64]) {
    SORT16(k, 0); SORT16(k, 16); SORT16(k, 32); SORT16(k, 48);
#pragma unroll
    for (int i = 0; i < 16; ++i) { k[i] = __builtin_fmaxf(k[i], k[31 - i]); k[32 + i] = __builtin_fmaxf(k[32 + i], k[63 - i]); }
    BMERGE16(k, 0); BMERGE16(k, 32);
#pragma unroll
    for (int i = 0; i < 16; ++i) k[i] = __builtin_fmaxf(k[i], k[47 - i]);
    BMERGE16(k, 0);
}
__device__ __forceinline__ float ctag(float s, unsigned code) { return __uint_as_float((__float_as_uint(s) & 0xffffff00u) | code); }
__device__ __forceinline__ void topk_load(u32x4 (&w)[8], const bf16_t* __restrict__ srow  ) {
#pragma unroll
    for (int i = 0; i < 8; ++i) w[i] = ((const u32x4*)srow)[i];
}
__device__ __forceinline__ void topk_half(float (&v)[16], u32x4 (&w)[8], const bf16_t* __restrict__ nxt, unsigned hx  ) {
    float k[64];
#pragma unroll
    for (int i = 0; i < 8; ++i)
#pragma unroll
        for (int q = 0; q < 4; ++q) { const unsigned x = w[i][q]; k[8 * i + 2 * q] = __uint_as_float((x << 16) | (unsigned)(8 * i + 2 * q)); k[8 * i + 2 * q + 1] = __uint_as_float((x & 0xffff0000u) | (unsigned)(8 * i + 2 * q + 1)); }
    if (nxt) topk_load(w, nxt);
    top16_of_64(k);
    float r0[16], r1[16];
#pragma unroll
    for (int i = 0; i < 16; ++i) { const unsigned ki = __float_as_uint(k[i]) | hx; const auto rr = __builtin_amdgcn_permlane32_swap(ki, ki, false, false); r0[i] = __uint_as_float(rr[0]); r1[i] = __uint_as_float(rr[1]); }
#pragma unroll
    for (int i = 0; i < 16; ++i) v[i] = __builtin_fmaxf(r0[i], r1[15 - i]);
    BMERGE16(v, 0);
}
__device__ __forceinline__ void topk_task(int tg, int hp, const bf16_t* __restrict__ qv  , LAS unsigned* lut, int* __restrict__ eidx, float* __restrict__ gate, int lane) {
    const int tl = lane & 31, hh = lane >> 5, t = tg * 32 + tl;
    const unsigned hx = (unsigned)hh << 6;
    float v1[16], v2[16];
    {
        const bf16_t* qrow = qv + (size_t)t * NQ + (2 * hp) * 256 + 64 * hh;
        float a[16], b_[16];
        u32x4 wa[8], wb[8];
        topk_load(wa, qrow); topk_load(wb, qrow + 256);
        topk_half(a, wa, qrow + 128, hx);
        __builtin_amdgcn_sched_barrier(0);
        topk_half(b_, wb, qrow + 384, hx);
#pragma unroll
        for (int i = 0; i < 16; ++i) v1[i] = hh ? b_[i] : a[i];
        __builtin_amdgcn_sched_barrier(0);
        topk_half(a, wa, nullptr, hx);
        __builtin_amdgcn_sched_barrier(0);
        topk_half(b_, wb, nullptr, hx);
#pragma unroll
        for (int i = 0; i < 16; ++i) v2[i] = hh ? b_[i] : a[i];
        __builtin_amdgcn_sched_barrier(0);
    }
    const int h = 2 * hp + hh;
    float f1[16], f2[16];
#pragma unroll
    for (int i = 0; i < 16; ++i) {
        const unsigned b1 = __float_as_uint(v1[i]), b2 = __float_as_uint(v2[i]);
        f1[i] = __uint_as_float(b1 & 0xffffff80u); f2[i] = __uint_as_float(b2 & 0xffffff80u);
        lut[i * 64 + lane] = (b1 & 127u) << 7; lut[(16 + i) * 64 + lane] = b2 & 127u;
    }
    float cand[64];
    cand[0] = ctag(f1[0] + f2[0], 255u);
    cand[1] = ctag(f1[0] + f2[1], 254u);
    cand[2] = ctag(f1[0] + f2[2], 253u);
    cand[3] = ctag(f1[0] + f2[3], 252u);
    cand[4] = ctag(f1[0] + f2[4], 251u);
    cand[5] = ctag(f1[0] + f2[5], 250u);
    cand[6] = ctag(f1[0] + f2[6], 249u);
    cand[7] = ctag(f1[0] + f2[7], 248u);
    cand[8] = ctag(f1[0] + f2[8], 247u);
    cand[9] = ctag(f1[0] + f2[9], 246u);
    cand[10] = ctag(f1[0] + f2[10], 245u);
    cand[11] = ctag(f1[0] + f2[11], 244u);
    cand[12] = ctag(f1[0] + f2[12], 243u);
    cand[13] = ctag(f1[0] + f2[13], 242u);
    cand[14] = ctag(f1[0] + f2[14], 241u);
    cand[15] = ctag(f1[0] + f2[15], 240u);
    cand[16] = ctag(f1[1] + f2[0], 239u);
    cand[17] = ctag(f1[1] + f2[1], 238u);
    cand[18] = ctag(f1[1] + f2[2], 237u);
    cand[19] = ctag(f1[1] + f2[3], 236u);
    cand[20] = ctag(f1[1] + f2[4], 235u);
    cand[21] = ctag(f1[1] + f2[5], 234u);
    cand[22] = ctag(f1[1] + f2[6], 233u);
    cand[23] = ctag(f1[1] + f2[7], 232u);
    cand[24] = ctag(f1[2] + f2[0], 223u);
    cand[25] = ctag(f1[2] + f2[1], 222u);
    cand[26] = ctag(f1[2] + f2[2], 221u);
    cand[27] = ctag(f1[2] + f2[3], 220u);
    cand[28] = ctag(f1[2] + f2[4], 219u);
    cand[29] = ctag(f1[3] + f2[0], 207u);
    cand[30] = ctag(f1[3] + f2[1], 206u);
    cand[31] = ctag(f1[3] + f2[2], 205u);
    cand[32] = ctag(f1[3] + f2[3], 204u);
    cand[33] = ctag(f1[4] + f2[0], 191u);
    cand[34] = ctag(f1[4] + f2[1], 190u);
    cand[35] = ctag(f1[4] + f2[2], 189u);
    cand[36] = ctag(f1[5] + f2[0], 175u);
    cand[37] = ctag(f1[5] + f2[1], 174u);
    cand[38] = ctag(f1[6] + f2[0], 159u);
    cand[39] = ctag(f1[6] + f2[1], 158u);
    cand[40] = ctag(f1[7] + f2[0], 143u);
    cand[41] = ctag(f1[7] + f2[1], 142u);
    cand[42] = ctag(f1[8] + f2[0], 127u);
    cand[43] = ctag(f1[9] + f2[0], 111u);
    cand[44] = ctag(f1[10] + f2[0], 95u);
    cand[45] = ctag(f1[11] + f2[0], 79u);
    cand[46] = ctag(f1[12] + f2[0], 63u);
    cand[47] = ctag(f1[13] + f2[0], 47u);
    cand[48] = ctag(f1[14] + f2[0], 31u);
    cand[49] = ctag(f1[15] + f2[0], 15u);
#pragma unroll
    for (int c = 50; c < 64; ++c) cand[c] = -INFINITY;
    top16_of_64(cand);
    float sc[16]; unsigned ex[16];
#pragma unroll
    for (int w = 0; w < 16; ++w) {
        const unsigned b = __float_as_uint(cand[w]), code = 255u - (b & 255u);
        sc[w] = __uint_as_float(b & 0xffffff00u);
        ex[w] = lut[(code >> 4) * 64 + lane] + lut[(16 + (code & 15u)) * 64 + lane];
    }
    float sum = 0.f; const float mx = sc[0];
#pragma unroll
    for (int w = 0; w < 16; ++w) { sc[w] = __expf(sc[w] - mx); sum += sc[w]; }
    const size_t o = ((size_t)t * 8 + h) * 16;
    const float inv = 1.f / sum;
#pragma unroll
    for (int i = 0; i < 4; ++i) { u32x4 w4 = {ex[4 * i], ex[4 * i + 1], ex[4 * i + 2], ex[4 * i + 3]}; *(u32x4*)(eidx + o + 4 * i) = w4; }
#pragma unroll
    for (int i = 0; i < 4; ++i) { f32x4 g4 = {sc[4 * i] * inv, sc[4 * i + 1] * inv, sc[4 * i + 2] * inv, sc[4 * i + 3] * inv}; *(f32x4*)(gate + o + 4 * i) = g4; }
}

typedef short v4i16_t __attribute__((ext_vector_type(4)));
constexpr int AT_K = 0, AT_V = 16384, AT_FK = 32768, AT_BIAS = AT_FK + 2 * 2048, AT_END = AT_BIAS + 4096,
              AT_FL = 73728, AT_DONE = AT_FL + 16, AT_QW = AT_FL + 48;
constexpr float AT_SKIP = 24.f;
__device__ __forceinline__ int crow(int r, int hh) { return (r & 3) + 8 * (r >> 2) + 4 * hh; }

__device__ __forceinline__ float at_max3(float a, float b, float c) { float r; asm("v_max3_f32 %0, %1, %2, %3" : "=v"(r) : "v"(a), "v"(b), "v"(c)); return r; }
__device__ __forceinline__ unsigned at_bf16(float x) { return cvt_pk_bf16(x, 0.f) & 0xffffu; }
__device__ __forceinline__ unsigned at_split3(float x, unsigned& d0) { const unsigned t1 = at_bf16(x); const float r1 = x - __uint_as_float(t1 << 16); const unsigned t2 = at_bf16(r1); const float r2 = r1 - __uint_as_float(t2 << 16); d0 = t1 | (t2 << 16); return at_bf16(r2); }
__device__ __forceinline__ bf16x8s at_mfrag(float m, int hh) { unsigned d0; const unsigned t3 = at_split3(-m, d0); u32x4 w = {0x3f803f80u, 0x3f80u | (d0 << 16), (d0 >> 16) | (t3 << 16), 0u}; if (hh) w = (u32x4){0u, 0u, 0u, 0u}; return __builtin_bit_cast(bf16x8s, w); }
constexpr float AT_THR = 6.f;
template <int MODE  >
__device__ __forceinline__ void attn_step(f32x16 (&o)[2], float& mhat, float& l, const bf16x8s (&qf)[4], const LAS unsigned char* Kt, const LAS unsigned char* Vt, const LAS unsigned char* AKt, bf16x8s& mfr,
                                          const LAS float* biasrow, int qg, int kv0, int lane, bool diag = false  ) {
    const int tl = lane & 31, hh = lane >> 5;
    const LAS unsigned char* kb = Kt + tl * 128; const int ksw = (tl >> 1) & 7;
    bf16x8s kf[2][4];
#pragma unroll
    for (int kvt = 0; kvt < 2; ++kvt)
#pragma unroll
        for (int ks = 0; ks < 4; ++ks) kf[kvt][ks] = *(const LAS bf16x8s*)(kb + kvt * 4096 + (((2 * ks + hh) ^ ksw) * 16));
    bf16x8s af[2];
    if (MODE < 2) {
#pragma unroll
        for (int kvt = 0; kvt < 2; ++kvt) af[kvt] = *(const LAS bf16x8s*)(AKt + (32 * kvt + tl) * 32 + hh * 16);
    } else {
        u32x4 w = {0u, 0x3f800000u, 0x3f803f80u, 0u}; if (hh) w = (u32x4){0u, 0u, 0u, 0u};
        af[0] = __builtin_bit_cast(bf16x8s, w); af[1] = af[0];
    }
    f32x16 p[2];
    const LAS unsigned char* vb = Vt + (4 * hh + ((lane & 15) >> 2)) * 64 + ((lane >> 4) & 1) * 32 + (lane & 3) * 8;
    bf16x8s vf[2][2][2];
#pragma unroll
    for (int kvt = 0; kvt < 2; ++kvt)
#pragma unroll
        for (int s = 0; s < 2; ++s)
#pragma unroll
            for (int d0 = 0; d0 < 2; ++d0) {
                const v4i16_t lo = __builtin_amdgcn_ds_read_tr16_b64_v4i16((LAS v4i16_t*)(vb + d0 * 4096 + kvt * 2048 + s * 1024));
                const v4i16_t hi = __builtin_amdgcn_ds_read_tr16_b64_v4i16((LAS v4i16_t*)(vb + d0 * 4096 + kvt * 2048 + s * 1024 + 512));
                vf[kvt][s][d0] = (bf16x8s){lo[0], lo[1], lo[2], lo[3], hi[0], hi[1], hi[2], hi[3]};
            }
    __builtin_amdgcn_sched_barrier(0);
#pragma unroll
    for (int kvt = 0; kvt < 2; ++kvt) {
        const f32x16 z = {0.f, 0.f, 0.f, 0.f, 0.f, 0.f, 0.f, 0.f, 0.f, 0.f, 0.f, 0.f, 0.f, 0.f, 0.f, 0.f};
        p[kvt] = __builtin_amdgcn_mfma_f32_32x32x16_bf16(af[kvt], mfr, z, 0, 0, 0);
#pragma unroll
        for (int ks = 0; ks < 4; ++ks) p[kvt] = __builtin_amdgcn_mfma_f32_32x32x16_bf16(kf[kvt][ks], qf[ks], p[kvt], 0, 0, 0);
    }
    if (MODE == 1 || (MODE == 0 && diag)) {
#pragma unroll
        for (int kvt = 0; kvt < 2; ++kvt)
#pragma unroll
            for (int r = 0; r < 16; ++r) { const int kv = kv0 + 32 * kvt + crow(r, hh); p[kvt][r] = (kv > qg) ? -INFINITY : p[kvt][r]; }
    }
    if (MODE == 2) {
        const LAS float* bp = biasrow + (191 - qg + kv0 + 4 * hh);
#pragma unroll
        for (int kvt = 0; kvt < 2; ++kvt)
#pragma unroll
            for (int r = 0; r < 16; ++r) {
                p[kvt][r] += bp[32 * kvt + crow(r, 0)];
            }
    }
    float mx = at_max3(p[0][0], p[1][0], p[0][1]), mx2 = at_max3(p[1][1], p[0][2], p[1][2]);
#pragma unroll
    for (int r = 3; r < 15; r += 2) { mx = at_max3(mx, p[0][r], p[1][r]); mx2 = at_max3(mx2, p[0][r + 1], p[1][r + 1]); }
    mx = at_max3(mx, p[0][15], p[1][15]); mx = __builtin_fmaxf(mx, mx2);
    { const auto rr = __builtin_amdgcn_permlane32_swap(__float_as_uint(mx), __float_as_uint(mx), false, false); mx = __builtin_fmaxf(__uint_as_float(rr[0]), __uint_as_float(rr[1])); }
    if (MODE == 0 && __all(mx < -AT_SKIP)) return;
    if (__any(mx > AT_THR)) {
        const float dl = __builtin_fmaxf(mx, 0.f), f = __builtin_amdgcn_exp2f(-dl);
        mhat += dl; l *= f; mfr = at_mfrag(mhat, hh);
#pragma unroll
        for (int kvt = 0; kvt < 2; ++kvt)
#pragma unroll
            for (int r = 0; r < 16; ++r) p[kvt][r] -= dl;
#pragma unroll
        for (int d0 = 0; d0 < 2; ++d0)
#pragma unroll
            for (int r = 0; r < 16; ++r) o[d0][r] *= f;
    }
    float sum = 0.f;
#pragma unroll
    for (int kvt = 0; kvt < 2; ++kvt)
#pragma unroll
        for (int r = 0; r < 16; ++r) { const float e = __builtin_amdgcn_exp2f(p[kvt][r]); p[kvt][r] = e; sum += e; }
    l += sum;
#pragma unroll
    for (int kvt = 0; kvt < 2; ++kvt)
#pragma unroll
        for (int s = 0; s < 2; ++s) {
            u32x4 pw;
#pragma unroll
            for (int i = 0; i < 4; ++i) pw[i] = cvt_pk_bf16(p[kvt][8 * s + 2 * i], p[kvt][8 * s + 2 * i + 1]);
            const bf16x8s pf = __builtin_bit_cast(bf16x8s, pw);
#pragma unroll
            for (int d0 = 0; d0 < 2; ++d0) o[d0] = __builtin_amdgcn_mfma_f32_32x32x16_bf16(vf[kvt][s][d0], pf, o[d0], 0, 0, 0);
        }
}

template <bool FOX>
__device__ __forceinline__ void attn_unit(LAS unsigned char* ldsl, int b, int hk, int qblk, const bf16_t* __restrict__ Q, const bf16_t* __restrict__ K, const bf16_t* __restrict__ V, int kvpitch,
                                          const float* __restrict__ F2, const float* __restrict__ sinks, bf16_t* __restrict__ MIX, int wave, int lane, unsigned serial, float sbound) {
    const int tid = threadIdx.x, tl = lane & 31, hh = lane >> 5;
    const size_t rowbase = (size_t)b * SEQ;
    int head, qw0, t_begin, t_end, wl;
    if (FOX) { head = hk; qw0 = qblk * 256 + 32 * wave; t_begin = 0; t_end = 4 * qblk + 4; wl = 4 * qblk + (wave >> 1); }
    else { head = hk * 4 + (wave >> 1); qw0 = qblk * 64 + 32 * (wave & 1); t_begin = qblk >= 2 ? qblk - 2 : 0; t_end = qblk + 1; wl = t_end; }
    const int qg = qw0 + tl;
    bf16x8s qf[4];
    { const bf16_t* qp = Q + (rowbase + qg) * 512 + head * 64 + 8 * hh;
#pragma unroll
      for (int ks = 0; ks < 4; ++ks) qf[ks] = *(const bf16x8s*)(qp + 16 * ks); }
    const float* Fr = F2 + ((size_t)b * 8 + head) * SEQ;
    float m, l;
    if (FOX) { m = 0.f; l = 0.f; } else { m = sinks[head] * LOG2E; l = hh == 0 ? 1.f : 0.f; }
    bf16x8s mfr = at_mfrag(m, hh);
    f32x16 o[2];
#pragma unroll
    for (int d0 = 0; d0 < 2; ++d0)
#pragma unroll
        for (int r = 0; r < 16; ++r) o[d0][r] = 0.f;
    const int skv = tid >> 3, sc = tid & 7;
    const bf16_t* kg = K + (rowbase + skv) * kvpitch + hk * 64 + sc * 8;
    const bf16_t* vg = V + (rowbase + skv) * kvpitch + hk * 64 + sc * 8;
    const int kwoff = skv * 128 + ((sc ^ ((skv >> 1) & 7)) * 16), vwoff = (sc >> 2) * 4096 + skv * 64 + (sc & 3) * 16;
    u32x4 kA, vA, kB, vB; float fA = 0.f, fB = 0.f;
#define AT_LOAD(t, KR, VR, FR) do { const int tt_ = (t) > t_begin ? (t) : t_begin; KR = *(const u32x4*)(kg + (size_t)tt_ * 64 * kvpitch); VR = *(const u32x4*)(vg + (size_t)tt_ * 64 * kvpitch); if (FOX) FR = Fr[tt_ * 64 + lane]; } while (0)
#define AT_WRITE(buf, KR, VR, FR) do { *(LAS u32x4*)(ldsl + AT_K + (buf) * 8192 + kwoff) = KR; *(LAS u32x4*)(ldsl + AT_V + (buf) * 8192 + vwoff) = VR; if (FOX && tid < 64) { unsigned d0_; const unsigned t3_ = at_split3(-FR, d0_); LAS u32x4* ak_ = (LAS u32x4*)(ldsl + AT_FK + (buf) * 2048 + tid * 32); ak_[0] = (u32x4){d0_, t3_ | 0x3f800000u, 0x3f803f80u, 0u}; ak_[1] = (u32x4){0u, 0u, 0u, 0u}; if (tid == 63) *(LAS float*)(ldsl + AT_FL + (buf) * 4) = -FR; } } while (0)
    AT_LOAD(t_end - 1, kA, vA, fA); AT_LOAD(t_end - 2, kB, vB, fB);
    AT_WRITE(0, kA, vA, fA);
    __syncthreads();
    const LAS float* biasrow = (const LAS float*)(ldsl + AT_BIAS) + head * 128;
#define AT_STEP(KL, VL, FL, KW, VW, FW) do { \
        const int cur = (t_end - 1 - t) & 1; \
        AT_LOAD(t - 2, KL, VL, FL); \
        const LAS unsigned char* Kt = ldsl + AT_K + cur * 8192; const LAS unsigned char* Vt = ldsl + AT_V + cur * 8192; const LAS unsigned char* Fk = ldsl + AT_FK + cur * 2048; \
        if (FOX) { \
            if (!wdone && t < wl) {     \
                const float fl_ = *(const LAS float*)(ldsl + AT_FL + cur * 4); \
                if (sbound + fl_ + wave_max_u(-m) < -AT_SKIP) { wdone = true; if (lane == 0) *(LAS unsigned*)(ldsl + AT_DONE + wave * 4) = serial; } \
            } \
            if (!wdone) { \
                if (t <= wl) attn_step<0>(o, m, l, qf, Kt, Vt, Fk, mfr, biasrow, qg, t * 64, lane, t == wl);     \
            } \
        } else attn_step<2>(o, m, l, qf, Kt, Vt, Fk, mfr, biasrow, qg, t * 64, lane); \
        if (t > t_begin) AT_WRITE(cur ^ 1, KW, VW, FW); \
        __syncthreads(); \
        if (FOX) { const bool d_ = lane < 8 ? (*(const LAS unsigned*)(ldsl + AT_DONE + lane * 4) == serial) : true; bdone = __all(d_); }     \
    } while (0)
    bool wdone = false, bdone = false;
    for (int t = t_end - 1;;) {
        AT_STEP(kA, vA, fA, kB, vB, fB); if (bdone || --t < t_begin) break;
        AT_STEP(kB, vB, fB, kA, vA, fA); if (bdone || --t < t_begin) break;
    }
#undef AT_STEP
#undef AT_LOAD
#undef AT_WRITE
    { const auto rr = __builtin_amdgcn_permlane32_swap(__float_as_uint(l), __float_as_uint(l), false, false); l = __uint_as_float(rr[0]) + __uint_as_float(rr[1]); }
    const float inv = 1.f / l;
    bf16_t* op = MIX + (rowbase + qg) * D + (FOX ? 512 : 0) + head * 64 + 4 * hh;
#pragma unroll
    for (int d0 = 0; d0 < 2; ++d0)
#pragma unroll
        for (int j = 0; j < 4; ++j) {
            u32x2 w; w.x = cvt_pk_bf16(o[d0][4 * j] * inv, o[d0][4 * j + 1] * inv); w.y = cvt_pk_bf16(o[d0][4 * j + 2] * inv, o[d0][4 * j + 3] * inv);
            *(u32x2*)(op + 32 * d0 + 8 * j) = w;
        }
}

constexpr int AT_SWA_V = 0, AT_SWA_K = 32768, AT_SWA_BIAS = 65536;
__device__ __forceinline__ void attn_swa_unit(LAS unsigned char* ldsl, int b, int kvh, int qb, const bf16_t* __restrict__ Q, const bf16_t* __restrict__ K, const bf16_t* __restrict__ V,
                                              const float* __restrict__ sinks, bf16_t* __restrict__ MIX, int wave, int lane) {
    const int tid = threadIdx.x, tl = lane & 31, hh = lane >> 5;
    const size_t rowbase = (size_t)b * SEQ;
    const int q0 = qb * 128, tbase = 2 * qb - 2;
    const int head = kvh * 4 + (wave >> 1);
    const int skv = tid >> 3, sc = tid & 7;
    const int kwoff = skv * 128 + ((sc ^ ((skv >> 1) & 7)) * 16), vwoff = (sc >> 2) * 4096 + skv * 64 + (sc & 3) * 16;
    u32x4 kr[4], vr[4];
#pragma unroll
    for (int sl = 0; sl < 4; ++sl) { const int tt = tbase + sl < 0 ? 0 : tbase + sl; const size_t off = (rowbase + (size_t)tt * 64 + skv) * 128 + kvh * 64 + sc * 8; kr[sl] = *(const u32x4*)(K + off); vr[sl] = *(const u32x4*)(V + off); }
#pragma unroll
    for (int sl = 0; sl < 4; ++sl) { *(LAS u32x4*)(ldsl + AT_SWA_K + sl * 8192 + kwoff) = kr[sl]; *(LAS u32x4*)(ldsl + AT_SWA_V + sl * 8192 + vwoff) = vr[sl]; }
    __syncthreads();
    const LAS float* biasrow = (const LAS float*)(ldsl + AT_SWA_BIAS) + head * 256;
    const float sink2 = sinks[head] * LOG2E;
#pragma unroll 1
    for (int ps = 0; ps < 2; ++ps) {
        const int qg = q0 + 64 * ps + 32 * (wave & 1) + tl;
        bf16x8s qf[4];
        { const bf16_t* qp = Q + (rowbase + qg) * 512 + head * 64 + 8 * hh;
#pragma unroll
          for (int ks = 0; ks < 4; ++ks) qf[ks] = *(const bf16x8s*)(qp + 16 * ks); }
        float m = sink2, l = hh == 0 ? 1.f : 0.f;
        bf16x8s mfr = at_mfrag(m, hh);
        f32x16 o[2];
#pragma unroll
        for (int d0 = 0; d0 < 2; ++d0)
#pragma unroll
            for (int r = 0; r < 16; ++r) o[d0][r] = 0.f;
#pragma unroll 1
        for (int j = 2; j >= 0; --j) {
            const int sl = ps + j, t = tbase + sl;
            if (t >= 0) attn_step<2>(o, m, l, qf, ldsl + AT_SWA_K + sl * 8192, ldsl + AT_SWA_V + sl * 8192, ldsl, mfr, biasrow, qg, t * 64, lane);
        }
        { const auto rr = __builtin_amdgcn_permlane32_swap(__float_as_uint(l), __float_as_uint(l), false, false); l = __uint_as_float(rr[0]) + __uint_as_float(rr[1]); }
        const float inv = 1.f / l;
        bf16_t* op = MIX + (rowbase + qg) * D + head * 64 + 4 * hh;
#pragma unroll
        for (int d0 = 0; d0 < 2; ++d0)
#pragma unroll
            for (int jj = 0; jj < 4; ++jj) {
                u32x2 w; w.x = cvt_pk_bf16(o[d0][4 * jj] * inv, o[d0][4 * jj + 1] * inv); w.y = cvt_pk_bf16(o[d0][4 * jj + 2] * inv, o[d0][4 * jj + 3] * inv);
                *(u32x2*)(op + 32 * d0 + 8 * jj) = w;
            }
    }
    __syncthreads();
}

__device__ __forceinline__ void attn_phase(LAS unsigned char* ldsl, const bf16_t* QA, const bf16_t* KA, const bf16_t* VA, const bf16_t* QB, const bf16_t* KB, const bf16_t* VB,
                                           const float* __restrict__ F2, const float* __restrict__ sinks, const float* __restrict__ relb, const float* __restrict__ gqb, const float* __restrict__ gkb,
                                           bf16_t* MIX, unsigned* qctr  , int G, int wave, int lane) {
    for (int i = threadIdx.x; i < 8 * 256; i += 512) { const int h = i >> 8, dist = 191 - (i & 255); ((LAS float*)(ldsl + AT_SWA_BIAS))[i] = (unsigned)dist < 128u ? relb[(int)T5B[dist & 127] * 8 + h] * LOG2E : -INFINITY; }
    if (threadIdx.x < 8) *(LAS unsigned*)(ldsl + AT_DONE + threadIdx.x * 4) = 0u;
    const float sbound = 64.f * C2 * 1.02f * wave_max_u(fabsf(gqb[lane])) * wave_max_u(fabsf(gkb[lane]));
    __syncthreads();
    unsigned serial = 0;
    for (;;) {
        if (threadIdx.x == 0) *(LAS unsigned*)(ldsl + AT_QW) = __hip_atomic_fetch_add(qctr, 1u, __ATOMIC_RELAXED, __HIP_MEMORY_SCOPE_AGENT);
        __syncthreads();
        const unsigned u = *(const LAS unsigned*)(ldsl + AT_QW);
        __syncthreads();
        if (u >= 768u) break;
        if (u < 512u) { const int bh = (int)(u & 31u), qb = 15 - (int)(u >> 5); ++serial;
            attn_unit<true>(ldsl, bh >> 3, bh & 7, qb, QB, KB, VB, 512, F2, sinks, MIX, wave, lane, serial, sbound); }
        else { const int us = (int)u - 512; attn_swa_unit(ldsl, us >> 6, (us >> 5) & 1, us & 31, QA, KA, VA, sinks, MIX, wave, lane); }
    }
}
#define RLX_AGENT __ATOMIC_RELAXED, __HIP_MEMORY_SCOPE_AGENT
#define XB_TMO      128
#define XB_XCNT(j)  (256  + 64 * (j))
#define XB_XSUB(j)  (1280 + 64 * (j))
#define XB_XGEN(j)  (2304 + 64 * (j))
#define XB_TOP      3328
#define XB_TOPGEN   3392
#define XCD_BAR_WORDS 3456
#define XB_SPIN_CAP (1u << 22)

__device__ __forceinline__ unsigned xb_ld(unsigned* p)              { return __hip_atomic_load(p, __ATOMIC_RELAXED, __HIP_MEMORY_SCOPE_AGENT); }
__device__ __forceinline__ unsigned xb_add(unsigned* p, unsigned v) { return __hip_atomic_fetch_add(p, v, __ATOMIC_RELAXED, __HIP_MEMORY_SCOPE_AGENT); }
__device__ __forceinline__ unsigned xb_xcc_id() { return (unsigned)__builtin_amdgcn_s_getreg((3 << 11) | 20) & 0xFu; }
#define XB_SPIN(cond, bar) do { unsigned _sp = 0; while (cond) { __builtin_amdgcn_s_sleep(1); \
    if ((++_sp & 255u) == 0u) { if (xb_ld(&(bar)[XB_TMO])) break; if (_sp > XB_SPIN_CAP) { atomicAdd(&(bar)[XB_TMO], 1u); break; } } } } while (0)

struct XcdBarrier {
    unsigned* bar; unsigned x;
    volatile LAS unsigned* st;
};

__device__ __forceinline__ XcdBarrier xcd_barrier_post(unsigned* bar, volatile LAS unsigned* st) {
    XcdBarrier b; b.bar = bar; b.x = xb_xcc_id(); b.st = st;
    if (threadIdx.x == 0) (void)xb_add(&bar[XB_XCNT(b.x)], 1u);
    return b;
}
__device__ __forceinline__ void xcd_barrier_complete(unsigned* bar, unsigned x, unsigned& nloc, unsigned& nx) {
    const unsigned G = gridDim.x * gridDim.y * gridDim.z;
    unsigned sum, cnt, mine, sp = 0u;
    for (;;) {
        sum = 0u; cnt = 0u; mine = 0u;
#pragma unroll
        for (unsigned j = 0; j < 16; ++j) { const unsigned c = xb_ld(&bar[XB_XCNT(j)]); sum += c; cnt += (c > 0u) ? 1u : 0u; mine = (j == x) ? c : mine; }
        if (sum == G) break;
        __builtin_amdgcn_s_sleep(1);
        if ((++sp & 255u) == 0u) { if (xb_ld(&bar[XB_TMO])) break; if (sp > XB_SPIN_CAP) { atomicAdd(&bar[XB_TMO], 1u); break; } }
    }
    nloc = mine > 0u ? mine : 1u; nx = cnt > 0u ? cnt : 1u;
}

__device__ __forceinline__ void xcd_barrier(const XcdBarrier& b) {
    asm volatile("s_waitcnt vmcnt(0)" ::: "memory");
    __syncthreads();
    if (threadIdx.x == 0) {
        unsigned* bar = b.bar;
        __builtin_amdgcn_s_waitcnt(0);
        unsigned nloc = b.st[0], nx = b.st[1];
        if (nloc == 0u) { xcd_barrier_complete(bar, b.x, nloc, nx); b.st[0] = nloc; b.st[1] = nx; }
        const unsigned old = xb_add(&bar[XB_XSUB(b.x)], 1u);
        const unsigned gen = old / nloc;
        if (old + 1u == (gen + 1u) * nloc) {
            __builtin_amdgcn_fence(__ATOMIC_RELEASE, "agent");
            asm volatile("s_waitcnt vmcnt(0)" ::: "memory");
            const unsigned og = xb_add(&bar[XB_TOP], 1u);
            const unsigned tg = og / nx;
            if (og + 1u == (tg + 1u) * nx) xb_add(&bar[XB_TOPGEN], 1u);
            else XB_SPIN(xb_ld(&bar[XB_TOPGEN]) == tg, bar);
            __builtin_amdgcn_fence(__ATOMIC_ACQUIRE, "agent");
            xb_add(&bar[XB_XGEN(b.x)], 1u);
            asm volatile("s_waitcnt vmcnt(0)" ::: "memory");
        } else {
            XB_SPIN(xb_ld(&bar[XB_XGEN(b.x)]) == gen, bar);
            __builtin_amdgcn_fence(__ATOMIC_ACQUIRE, "agent");
            asm volatile("s_waitcnt vmcnt(0)" ::: "memory");
        }
    }
    __syncthreads();
}
constexpr int LDS_BYTES = 147456;
struct Params { const float* in[17]; float* out; unsigned char* ws; };

__global__ void __launch_bounds__(512, 2) mega(Params p) {
    extern __shared__ __attribute__((aligned(16))) unsigned char lds[];
    const float* x = p.in[0]; const float* relb = p.in[1]; const float* norm_mix = p.in[2]; const float* w_in = p.in[3];
    const float* gqa = p.in[4]; const float* gka = p.in[5]; const float* gqb = p.in[6]; const float* gkb = p.in[7];
    const float* bforget = p.in[8]; const float* sinks = p.in[9]; const float* w_out = p.in[10]; const float* norm_ffn = p.in[11];
    const float* w_query = p.in[12]; const float* sk1 = p.in[13]; const float* sk2 = p.in[14]; const float* eu = p.in[15]; const float* ev = p.in[16];
    float* out = p.out; unsigned char* ws = p.ws;
    bf16_t* WTIN = (bf16_t*)(ws + WS_WTIN); bf16_t* WTOUT = (bf16_t*)(ws + WS_WTOUT); bf16_t* WTQ = (bf16_t*)(ws + WS_WTQ);
    float* LOGF = (float*)(ws + WS_LOGF); float* F2 = (float*)(ws + WS_F2); float* SSQ = (float*)(ws + WS_SSQ);
    int* EIDX = (int*)(ws + WS_EIDX); float* GATE = (float*)(ws + WS_GATE);
    bf16_t* XN = (bf16_t*)(ws + WS_XN); bf16_t* AP = XN;
    bf16_t* QA = (bf16_t*)(ws + WS_QA); bf16_t* KA = (bf16_t*)(ws + WS_KA); bf16_t* VA = (bf16_t*)(ws + WS_VA);
    bf16_t* QB = (bf16_t*)(ws + WS_QB); bf16_t* KB = (bf16_t*)(ws + WS_KB); bf16_t* VB = (bf16_t*)(ws + WS_VB);
    bf16_t* MIX = (bf16_t*)(ws + WS_MIX); bf16_t* QV = (bf16_t*)(ws + WS_QV);

    unsigned char* EU8 = ws + WS_EU8; unsigned char* EV8 = ws + WS_EV8; float* SU = (float*)(ws + WS_SU); float* SV = (float*)(ws + WS_SV); float* RR = (float*)(ws + WS_RR);
    const int tid = threadIdx.x, lane = tid & 63, wave = __builtin_amdgcn_readfirstlane(tid >> 6);
    const int G = gridDim.x, gw = blockIdx.x * 8 + wave, NGW = G * 8;
    LAS unsigned char* ldsl = (LAS unsigned char*)lds;
    if (tid < 4) ((LAS unsigned*)(ldsl + LDS_BYTES - 16))[tid] = 0u;
    __syncthreads();
    const XcdBarrier xbar = xcd_barrier_post((unsigned*)(ws + WS_CTL), (volatile LAS unsigned*)(ldsl + LDS_BYTES - 16));

    {
        LAS float* scr = (LAS float*)(ldsl + wave * 16384);
        constexpr int I_IN = 16 * (NQKV / 32), I_OUT = 16 * (D / 32), I_Q = 16 * 32 * 4;
        for (int it = gw; it < I_IN + I_OUT + I_Q; it += NGW) {
            int r = it;
            if (r < I_Q) { p0_keyfold_item(w_query, sk1, sk2, norm_ffn, WTQ, r, lane); continue; } r -= I_Q;
            if (r < I_IN) { p0_transpose_item<true, true>(w_in, INW, D, NQKV / 32, WTIN, scr, r, lane, norm_mix); continue; } r -= I_IN;
            p0_transpose_item<false>(w_out, D, D, D / 32, WTOUT, scr, r, lane);
        }
        p0_rows(x, norm_mix, w_in, bforget, XN, RR, LOGF, gw, NGW, lane);
    }
    xcd_barrier(xbar);
    {
        { const int cb = G >= 128 ? (int)blockIdx.x - (G - 32) : (int)blockIdx.x;
          if (cb >= 0 && cb < 32) p1_cumsum(cb, (LAS float*)ldsl, LOGF, F2); }
        pg8::Gemm g{XN, WTIN, M, NQKV, D}; pg8::StaticOrder S; S.init(M, NQKV, G, (int)blockIdx.x);
        EpiQKV E{QA, KA, VA, QB, KB, VB, gqa, gka, gqb, gkb, RR};
        pg8::gemm_phase<EpiQKV, pg8::StaticOrder, true, true>(ldsl, g, S, E);
        { const int nfull = (M / 256) * (NQKV / 256) - 2 * G;
          if (nfull > 0 && nfull < G) { if ((int)blockIdx.x >= nfull) { const int qw = ((int)blockIdx.x - nfull) * 8 + wave, NQW = (G - nfull) * 8; p0_quant4_rows<1>(eu, EU8, SU, qw, NQW, lane); p0_quant4_rows<2>(ev, EV8, SV, qw, NQW, lane); } }
          else { p0_quant4_rows<1>(eu, EU8, SU, gw, NGW, lane); p0_quant4_rows<2>(ev, EV8, SV, gw, NGW, lane); } }
    }
    xcd_barrier(xbar);
    attn_phase(ldsl, QA, KA, VA, QB, KB, VB, F2, sinks, relb, gqb, gkb, MIX, (unsigned*)(ws + WS_CTL) + 3584, G, wave, lane);
    xcd_barrier(xbar);
    {
        pg8::Gemm g{MIX, WTOUT, M, D, D}; pg8::StaticOrder S; S.init(M, D, G, (int)blockIdx.x);
        EpiOut E{AP, SSQ};
        pg8::gemm_phase<EpiOut, pg8::StaticOrder, true, true>(ldsl, g, S, E);
    }
    xcd_barrier(xbar);
    {
        pg8::Gemm g{AP, WTQ, M, NQ, D}; pg8::StaticOrder S; S.init(M, NQ, G, (int)blockIdx.x);
        EpiQV E{QV, SSQ};
        pg8::gemm_phase<EpiQV, pg8::StaticOrder, true, true>(ldsl, g, S, E);
    }
    xcd_barrier(xbar);
    {
        LAS unsigned* lut = (LAS unsigned*)(ldsl + TK_LUT_OFF + wave * 8192);
        for (int task = gw; task < (M / 32) * 4; task += NGW) topk_task(task >> 2, task & 3, QV, lut, EIDX, GATE, lane);
    }
    const bool p6local = NGW == (M / 32) * 4 && NGW * 8 == M;
    if (p6local) { __builtin_amdgcn_fence(__ATOMIC_RELEASE, "workgroup"); __syncthreads(); __builtin_amdgcn_fence(__ATOMIC_ACQUIRE, "workgroup"); }
    else xcd_barrier(xbar);
    { auto gbar = [&]() { xcd_barrier(xbar); };
      const int tfirst = p6local ? 64 * (int)blockIdx.x + 8 * wave : gw, tstep = 8 * NGW, tstride = p6local ? 1 : NGW, ntb = p6local ? 1 : (M + 8 * NGW - 1) / (8 * NGW);
      gather_chunked(AP, SSQ, norm_ffn, EIDX, GATE, EU8, EV8, SU, SV, out, ldsl + wave * GQ_WAVE, tfirst, tstep, tstride, ntb, lane, gbar); }
}
}

extern "C" void kernel_launch(void* const* d_in, const int* in_sizes, int n_in, void* d_out, int out_size, void* d_ws, size_t ws_size, hipStream_t stream) {
    static int grid_blocks = 0;
    if (!grid_blocks) {
        int dev = 0, cus = 0, per_cu = 0;
        (void)hipGetDevice(&dev);
        (void)hipDeviceGetAttribute(&cus, hipDeviceAttributeMultiprocessorCount, dev);
        (void)hipFuncSetAttribute((const void*)mk::mega, hipFuncAttributeMaxDynamicSharedMemorySize, mk::LDS_BYTES);
        (void)hipOccupancyMaxActiveBlocksPerMultiprocessor(&per_cu, (const void*)mk::mega, 512, (size_t)mk::LDS_BYTES);
        if (per_cu < 1) fprintf(stderr, "occupancy query says %d blocks/CU\n", per_cu);
        grid_blocks = cus;
    }
    (void)hipMemsetAsync(d_ws, 0, 16384, stream);
    mk::Params p{};
    for (int i = 0; i < 17; ++i) p.in[i] = (const float*)d_in[i];
    p.out = (float*)d_out; p.ws = (unsigned char*)d_ws;
    void* args[] = {&p};
    hipError_t e = hipLaunchCooperativeKernel((void*)mk::mega, dim3(grid_blocks), dim3(512), args, (size_t)mk::LDS_BYTES, stream);
    if (e != hipSuccess) fprintf(stderr, "cooperative launch failed: %s (grid %d)\n", hipGetErrorString(e), grid_blocks);
}
```

```cpp
#include <hip/hip_runtime.h>
#include <cstdint>
#include <cstdio>
namespace pg8 {
#define PG8_LAS __attribute__((address_space(3)))
typedef unsigned short bf16_t;
typedef short bf16x8 __attribute__((ext_vector_type(8)));
typedef float f32x4 __attribute__((ext_vector_type(4)));
typedef unsigned u32x4 __attribute__((ext_vector_type(4)));
constexpr int BM = 256, BK = 64, HALF = 128, HTB = HALF * BK * 2  , STAGE_BYTES = 8 * HTB, NXCD = 8, WGM = 8;

__host__ __device__ __forceinline__ int lds_byte(int r, int c) { const int st = (r >> 4) * 2 + (c >> 5), rr = r & 15, cc = c & 31, ob = rr * 64 + cc * 2; return st * 1024 + (ob ^ (((ob >> 9) & 1) << 5)); }
__host__ __device__ __forceinline__ void stage_rc(int b, int& R, int& C) { const int st = b / 1024, sb = b % 1024, swz = sb ^ (((sb >> 9) & 1) << 5); R = (st >> 1) * 16 + swz / 64; C = (st & 1) * 32 + (swz % 64) / 2; }
__host__ __device__ __forceinline__ int perm32(int rho) { const int n = rho >> 4, i = rho & 15; return 8 * (i >> 2) + 4 * n + (i & 3); }

struct Unit { int pm, pn; };
struct Gemm { const bf16_t* A; const bf16_t* Bt; int M, N, K; };

struct StaticOrder {
    int nM, nN, nwg, G, c;
    __host__ __device__ void init(int M, int N, int G_, int c_) { nM = M / BM; nN = N / BM; nwg = nM * nN; G = G_; c = c_; }
    __host__ __device__ bool next(int i, Unit& u) const {
        const long L = (long)i * G + c; if (L >= nwg) return false;
        int wgid = (int)L; { const int q = nwg / NXCD, r = nwg % NXCD, xcd = wgid % NXCD, off = wgid / NXCD; wgid = (xcd < r ? xcd * (q + 1) : r * (q + 1) + (xcd - r) * q) + off; }
        const int nig = WGM * nN, gid = wgid / nig, fm = gid * WGM, gsz = (nM - fm) < WGM ? (nM - fm) : WGM;
        u.pm = fm + ((wgid % nig) % gsz); u.pn = (wgid % nig) / gsz; return true;
    }
    __device__ __forceinline__ void a_ready(const Unit&) const {}
    __device__ __forceinline__ void done(const Unit&) const {}
};

__device__ __forceinline__ unsigned cvt_pk_bf16(float lo, float hi) { unsigned r; asm volatile("v_cvt_pk_bf16_f32 %0, %1, %2" : "=v"(r) : "v"(lo), "v"(hi)); return r; }
typedef float f32x2 __attribute__((ext_vector_type(2)));
template <class Epi, class Sched, bool ALIGN_EPI = false, bool SP2 = false>
__device__ __forceinline__ void gemm_phase(PG8_LAS unsigned char* lds, const Gemm g, const Sched& S, const Epi& E) {
    int tid_ = threadIdx.x; asm volatile("" : "+v"(tid_));
    const int tid = tid_, wid = __builtin_amdgcn_readfirstlane(tid >> 6), lane = tid & 63, wr = wid >> 2, wc = wid & 3, fr = lane & 15, fq = lane >> 4;
    const int K = g.K, nt = K / BK;
    unsigned voffA[2], voffB[2];
#pragma unroll
    for (int i = 0; i < 2; ++i) { int R, C; stage_rc(tid * 16 + i * 8192, R, C); const int Rb = Epi::PERM ? ((R & ~31) + perm32(R & 31)) : R;
        voffA[i] = (unsigned)(R * K + C) * 2u; voffB[i] = (unsigned)(Rb * K + C) * 2u; }
    const size_t kstep = (size_t)(BK * 2);
    const size_t hstep = (size_t)HALF * K * 2;
    const size_t tstep = 2 * hstep;
    const unsigned ldsw = (unsigned)wid * 1024u;
    const int aoff = lds_byte(wr * 64 + fr, fq * 8), boff = lds_byte(wc * 32 + fr, fq * 8);
#define PG8_SA(b, h) (((b) * 2 + (h)) * HTB)
#define PG8_SB(b, h) ((4 + (b) * 2 + (h)) * HTB)
#define PG8_STAGE(bufoff, gbase, voff) do { _Pragma("unroll") for (int _i = 0; _i < 2; ++_i) \
        __builtin_amdgcn_global_load_lds((const unsigned*)((const char*)(gbase) + (voff)[_i]), (PG8_LAS unsigned*)(lds + (bufoff) + ldsw + _i * 8192), 16, 0, 0); } while (0)
#define PG8_LDA(dst, b, h) do { _Pragma("unroll") for (int m = 0; m < 4; ++m) _Pragma("unroll") for (int k = 0; k < 2; ++k) dst[m][k] = *(const PG8_LAS bf16x8*)(lds + PG8_SA(b, h) + aoff + m * 2048 + k * 1024); } while (0)
#define PG8_LDB(dst, b, h) do { _Pragma("unroll") for (int n = 0; n < 2; ++n) _Pragma("unroll") for (int k = 0; k < 2; ++k) dst[n][k] = *(const PG8_LAS bf16x8*)(lds + PG8_SB(b, h) + boff + n * 2048 + k * 1024); } while (0)
#define PG8_MMA(ai, bj, At, Bt) do { __builtin_amdgcn_s_setprio(1); _Pragma("unroll") for (int m = 0; m < 4; ++m) _Pragma("unroll") for (int n = 0; n < 2; ++n) _Pragma("unroll") for (int k = 0; k < 2; ++k) \
        acc[ai][bj][m][n] = __builtin_amdgcn_mfma_f32_16x16x32_bf16(Bt[n][k], At[m][k], acc[ai][bj][m][n], 0, 0, 0); __builtin_amdgcn_s_setprio(0); } while (0)
#define PG8_WAIT_V(n) asm volatile("s_waitcnt vmcnt(" #n ")" ::: "memory")
#define PG8_WAIT_L(n) asm volatile("s_waitcnt lgkmcnt(" #n ")" ::: "memory")
#define PG8_BAR __builtin_amdgcn_s_barrier()
#define PG8_SCHED __builtin_amdgcn_sched_barrier(0)
    Unit cur, nxt; int ui = 0;
    if (!S.next(0, cur)) return;
    f32x4 acc[2][2][4][2];
#pragma unroll
    for (int a = 0; a < 2; ++a)
#pragma unroll
        for (int b = 0; b < 2; ++b)
#pragma unroll
            for (int m = 0; m < 4; ++m)
#pragma unroll
                for (int n = 0; n < 2; ++n) acc[a][b][m][n] = (f32x4){0.f, 0.f, 0.f, 0.f};
    bf16x8 At[4][2], B0[2][2], B1[2][2];
    const char* cA = (const char*)g.A + (size_t)cur.pm * tstep; const char* cB = (const char*)g.Bt + (size_t)cur.pn * tstep;
    S.a_ready(cur);
    if constexpr (SP2) {
        PG8_STAGE(PG8_SB(0, 0), cB, voffB); PG8_STAGE(PG8_SB(0, 1), cB + hstep, voffB); PG8_STAGE(PG8_SA(0, 0), cA, voffA); PG8_STAGE(PG8_SA(0, 1), cA + hstep, voffA);
        if (wr == 1) PG8_BAR;
        PG8_WAIT_V(2); PG8_BAR;
        PG8_STAGE(PG8_SB(1, 0), cB + kstep, voffB); PG8_STAGE(PG8_SA(1, 0), cA + kstep, voffA); PG8_STAGE(PG8_SB(1, 1), cB + hstep + kstep, voffB);
        PG8_WAIT_V(6); PG8_BAR;
    } else {
        PG8_STAGE(PG8_SB(0, 0), cB, voffB); PG8_STAGE(PG8_SA(0, 0), cA, voffA); PG8_STAGE(PG8_SB(0, 1), cB + hstep, voffB); PG8_STAGE(PG8_SA(0, 1), cA + hstep, voffA);
        if (wr == 1) PG8_BAR;
        PG8_WAIT_V(4); PG8_BAR;
        PG8_STAGE(PG8_SB(1, 0), cB + kstep, voffB); PG8_STAGE(PG8_SA(1, 0), cA + kstep, voffA); PG8_STAGE(PG8_SB(1, 1), cB + hstep + kstep, voffB);
        PG8_WAIT_V(6); PG8_BAR;
    }
    for (;;) {
        const bool has_next = S.next(ui + 1, nxt);
        const char* nA = has_next ? (const char*)g.A + (size_t)nxt.pm * tstep : cA; const char* nB = has_next ? (const char*)g.Bt + (size_t)nxt.pn * tstep : cB;
        for (int t = 0; t < nt; t += 2) {
            const bool last = (t == nt - 2);
            const char* a1 = cA + (size_t)(t + 1) * kstep;
            const char* a2 = last ? nA : cA + (size_t)(t + 2) * kstep; const char* b2 = last ? nB : cB + (size_t)(t + 2) * kstep;
            const char* a3 = a2 + kstep; const char* b3 = b2 + kstep;
            if (last && has_next) S.a_ready(nxt);
            if constexpr (SP2) {
            PG8_LDB(B0, 0, 0); PG8_LDB(B1, 0, 1); PG8_SCHED; PG8_LDA(At, 0, 0); PG8_STAGE(PG8_SA(1, 1), a1 + hstep, voffA);
            PG8_WAIT_V(8); PG8_WAIT_L(0); PG8_BAR; PG8_MMA(0, 0, At, B0); PG8_MMA(0, 1, At, B1); PG8_BAR; PG8_SCHED;
            PG8_LDA(At, 0, 1); PG8_STAGE(PG8_SB(0, 0), b2, voffB); PG8_STAGE(PG8_SB(0, 1), b2 + hstep, voffB); PG8_STAGE(PG8_SA(0, 0), a2, voffA);
            PG8_WAIT_V(8); PG8_WAIT_L(0); PG8_BAR; PG8_MMA(1, 0, At, B0); PG8_MMA(1, 1, At, B1); PG8_BAR; PG8_SCHED;
            PG8_LDB(B0, 1, 0); PG8_LDB(B1, 1, 1); PG8_SCHED; PG8_LDA(At, 1, 0); PG8_STAGE(PG8_SA(0, 1), a2 + hstep, voffA);
            PG8_WAIT_V(8); PG8_WAIT_L(0); PG8_BAR; PG8_MMA(0, 0, At, B0); PG8_MMA(0, 1, At, B1); PG8_BAR; PG8_SCHED;
            PG8_LDA(At, 1, 1); PG8_STAGE(PG8_SB(1, 0), b3, voffB); PG8_STAGE(PG8_SB(1, 1), b3 + hstep, voffB); PG8_STAGE(PG8_SA(1, 0), a3, voffA);
            PG8_WAIT_V(8); PG8_WAIT_L(0); PG8_BAR; PG8_MMA(1, 0, At, B0); PG8_MMA(1, 1, At, B1); PG8_BAR; PG8_SCHED;
            } else {
            PG8_LDB(B0, 0, 0); PG8_SCHED; PG8_LDA(At, 0, 0); PG8_STAGE(PG8_SA(1, 1), a1 + hstep, voffA);
            PG8_WAIT_L(8); PG8_BAR; PG8_WAIT_L(0); PG8_MMA(0, 0, At, B0); PG8_BAR; PG8_SCHED;
            PG8_LDB(B1, 0, 1); PG8_STAGE(PG8_SB(0, 0), b2, voffB);
            PG8_BAR; PG8_WAIT_L(0); PG8_MMA(0, 1, At, B1); PG8_BAR;
            PG8_LDA(At, 0, 1); PG8_STAGE(PG8_SA(0, 0), a2, voffA);
            PG8_BAR; PG8_WAIT_L(0); PG8_MMA(1, 0, At, B0); PG8_BAR; PG8_SCHED;
            PG8_STAGE(PG8_SB(0, 1), b2 + hstep, voffB);
            PG8_WAIT_V(6); PG8_BAR; PG8_MMA(1, 1, At, B1); PG8_BAR;
            PG8_LDB(B0, 1, 0); PG8_SCHED; PG8_LDA(At, 1, 0); PG8_STAGE(PG8_SA(0, 1), a2 + hstep, voffA);
            PG8_WAIT_L(8); PG8_BAR; PG8_WAIT_L(0); PG8_MMA(0, 0, At, B0); PG8_BAR; PG8_SCHED;
            PG8_LDB(B1, 1, 1); PG8_STAGE(PG8_SB(1, 0), b3, voffB);
            PG8_BAR; PG8_WAIT_L(0); PG8_MMA(0, 1, At, B1); PG8_BAR;
            PG8_LDA(At, 1, 1); PG8_STAGE(PG8_SA(1, 0), a3, voffA);
            PG8_BAR; PG8_WAIT_L(0); PG8_MMA(1, 0, At, B0); PG8_BAR; PG8_SCHED;
            PG8_STAGE(PG8_SB(1, 1), b3 + hstep, voffB);
            PG8_WAIT_V(6); PG8_BAR; PG8_MMA(1, 1, At, B1); PG8_BAR;
            }
        }
        if constexpr (ALIGN_EPI) { if (wr == 0) PG8_BAR; }
        if constexpr (!Epi::AFTER_DRAIN) { E(acc, cur, wr, wc, fr, fq); S.done(cur); }
        if (!has_next) break;
#pragma unroll
        for (int a = 0; a < 2; ++a)
#pragma unroll
            for (int b = 0; b < 2; ++b)
#pragma unroll
                for (int m = 0; m < 4; ++m)
#pragma unroll
                    for (int n = 0; n < 2; ++n) acc[a][b][m][n] = (f32x4){0.f, 0.f, 0.f, 0.f};
        cur = nxt; cA = nA; cB = nB; ++ui;
        if constexpr (ALIGN_EPI) { if (wr == 1) PG8_BAR; }
    }
    PG8_WAIT_V(0);
    if constexpr (!ALIGN_EPI) { if (wr == 0) PG8_BAR; }
    PG8_BAR;
    if constexpr (Epi::AFTER_DRAIN) { E.fused(acc, cur, wr, wc, fr, fq, lds, wid, lane); S.done(cur); }
#undef PG8_SA
#undef PG8_SB
#undef PG8_STAGE
#undef PG8_LDA
#undef PG8_LDB
#undef PG8_MMA
#undef PG8_WAIT_V
#undef PG8_WAIT_L
#undef PG8_BAR
#undef PG8_SCHED
}
}
namespace mk {
using pg8::bf16_t; using pg8::f32x4; using pg8::u32x4; using pg8::Unit; using pg8::cvt_pk_bf16;
typedef unsigned u32x2 __attribute__((ext_vector_type(2)));
#define LAS __attribute__((address_space(3)))
constexpr int D = 1024, BATCH = 4, SEQ = 4096, M = BATCH * SEQ;
constexpr int INW = 2312, NQKV = 2304, NQ = 2048, NEXP = 16384;
constexpr float EPS = 1e-6f, LOG2E = 1.4426950408889634f, C2 = 0.125f * LOG2E;
constexpr size_t MiB = 1u << 20;
constexpr size_t WS_CTL = 0, WS_WTIN = 1 * MiB, WS_WTOUT = 6 * MiB, WS_WTQ = 8 * MiB, WS_SK = 12 * MiB, WS_LOGF = 13 * MiB, WS_F2 = 13 * MiB + 512 * 1024, WS_SSQ = 14 * MiB,
                 WS_EIDX = 16 * MiB, WS_GATE = 24 * MiB, WS_XN = 32 * MiB, WS_QA = 64 * MiB, WS_KA = 80 * MiB, WS_VA = 84 * MiB, WS_QB = 88 * MiB, WS_KB = 104 * MiB, WS_VB = 120 * MiB,
                 WS_MIX = 136 * MiB, WS_QV = 64 * MiB, WS_EU8 = 168 * MiB, WS_EV8 = 184 * MiB, WS_X1 = 192 * MiB, WS_COEF = 136 * MiB, WS_CSUM = 144 * MiB, WS_SU = 15 * MiB, WS_SV = 15 * MiB + 65536, WS_RR = 15 * MiB + 131072;

__device__ __constant__ unsigned char T5B[128] = {0, 1, 2, 3, 4, 5, 6, 7, 8, 9, 10, 11, 12, 13, 14, 15, 16, 16, 16, 17, 17, 18, 18, 18, 19, 19, 19, 20, 20, 20, 20, 21, 21, 21, 21, 22, 22, 22, 22, 22, 23, 23, 23, 23, 23, 23, 24, 24, 24, 24, 24, 24, 25, 25, 25, 25, 25, 25, 25, 26, 26, 26, 26, 26, 26, 26, 26, 27, 27, 27, 27, 27, 27, 27, 27, 27, 27, 28, 28, 28, 28, 28, 28, 28, 28, 28, 28, 29, 29, 29, 29, 29, 29, 29, 29, 29, 29, 29, 29, 30, 30, 30, 30, 30, 30, 30, 30, 30, 30, 30, 30, 30, 30, 31, 31, 31, 31, 31, 31, 31, 31, 31, 31, 31, 31, 31, 31, 31};

__device__ __forceinline__ float wave_sum(float v) {
#pragma unroll
    for (int o = 1; o < 64; o <<= 1) v += __shfl_xor(v, o);
    return v;
}
__device__ __forceinline__ float bf_lo(unsigned w) { return __uint_as_float(w << 16); }
__device__ __forceinline__ float bf_hi(unsigned w) { return __uint_as_float(w & 0xffff0000u); }

struct EpiQKV {
    static constexpr bool PERM = true, AFTER_DRAIN = false;
    bf16_t *QA, *KA, *VA, *QB, *KB, *VB; const float *gqa, *gka, *gqb, *gkb; const float* rr;
    __device__ __forceinline__ void operator()(const f32x4 (&acc)[2][2][4][2], const Unit& u, int wr, int wc, int fr, int fq) const {
        const int s = u.pn * 4 + wc;
        bf16_t* dst; int pitch; const float* g; float sc = 1.f;
        if (s < 8) { dst = QA + 64 * s; pitch = 512; g = gqa; sc = C2; }
        else if (s < 10) { dst = KA + 64 * (s - 8); pitch = 128; g = gka; }
        else if (s < 12) { dst = VA + 64 * (s - 10); pitch = 128; g = nullptr; }
        else if (s < 20) { dst = QB + 64 * (s - 12); pitch = 512; g = gqb; sc = C2; }
        else if (s < 28) { dst = KB + 64 * (s - 20); pitch = 512; g = gkb; }
        else { dst = VB + 64 * (s - 28); pitch = 512; g = nullptr; }
        f32x4 gv[2][2];
#pragma unroll
        for (int bj = 0; bj < 2; ++bj)
#pragma unroll
            for (int n = 0; n < 2; ++n) gv[bj][n] = g ? *(const f32x4*)(g + 32 * bj + 8 * fq + 4 * n) * sc : (f32x4){1.f, 1.f, 1.f, 1.f};
        const int row0 = u.pm * 256 + wr * 64 + fr;
        float rw[2][4];
#pragma unroll
        for (int ai = 0; ai < 2; ++ai)
#pragma unroll
            for (int m = 0; m < 4; ++m) rw[ai][m] = rr[row0 + ai * 128 + m * 16];
#pragma unroll
        for (int ai = 0; ai < 2; ++ai)
#pragma unroll
            for (int m = 0; m < 4; ++m) {
                float ss = 0.f;
#pragma unroll
                for (int bj = 0; bj < 2; ++bj)
#pragma unroll
                    for (int n = 0; n < 2; ++n) { const f32x4 v = acc[ai][bj][m][n]; ss += (v[0] * v[0] + v[1] * v[1]) + (v[2] * v[2] + v[3] * v[3]); }
                ss += __shfl_xor(ss, 16); ss += __shfl_xor(ss, 32);
                const float rx = rw[ai][m]; const float rs = g ? rsqrtf(ss * (rx * rx) * (1.f / 64.f) + EPS) * rx : rx;
                bf16_t* rowp = dst + (size_t)(row0 + ai * 128 + m * 16) * pitch + 8 * fq;
#pragma unroll
                for (int bj = 0; bj < 2; ++bj) {
                    const f32x4 v0 = acc[ai][bj][m][0] * rs * gv[bj][0], v1 = acc[ai][bj][m][1] * rs * gv[bj][1];
                    u32x4 w; w.x = cvt_pk_bf16(v0[0], v0[1]); w.y = cvt_pk_bf16(v0[2], v0[3]); w.z = cvt_pk_bf16(v1[0], v1[1]); w.w = cvt_pk_bf16(v1[2], v1[3]);
                    *(u32x4*)(rowp + 32 * bj) = w;
                }
            }
    }
};
struct EpiOut {
    static constexpr bool PERM = true, AFTER_DRAIN = false;
    bf16_t* ap; float* ssq;
    __device__ __forceinline__ void operator()(const f32x4 (&acc)[2][2][4][2], const Unit& u, int wr, int wc, int fr, int fq) const {
        const int col0 = u.pn * 256 + wc * 32 + 8 * fq;
        const int row0 = u.pm * 256 + wr * 64 + fr;
        u32x4 xc[2][4][2];
#pragma unroll
        for (int m = 0; m < 4; ++m)
#pragma unroll
            for (int bj = 0; bj < 2; ++bj) xc[0][m][bj] = *(const u32x4*)(ap + (size_t)(row0 + m * 16) * D + col0 + bj * 128);
        __builtin_amdgcn_sched_barrier(0);
#pragma unroll
        for (int ai = 0; ai < 2; ++ai) {
#pragma unroll
            for (int m = 0; m < 4; ++m) {
                const int row = row0 + ai * 128 + m * 16; const size_t off = (size_t)row * D + col0; float ss = 0.f;
#pragma unroll
                for (int bj = 0; bj < 2; ++bj) {
                    const u32x4 xw = xc[ai][m][bj];
                    const f32x4 v0 = acc[ai][bj][m][0] + (f32x4){bf_lo(xw.x), bf_hi(xw.x), bf_lo(xw.y), bf_hi(xw.y)};
                    const f32x4 v1 = acc[ai][bj][m][1] + (f32x4){bf_lo(xw.z), bf_hi(xw.z), bf_lo(xw.w), bf_hi(xw.w)};
                    ss += ((v0[0] * v0[0] + v0[1] * v0[1]) + (v0[2] * v0[2] + v0[3] * v0[3])) + ((v1[0] * v1[0] + v1[1] * v1[1]) + (v1[2] * v1[2] + v1[3] * v1[3]));
                    u32x4 w; w.x = cvt_pk_bf16(v0[0], v0[1]); w.y = cvt_pk_bf16(v0[2], v0[3]); w.z = cvt_pk_bf16(v1[0], v1[1]); w.w = cvt_pk_bf16(v1[2], v1[3]);
                    *(u32x4*)(ap + off + bj * 128) = w;
                }
                if (ai == 0) {
#pragma unroll
                    for (int bj = 0; bj < 2; ++bj) xc[1][m][bj] = *(const u32x4*)(ap + (size_t)(row0 + 128 + m * 16) * D + col0 + bj * 128);
                }
                ss += __shfl_xor(ss, 16); ss += __shfl_xor(ss, 32);
                if (fq == 0) ssq[(size_t)row * 16 + u.pn * 4 + wc] = ss;
                __builtin_amdgcn_sched_barrier(0);
            }
        }
    }
};
struct EpiQV {
    static constexpr bool PERM = true, AFTER_DRAIN = false;
    bf16_t* qv; const float* ssq;
    __device__ __forceinline__ void operator()(const f32x4 (&acc)[2][2][4][2], const Unit& u, int wr, int wc, int fr, int fq) const {
        const int row0 = u.pm * 256 + wr * 64 + fr, col0 = u.pn * 256 + wc * 32 + 8 * fq;
#pragma unroll
        for (int ai = 0; ai < 2; ++ai)
#pragma unroll
            for (int m = 0; m < 4; ++m) {
                const int row = row0 + ai * 128 + m * 16;
                const f32x4* sp = (const f32x4*)(ssq + (size_t)row * 16);
                const f32x4 s0 = sp[0], s1 = sp[1], s2 = sp[2], s3 = sp[3];
                const float tot = ((s0[0] + s0[1]) + (s0[2] + s0[3])) + ((s1[0] + s1[1]) + (s1[2] + s1[3])) + ((s2[0] + s2[1]) + (s2[2] + s2[3])) + ((s3[0] + s3[1]) + (s3[2] + s3[3]));
                const float rs = rsqrtf(tot * (1.f / D) + EPS);
                bf16_t* rowp = qv + (size_t)row * NQ + col0;
#pragma unroll
                for (int bj = 0; bj < 2; ++bj) {
                    const f32x4 v0 = acc[ai][bj][m][0] * rs, v1 = acc[ai][bj][m][1] * rs;
                    u32x4 w; w.x = cvt_pk_bf16(v0[0], v0[1]); w.y = cvt_pk_bf16(v0[2], v0[3]); w.z = cvt_pk_bf16(v1[0], v1[1]); w.w = cvt_pk_bf16(v1[2], v1[3]);
                    *(u32x4*)(rowp + 128 * bj) = w;
                }
            }
    }
};

__device__ __forceinline__ int rowmap_in(int n0) { const int s = n0 >> 6, bj = (n0 >> 5) & 1; return 256 * (s >> 2) + 128 * bj + 32 * (s & 3); }
template <bool MAPIN, bool SCALE = false  >
__device__ __forceinline__ void p0_transpose_item(const float* __restrict__ W, int ldw, int K, int nblk, bf16_t* __restrict__ WT, LAS float* scr, int item, int lane, const float* __restrict__ rsc = nullptr) {
    const int kb = item / nblk, nb = item % nblk, k0 = 64 * kb, n0 = 32 * nb;
    const int r0 = MAPIN ? rowmap_in(n0) : n0;
#pragma unroll 8
    for (int i = 0; i < 32; ++i) { const int kk = 2 * i + (lane >> 5); scr[kk * 33 + (lane & 31)] = W[(size_t)(k0 + kk) * ldw + n0 + (lane & 31)] * (SCALE ? rsc[k0 + kk] : 1.f); }
    asm volatile("s_waitcnt lgkmcnt(0)" ::: "memory");
    const int c = lane & 7;
#pragma unroll
    for (int j = 0; j < 4; ++j) { const int n = (lane >> 3) + 8 * j; const LAS float* s = scr + (8 * c) * 33 + n;
        u32x4 o; o.x = cvt_pk_bf16(s[0 * 33], s[1 * 33]); o.y = cvt_pk_bf16(s[2 * 33], s[3 * 33]); o.z = cvt_pk_bf16(s[4 * 33], s[5 * 33]); o.w = cvt_pk_bf16(s[6 * 33], s[7 * 33]);
        *(u32x4*)(WT + (size_t)(r0 + n) * K + k0 + 8 * c) = o; }
    asm volatile("s_waitcnt lgkmcnt(0)" ::: "memory");
}
__device__ __forceinline__ void p0_keyfold_item(const float* __restrict__ wq, const float* __restrict__ sk1, const float* __restrict__ sk2, const float* __restrict__ g, bf16_t* __restrict__ WT, int item, int lane) {
    typedef short bf16x8s_ __attribute__((ext_vector_type(8)));
    typedef float f32x16_ __attribute__((ext_vector_type(16)));
    const int tile = item & 3, k0 = 32 * ((item >> 2) & 31), hh2 = item >> 7, tl = lane & 31, dg = lane >> 5;
    const float* sp = ((hh2 & 1) ? sk2 : sk1) + (size_t)(32 * tile + tl) * 128 + dg * 8;
    const float* wrow = wq + (size_t)(k0 + tl) * NQ + hh2 * 128 + dg * 8;
    const float gk = g[k0 + tl];
    f32x4 a0[8], a1[8], b0[8], b1[8];
#pragma unroll
    for (int ds = 0; ds < 8; ++ds) { b0[ds] = *(const f32x4*)(wrow + ds * 16); b1[ds] = *(const f32x4*)(wrow + ds * 16 + 4); a0[ds] = *(const f32x4*)(sp + ds * 16); a1[ds] = *(const f32x4*)(sp + ds * 16 + 4); }
    f32x16_ acc;
#pragma unroll
    for (int r = 0; r < 16; ++r) acc[r] = 0.f;
#pragma unroll
    for (int ds = 0; ds < 8; ++ds) {
        const f32x4 p0 = b0[ds] * gk, p1 = b1[ds] * gk;
        const u32x4 bw = {cvt_pk_bf16(p0[0], p0[1]), cvt_pk_bf16(p0[2], p0[3]), cvt_pk_bf16(p1[0], p1[1]), cvt_pk_bf16(p1[2], p1[3])};
        const u32x4 aw = {cvt_pk_bf16(a0[ds][0], a0[ds][1]), cvt_pk_bf16(a0[ds][2], a0[ds][3]), cvt_pk_bf16(a1[ds][0], a1[ds][1]), cvt_pk_bf16(a1[ds][2], a1[ds][3])};
        acc = __builtin_amdgcn_mfma_f32_32x32x16_bf16(__builtin_bit_cast(bf16x8s_, aw), __builtin_bit_cast(bf16x8s_, bw), acc, 0, 0, 0);
    }
    const int odd = tl & 1;
#pragma unroll
    for (int r = 0; r < 16; r += 2) {
        const float own0 = acc[r], own1 = acc[r + 1];
        const float recv = __shfl_xor(odd ? own0 : own1, 1);
        const int n = 32 * tile + ((r + odd) & 3) + 8 * ((r + odd) >> 2) + 4 * dg;
        const unsigned w = odd ? cvt_pk_bf16(recv, own1) : cvt_pk_bf16(own0, recv);
        *(unsigned*)(WT + (size_t)(hh2 * 128 + n) * D + k0 + (tl & ~1)) = w;
    }
}
__device__ __forceinline__ void p0_convert(const float* __restrict__ src, bf16_t* __restrict__ dst, size_t n8, int gw, int NGW, int lane) {
    for (size_t i = (size_t)gw * 64 + lane; i < n8; i += (size_t)NGW * 64) {
        const f32x4 a = ((const f32x4*)src)[2 * i], b = ((const f32x4*)src)[2 * i + 1];
        u32x4 w; w.x = cvt_pk_bf16(a[0], a[1]); w.y = cvt_pk_bf16(a[2], a[3]); w.z = cvt_pk_bf16(b[0], b[1]); w.w = cvt_pk_bf16(b[2], b[3]);
        ((u32x4*)dst)[i] = w;
    }
}
__device__ __forceinline__ void p0_rows(const float* __restrict__ x, const float* __restrict__ g, const float* __restrict__ w_in, const float* __restrict__ bforget, bf16_t* __restrict__ XN, float* __restrict__ RR, float* __restrict__ logf, int gw, int NGW, int lane, LAS unsigned char* wsl  ) {
    for (int k = threadIdx.x; k < D; k += 512) { const f32x4* wp = (const f32x4*)(w_in + (size_t)k * INW + NQKV); const f32x4 a = wp[0], b = wp[1];
        LAS f32x4* dp = (LAS f32x4*)(wsl + ((((k >> 8) * 4 + (k & 3)) * 64 + ((k >> 2) & 63)) * 32)); dp[0] = a; dp[1] = b; }
    __syncthreads();
    f32x4 wa[16], wb[16];
#pragma unroll
    for (int jj = 0; jj < 4; ++jj)
#pragma unroll
        for (int e = 0; e < 4; ++e) { const LAS f32x4* wp = (const LAS f32x4*)(wsl + (((jj * 4 + e) * 64 + lane) * 32)); wa[jj * 4 + e] = wp[0]; wb[jj * 4 + e] = wp[1]; }
    const float bl = bforget[lane & 7];
#pragma unroll 1
    for (int rowb = gw; rowb < M; rowb += 4 * NGW) {
        f32x4 v4[4][4];
#pragma unroll
        for (int r = 0; r < 4; ++r) { const int row = rowb + r * NGW < M ? rowb + r * NGW : rowb; const f32x4* xr = (const f32x4*)(x + (size_t)row * D);
#pragma unroll
            for (int jj = 0; jj < 4; ++jj) v4[r][jj] = __builtin_nontemporal_load(xr + lane + 64 * jj); }
#pragma unroll
        for (int r = 0; r < 4; ++r) {
            const int row = rowb + r * NGW;
            if (row < M) {
                float s = 0.f;
#pragma unroll
                for (int jj = 0; jj < 4; ++jj) { const f32x4 v = v4[r][jj]; s += (v[0] * v[0] + v[1] * v[1]) + (v[2] * v[2] + v[3] * v[3]); }
                s = wave_sum(s);
                const float rs = rsqrtf(s * (1.f / D) + EPS);
                f32x4 pa = {0.f, 0.f, 0.f, 0.f}, pb = {0.f, 0.f, 0.f, 0.f};
#pragma unroll
                for (int jj = 0; jj < 4; ++jj) {
                    const f32x4 v = v4[r][jj]; const f32x4 h = v * rs * ((const f32x4*)g)[lane + 64 * jj];
                    u32x2 w; w.x = cvt_pk_bf16(v[0], v[1]); w.y = cvt_pk_bf16(v[2], v[3]);
                    *(u32x2*)(XN + (size_t)row * D + 256 * jj + 4 * lane) = w;
#pragma unroll
                    for (int e = 0; e < 4; ++e) { pa += wa[jj * 4 + e] * h[e]; pb += wb[jj * 4 + e] * h[e]; }
                }
                float z = 0.f;
#pragma unroll
                for (int j = 0; j < 4; ++j) { const float sa = wave_sum(pa[j]), sb = wave_sum(pb[j]); if (lane == j) z = sa; if (lane == 4 + j) z = sb; }
                if (lane == 8) RR[row] = rs;
                if (lane < 8) { z += bl; logf[(size_t)row * 8 + lane] = fminf(z, 0.f) - log1pf(expf(-fabsf(z))); }
            }
        }
    }
}
__device__ __forceinline__ void p1_cumsum(int bh, LAS float* part, const float* __restrict__ logf, float* __restrict__ F2) {
    const int b = bh >> 3, h = bh & 7, tid = threadIdx.x, lane = tid & 63, wv = tid >> 6;
    float v[8]; float s = 0.f;
#pragma unroll
    for (int i = 0; i < 8; ++i) { s += logf[((size_t)b * SEQ + tid * 8 + i) * 8 + h]; v[i] = s; }
    float inc = s;
#pragma unroll
    for (int o = 1; o < 64; o <<= 1) { const float t = __shfl_up(inc, o); if (lane >= o) inc += t; }
    if (lane == 63) part[wv] = inc;
    __syncthreads();
    float base = inc - s;
    for (int w = 0; w < wv; ++w) base += part[w];
#pragma unroll
    for (int i = 0; i < 8; ++i) F2[(size_t)bh * SEQ + tid * 8 + i] = (base + v[i]) * LOG2E;
    __syncthreads();
}
__device__ __forceinline__ float wave_max(float v) {
#pragma unroll
    for (int o = 1; o < 64; o <<= 1) v = fmaxf(v, __shfl_xor(v, o));
    return v;
}
template <int SIGNED  >
__device__ __forceinline__ void p0_quant4_rows(const float* __restrict__ T, unsigned char* __restrict__ T4, float* __restrict__ SC, int gw, int NGW, int lane) {
    for (int row = gw; row < NEXP; row += NGW) {
        const f32x4* tr = (const f32x4*)(T + (size_t)row * D + 16 * lane);
        f32x4 v[4]; float ss = 0.f;
#pragma unroll
        for (int j = 0; j < 4; ++j) { v[j] = __builtin_nontemporal_load(tr + j); ss += (v[j][0] * v[j][0] + v[j][1] * v[j][1]) + (v[j][2] * v[j][2] + v[j][3] * v[j][3]); }
        ss = wave_sum(ss);
        const float s = fmaxf(0.3352f * sqrtf(ss * (1.f / D)), 1e-30f), inv = 1.f / s;
        u32x2 w;
#pragma unroll
        for (int j2 = 0; j2 < 2; ++j2) {
            unsigned p = 0;
#pragma unroll
            for (int e = 0; e < 4; ++e) {
                const int lo = ((int)fminf(fmaxf(floorf(v[2 * j2][e] * inv), -8.f), 7.f) + (SIGNED == 1 ? 0 : 8)) & 15, hi = (int)fminf(fmaxf(floorf(v[2 * j2 + 1][e] * inv), -8.f), 7.f) & 15;
                p |= ((unsigned)lo | ((unsigned)hi << 4)) << (8 * e);
            }
            w[j2] = p;
        }
        *(u32x2*)(T4 + (size_t)row * 512 + 8 * lane) = w;
        if (lane == 0) SC[row] = s;
    }
}

__device__ __forceinline__ int row16_sum_i(int v) {
    v += __builtin_amdgcn_update_dpp(0, v, 0xB1, 0xf, 0xf, false);
    v += __builtin_amdgcn_update_dpp(0, v, 0x4E, 0xf, 0xf, false);
    v += __builtin_amdgcn_update_dpp(0, v, 0x141, 0xf, 0xf, false);
    v += __builtin_amdgcn_update_dpp(0, v, 0x140, 0xf, 0xf, false);
    return v;
}
typedef int i32x4 __attribute__((ext_vector_type(4)));
typedef float f32x2 __attribute__((ext_vector_type(2)));
__device__ __forceinline__ float ub(unsigned w, int k) { return (float)((w >> (8 * k)) & 0xffu); }

constexpr int GQ_DOT = 0, GQ_TOKC = 4096, GQ_PKL = 4352, GQ_UN = 5376, GQ_H2Q = GQ_UN, GQ_UIMG = GQ_UN + 8192, GQ_VIMG = GQ_UN, GQ_WAVE = 17920;
constexpr int GQ_UROW = 68, GQ_VROW = 36;
static_assert(GQ_UIMG + 16 * GQ_UROW * 4 <= GQ_WAVE && GQ_VIMG + 64 * GQ_VROW * 4 <= GQ_WAVE && 8 * GQ_WAVE <= 147440, "gather LDS");
#define GT_DPP(v, ctrl) __uint_as_float((unsigned)__builtin_amdgcn_update_dpp(0, (int)__float_as_uint(v), ctrl, 0xf, 0xf, false))
__device__ __forceinline__ float wave_max_u(float v) {
    v = fmaxf(v, GT_DPP(v, 0xB1)); v = fmaxf(v, GT_DPP(v, 0x4E)); v = fmaxf(v, GT_DPP(v, 0x141)); v = fmaxf(v, GT_DPP(v, 0x140));
    const int iv = (int)__float_as_uint(v);
    const float a = __uint_as_float((unsigned)__builtin_amdgcn_readlane(iv, 0)), b = __uint_as_float((unsigned)__builtin_amdgcn_readlane(iv, 16)), c = __uint_as_float((unsigned)__builtin_amdgcn_readlane(iv, 32)), d = __uint_as_float((unsigned)__builtin_amdgcn_readlane(iv, 48));
    return fmaxf(fmaxf(a, b), fmaxf(c, d));
}
__device__ __forceinline__ int wave_sum_iu(int v) { v = row16_sum_i(v); return (__builtin_amdgcn_readlane(v, 0) + __builtin_amdgcn_readlane(v, 16)) + (__builtin_amdgcn_readlane(v, 32) + __builtin_amdgcn_readlane(v, 48)); }

template <class Bar>
__device__ __forceinline__ void gather_chunked(const bf16_t* __restrict__ ap, const float* __restrict__ ssq, const float* __restrict__ gffn, const int* __restrict__ eidx, const float* __restrict__ gate,
                                               const unsigned char* __restrict__ EU4, const unsigned char* __restrict__ EV4, const float* __restrict__ SU, const float* __restrict__ SV,
                                               float* __restrict__ out, LAS unsigned char* wl, int tfirst, int tstep, int tstride, int ntb  , int lane, const Bar& bar) {
    const int g8 = lane >> 3, pc = lane & 7, g84 = 4 * g8;
    const int asub = ((lane >> 2) & 1) + 2 * (lane >> 4);
    const bool arow_ = (lane & 15) < 8;
    const unsigned am0 = (arow_ && (lane & 3) == 0) ? 0xffffffffu : 0u, am1 = (arow_ && (lane & 3) == 1) ? 0xffffffffu : 0u, am2 = (arow_ && (lane & 3) == 2) ? 0xffffffffu : 0u, am3 = (arow_ && (lane & 3) == 3) ? 0xffffffffu : 0u;
    const bool vsrc = lane < 8 || (lane >= 24 && lane < 32);
    const int vrow = lane < 8 ? lane : lane - 16;
    const unsigned pc16 = (unsigned)pc * 16u;
    LAS int* DOT = (LAS int*)(wl + GQ_DOT); LAS float* TOKC = (LAS float*)(wl + GQ_TOKC); LAS unsigned* PKL = (LAS unsigned*)(wl + GQ_PKL);
    LAS unsigned char* H2Q = wl + GQ_H2Q; LAS int* UIMG = (LAS int*)(wl + GQ_UIMG); LAS int* VIMG = (LAS int*)(wl + GQ_VIMG);
#pragma unroll 1
    for (int tb = 0; tb < ntb; ++tb) {
        const int t0 = tfirst + tb * tstep;
        int ntok = 0; if (t0 < M) { ntok = (M - t0 + tstride - 1) / tstride; ntok = ntok > 8 ? 8 : ntok; }
#pragma unroll 1
        for (int i = 0; i < ntok; ++i) {
            const int t = t0 + i * tstride;
            float rs;
            { const f32x4* sp = (const f32x4*)(ssq + (size_t)t * 16); const f32x4 a = sp[0], b = sp[1], c = sp[2], d = sp[3];
              const float tot = ((a[0] + a[1]) + (a[2] + a[3])) + ((b[0] + b[1]) + (b[2] + b[3])) + ((c[0] + c[1]) + (c[2] + c[3])) + ((d[0] + d[1]) + (d[2] + d[3]));
              rs = rsqrtf(tot * (1.f / D) + EPS); }
            const u32x4* hp = (const u32x4*)(ap + (size_t)t * D + 16 * lane); const u32x4 w0 = hp[0], w1 = hp[1];
            float h[16];
#pragma unroll
            for (int k = 0; k < 4; ++k) { h[2 * k] = bf_lo(w0[k]); h[2 * k + 1] = bf_hi(w0[k]); h[8 + 2 * k] = bf_lo(w1[k]); h[8 + 2 * k + 1] = bf_hi(w1[k]); }
#pragma unroll
            for (int k = 0; k < 4; ++k) { const f32x4 gk = ((const f32x4*)(gffn + 16 * lane))[k]; h[4 * k] *= gk[0]; h[4 * k + 1] *= gk[1]; h[4 * k + 2] *= gk[2]; h[4 * k + 3] *= gk[3]; }
            float am = 0.f;
#pragma unroll
            for (int k = 0; k < 16; ++k) am = fmaxf(am, fabsf(h[k]));
            am = wave_max_u(am);
            const float hinv = am > 0.f ? 119.f / am : 0.f;
            u32x4 qw; int hs = -128;
#pragma unroll
            for (int d = 0; d < 2; ++d) {
                unsigned u[8];
#pragma unroll
                for (int j = 0; j < 8; ++j) u[j] = __float_as_uint(__builtin_fmaf(h[8 * d + j], hinv, 12582920.f));
                const unsigned ba = __builtin_amdgcn_perm(__builtin_amdgcn_perm(u[3], u[2], 0x0c0c0400u), __builtin_amdgcn_perm(u[1], u[0], 0x0c0c0400u), 0x05040100u);
                const unsigned bb = __builtin_amdgcn_perm(__builtin_amdgcn_perm(u[7], u[6], 0x0c0c0400u), __builtin_amdgcn_perm(u[5], u[4], 0x0c0c0400u), 0x05040100u);
                hs = __builtin_amdgcn_sdot4((int)ba, 0x01010101, hs, false); hs = __builtin_amdgcn_sdot4((int)bb, 0x01010101, hs, false);
                qw[2 * d] = ((ba >> 4) & 0x0f0f0f0fu) | (((bb >> 4) & 0x0f0f0f0fu) << 4);
                qw[2 * d + 1] = ((ba & 0x0f0f0f0fu) ^ 0x08080808u) | (((bb & 0x0f0f0f0fu) ^ 0x08080808u) << 4);
            }
            *(LAS u32x4*)(H2Q + i * 1024 + 16 * lane) = qw;
            hs = wave_sum_iu(hs);
            if (lane == 0) { TOKC[i * 8 + 0] = am * (1.f / 119.f) * rs; TOKC[i * 8 + 1] = (float)hs; }
            DOT[i * 128 + lane] = 0; DOT[i * 128 + 64 + lane] = 0;
        }
        u32x4 r[16];
        int en0 = 0, en1 = 0;
        {
            const int nit = 4 * ntok;
            int e0 = 0, e1 = 0;
            if (ntok > 0) { e0 = eidx[(size_t)t0 * 128 + lane]; e1 = eidx[(size_t)t0 * 128 + 64 + lane]; }
            if (nit > 1) { const int tn = t0 + (1 % ntok) * tstride; en0 = eidx[(size_t)tn * 128 + lane]; en1 = eidx[(size_t)tn * 128 + 64 + lane]; }
            if (nit > 0) {
#pragma unroll
                for (int s_ = 0; s_ < 16; ++s_) { const unsigned e = (unsigned)__builtin_amdgcn_ds_bpermute(g84 + 32 * (s_ & 7), s_ < 8 ? e0 : e1); r[s_] = *(const u32x4*)(EU4 + (e * 512u + pc16)); }
            }
#pragma unroll 1
            for (int n = 0; n < nit; ++n) {
                const int c = n / ntok, i = n - c * ntok;
                const int n1 = n + 1; const bool more = n1 < nit; const int c1 = more ? n1 / ntok : 0;
                int ef0 = 0, ef1 = 0;
                { const int n2 = n + 2; const int i2 = n2 % ntok; const int tn = t0 + i2 * tstride; ef0 = eidx[(size_t)tn * 128 + lane]; ef1 = eidx[(size_t)tn * 128 + 64 + lane]; }
                int hq[8];
                { const LAS i32x4* hp = (const LAS i32x4*)(H2Q + i * 1024 + 256 * c + 32 * pc); const i32x4 a = hp[0], b = hp[1];
                  hq[0] = a[0]; hq[1] = a[1]; hq[2] = a[2]; hq[3] = a[3]; hq[4] = b[0]; hq[5] = b[1]; hq[6] = b[2]; hq[7] = b[3]; }
                const unsigned noff = (unsigned)c1 * 128u + pc16;
                const unsigned char* nbase = more ? EU4 : EV4;
                unsigned enx = (unsigned)__builtin_amdgcn_ds_bpermute(g84, en0);
#pragma unroll
                for (int s_ = 0; s_ < 16; ++s_) {
                    const unsigned ecur = enx;
                    if (s_ + 1 < 16) enx = (unsigned)__builtin_amdgcn_ds_bpermute(g84 + 32 * ((s_ + 1) & 7), (s_ + 1) < 8 ? en0 : en1);
                    int ah, al;
                    { const int w = (int)r[s_][0]; asm("v_dot8_i32_i4 %0, %1, %2, 0" : "=v"(ah) : "v"(w), "v"(hq[0])); asm("v_dot8_i32_i4 %0, %1, %2, 0" : "=v"(al) : "v"(w), "v"(hq[1])); }
#pragma unroll
                    for (int q = 1; q < 4; ++q) { const int w = (int)r[s_][q]; ah = __builtin_amdgcn_sdot8(w, hq[2 * q], ah, false); al = __builtin_amdgcn_sdot8(w, hq[2 * q + 1], al, false); }
                    UIMG[s_ * GQ_UROW + lane] = 16 * ah + al;
                    r[s_] = *(const u32x4*)(nbase + (ecur * 512u + noff));
                    __builtin_amdgcn_sched_barrier(0);
                }
                { const LAS int* rp = UIMG + (lane >> 3) * GQ_UROW + 8 * (lane & 7);
                  const i32x4 a0 = *(const LAS i32x4*)(rp), a1 = *(const LAS i32x4*)(rp + 4), b0 = *(const LAS i32x4*)(rp + 8 * GQ_UROW), b1 = *(const LAS i32x4*)(rp + 8 * GQ_UROW + 4);
                  DOT[i * 128 + lane] += ((a0[0] + a0[1]) + (a0[2] + a0[3])) + ((a1[0] + a1[1]) + (a1[2] + a1[3]));
                  DOT[i * 128 + 64 + lane] += ((b0[0] + b0[1]) + (b0[2] + b0[3])) + ((b1[0] + b1[1]) + (b1[2] + b1[3])); }
                en0 = ef0; en1 = ef1;
            }
        }
#pragma unroll 1
        for (int i = 0; i < ntok; ++i) {
            const int t = t0 + i * tstride;
            const int e0 = eidx[(size_t)t * 128 + lane], e1 = eidx[(size_t)t * 128 + 64 + lane];
            const float g0 = gate[(size_t)t * 128 + lane], g1 = gate[(size_t)t * 128 + 64 + lane];
            const float su0 = SU[e0], su1 = SU[e1], sv0 = SV[e0], sv1 = SV[e1];
            const float sh = TOKC[i * 8 + 0], hoff = 0.5f * TOKC[i * 8 + 1];
            const float p0 = ((float)DOT[i * 128 + lane] + hoff) * su0 * sh, p1 = ((float)DOT[i * 128 + 64 + lane] + hoff) * su1 * sh;
            const float c0 = g0 * 0.5f * p0 * (1.f + erff(p0 * 0.70710678118654752f)) * sv0, c1 = g1 * 0.5f * p1 * (1.f + erff(p1 * 0.70710678118654752f)) * sv1;
            const float cmax = wave_max_u(fmaxf(fabsf(c0), fabsf(c1)));
            const float cinv = cmax > 0.f ? 127.f / cmax : 0.f;
            const int cq0 = __float2int_rn(c0 * cinv), cq1 = __float2int_rn(c1 * cinv);
            const int csq = wave_sum_iu(cq0 + cq1);
            unsigned pk = 0;
            { const int G = (lane >> 3) & 3, gl = lane & 7;
#pragma unroll
              for (int m = 0; m < 4; ++m) { const int slot = 32 * G + gl + 8 * m; const int a = __builtin_amdgcn_ds_bpermute(4 * (slot & 63), cq0), b = __builtin_amdgcn_ds_bpermute(4 * (slot & 63), cq1);
                  pk |= ((unsigned)(G < 2 ? a : b) & 0xffu) << (8 * m); } }
            if (lane < 32) PKL[i * 32 + lane] = pk;
            if (lane == 0) { TOKC[i * 8 + 2] = cmax * (1.f / 127.f); TOKC[i * 8 + 3] = (float)csq; }
        }
        {
            const int nit = 4 * ntok;
#pragma unroll 1
            for (int n = 0; n < nit; ++n) {
                const int c = n / ntok, i = n - c * ntok;
                const int n1 = n + 1; const bool more = n1 < nit; const int c1 = more ? n1 / ntok : 0;
                const int t = t0 + i * tstride;
                int ef0 = 0, ef1 = 0;
                { const int n2 = n + 2; const int i2 = n2 % ntok; const int tn = t0 + i2 * tstride; ef0 = eidx[(size_t)tn * 128 + lane]; ef1 = eidx[(size_t)tn * 128 + 64 + lane]; }
                const u32x2 xrw = *(const u32x2*)(ap + (size_t)t * D + 256 * c + 4 * lane); const f32x4 xres = {bf_lo(xrw.x), bf_hi(xrw.x), bf_lo(xrw.y), bf_hi(xrw.y)};
                const unsigned noff = (unsigned)c1 * 128u + pc16;
                i32x4 accl[4], accf[4];
#pragma unroll
                for (int G = 0; G < 4; ++G) {
                    const int cpA = (int)PKL[i * 32 + 8 * G + asub];
                    const i32x4 Aop = {(int)((unsigned)cpA & am0), (int)((unsigned)cpA & am1), (int)((unsigned)cpA & am2), (int)((unsigned)cpA & am3)};
                    unsigned en[4];
#pragma unroll
                    for (int m = 0; m < 4; ++m) { const int s_ = 4 * G + m; en[m] = (unsigned)__builtin_amdgcn_ds_bpermute(g84 + 32 * (s_ & 7), s_ < 8 ? en0 : en1); }
#pragma unroll
                    for (int q = 0; q < 4; ++q) {
                        const unsigned x0 = r[4 * G][q], x1_ = r[4 * G + 1][q], x2 = r[4 * G + 2][q], x3 = r[4 * G + 3][q];
                        const unsigned t0_ = __builtin_amdgcn_perm(x1_, x0, 0x05010400u), t1_ = __builtin_amdgcn_perm(x1_, x0, 0x07030602u);
                        const unsigned t2_ = __builtin_amdgcn_perm(x3, x2, 0x05010400u), t3_ = __builtin_amdgcn_perm(x3, x2, 0x07030602u);
                        const unsigned y0 = __builtin_amdgcn_perm(t2_, t0_, 0x05040100u), y1 = __builtin_amdgcn_perm(t2_, t0_, 0x07060302u);
                        const unsigned y2 = __builtin_amdgcn_perm(t3_, t1_, 0x05040100u), y3 = __builtin_amdgcn_perm(t3_, t1_, 0x07060302u);
                        const i32x4 Bf = {(int)y0, (int)y1, (int)y2, (int)y3};
                        const i32x4 Bl = {(int)(y0 & 0x0f0f0f0fu), (int)(y1 & 0x0f0f0f0fu), (int)(y2 & 0x0f0f0f0fu), (int)(y3 & 0x0f0f0f0fu)};
                        const i32x4 z4 = {0, 0, 0, 0};
                        accf[q] = __builtin_amdgcn_mfma_i32_16x16x64_i8(Aop, Bf, G == 0 ? z4 : accf[q], 0, 0, 0);
                        accl[q] = __builtin_amdgcn_mfma_i32_16x16x64_i8(Aop, Bl, G == 0 ? z4 : accl[q], 0, 0, 0);
                    }
#pragma unroll
                    for (int m = 0; m < 4; ++m) r[4 * G + m] = *(const u32x4*)(EV4 + (en[m] * 512u + noff));
                    __builtin_amdgcn_sched_barrier(0);
                }
                if (vsrc) {
#pragma unroll
                    for (int q = 0; q < 4; ++q) {
                        *(LAS i32x4*)(VIMG + vrow * GQ_VROW + 8 * q) = accl[q];
                        *(LAS i32x4*)(VIMG + vrow * GQ_VROW + 8 * q + 4) = accf[q] - accl[q];
                    }
                }
                const i32x4 sm = *(const LAS i32x4*)(VIMG + (lane >> 3) * GQ_VROW + 4 * (lane & 7)) + *(const LAS i32x4*)(VIMG + (8 + (lane >> 3)) * GQ_VROW + 4 * (lane & 7));
                const float csc0 = TOKC[i * 8 + 2], csc = (lane & 1) ? csc0 * 0.0625f : csc0, off = ((lane & 1) ? 0.5f : -7.5f) * csc0 * TOKC[i * 8 + 3];
                f32x4 o; o[0] = xres[0] + (float)sm[0] * csc + off; o[1] = xres[1] + (float)sm[1] * csc + off; o[2] = xres[2] + (float)sm[2] * csc + off; o[3] = xres[3] + (float)sm[3] * csc + off;
                __builtin_nontemporal_store(o, (f32x4*)(out + (size_t)t * D + 256 * c + 4 * lane));
                en0 = ef0; en1 = ef1;
            }
        }
    }
}
#define CE(a, b) do { const float _h = __builtin_fmaxf(a, b), _l = __builtin_fminf(a, b); a = _h; b = _l; } while (0)
#define SORT16(K, B) do { \
    CE(K[(B)+0], K[(B)+1]); CE(K[(B)+2], K[(B)+3]); CE(K[(B)+0], K[(B)+2]); CE(K[(B)+1], K[(B)+3]); \
    CE(K[(B)+1], K[(B)+2]); CE(K[(B)+4], K[(B)+5]); CE(K[(B)+6], K[(B)+7]); CE(K[(B)+4], K[(B)+6]); \
    CE(K[(B)+5], K[(B)+7]); CE(K[(B)+5], K[(B)+6]); CE(K[(B)+0], K[(B)+4]); CE(K[(B)+2], K[(B)+6]); \
    CE(K[(B)+2], K[(B)+4]); CE(K[(B)+1], K[(B)+5]); CE(K[(B)+3], K[(B)+7]); CE(K[(B)+3], K[(B)+5]); \
    CE(K[(B)+1], K[(B)+2]); CE(K[(B)+3], K[(B)+4]); CE(K[(B)+5], K[(B)+6]); CE(K[(B)+8], K[(B)+9]); \
    CE(K[(B)+10], K[(B)+11]); CE(K[(B)+8], K[(B)+10]); CE(K[(B)+9], K[(B)+11]); CE(K[(B)+9], K[(B)+10]); \
    CE(K[(B)+12], K[(B)+13]); CE(K[(B)+14], K[(B)+15]); CE(K[(B)+12], K[(B)+14]); CE(K[(B)+13], K[(B)+15]); \
    CE(K[(B)+13], K[(B)+14]); CE(K[(B)+8], K[(B)+12]); CE(K[(B)+10], K[(B)+14]); CE(K[(B)+10], K[(B)+12]); \
    CE(K[(B)+9], K[(B)+13]); CE(K[(B)+11], K[(B)+15]); CE(K[(B)+11], K[(B)+13]); CE(K[(B)+9], K[(B)+10]); \
    CE(K[(B)+11], K[(B)+12]); CE(K[(B)+13], K[(B)+14]); CE(K[(B)+0], K[(B)+8]); CE(K[(B)+4], K[(B)+12]); \
    CE(K[(B)+4], K[(B)+8]); CE(K[(B)+2], K[(B)+10]); CE(K[(B)+6], K[(B)+14]); CE(K[(B)+6], K[(B)+10]); \
    CE(K[(B)+2], K[(B)+4]); CE(K[(B)+6], K[(B)+8]); CE(K[(B)+10], K[(B)+12]); CE(K[(B)+1], K[(B)+9]); \
    CE(K[(B)+5], K[(B)+13]); CE(K[(B)+5], K[(B)+9]); CE(K[(B)+3], K[(B)+11]); CE(K[(B)+7], K[(B)+15]); \
    CE(K[(B)+7], K[(B)+11]); CE(K[(B)+3], K[(B)+5]); CE(K[(B)+7], K[(B)+9]); CE(K[(B)+11], K[(B)+13]); \
    CE(K[(B)+1], K[(B)+2]); CE(K[(B)+3], K[(B)+4]); CE(K[(B)+5], K[(B)+6]); CE(K[(B)+7], K[(B)+8]); \
    CE(K[(B)+9], K[(B)+10]); CE(K[(B)+11], K[(B)+12]); CE(K[(B)+13], K[(B)+14]); \
} while (0)
#define BMERGE16(K, B) do { \
    CE(K[(B)+0], K[(B)+8]); CE(K[(B)+1], K[(B)+9]); CE(K[(B)+2], K[(B)+10]); CE(K[(B)+3], K[(B)+11]); \
    CE(K[(B)+4], K[(B)+12]); CE(K[(B)+5], K[(B)+13]); CE(K[(B)+6], K[(B)+14]); CE(K[(B)+7], K[(B)+15]); \
    CE(K[(B)+0], K[(B)+4]); CE(K[(B)+1], K[(B)+5]); CE(K[(B)+2], K[(B)+6]); CE(K[(B)+3], K[(B)+7]); \
    CE(K[(B)+8], K[(B)+12]); CE(K[(B)+9], K[(B)+13]); CE(K[(B)+10], K[(B)+14]); CE(K[(B)+11], K[(B)+15]); \
    CE(K[(B)+0], K[(B)+2]); CE(K[(B)+1], K[(B)+3]); CE(K[(B)+4], K[(B)+6]); CE(K[(B)+5], K[(B)+7]); \
    CE(K[(B)+8], K[(B)+10]); CE(K[(B)+9], K[(B)+11]); CE(K[(B)+12], K[(B)+14]); CE(K[(B)+13], K[(B)+15]); \
    CE(K[(B)+0], K[(B)+1]); CE(K[(B)+2], K[(B)+3]); CE(K[(B)+4], K[(B)+5]); CE(K[(B)+6], K[(B)+7]); \
    CE(K[(B)+8], K[(B)+9]); CE(K[(B)+10], K[(B)+11]); CE(K[(B)+12], K[(B)+13]); CE(K[(B)+14], K[(B)+15]); \
} while (0)
typedef short bf16x8s __attribute__((ext_vector_type(8)));
typedef float f32x16 __attribute__((ext_vector_type(16)));
constexpr int TK_LUT_OFF = 0, TK_LDS_END = TK_LUT_OFF + 8 * 8192;
__device__ __forceinline__ void top16_of_64(float (&k)[64]) {
    SORT16(k, 0); SORT16(k, 16); SORT16(k, 32); SORT16(k, 48);
#pragma unroll
    for (int i = 0; i < 16; ++i) { k[i] = __builtin_fmaxf(k[i], k[31 - i]); k[32 + i] = __builtin_fmaxf(k[32 + i], k[63 - i]); }
    BMERGE16(k, 0); BMERGE16(k, 32);
#pragma unroll
    for (int i = 0; i < 16; ++i) k[i] = __builtin_fmaxf(k[i], k[47 - i]);
    BMERGE16(k, 0);
}
__device__ __forceinline__ void top16_of_64_s0(float (&k)[64]) {
    SORT16(k, 16); SORT16(k, 32);
#pragma unroll
    for (int i = 0; i < 16; ++i) k[i] = __builtin_fmaxf(k[i], k[31 - i]);
    k[46] = __builtin_fmaxf(k[46], k[49]); k[47] = __builtin_fmaxf(k[47], k[48]);
    BMERGE16(k, 0); BMERGE16(k, 32);
#pragma unroll
    for (int i = 0; i < 16; ++i) k[i] = __builtin_fmaxf(k[i], k[47 - i]);
}
__device__ __forceinline__ float ctag(float s, unsigned code) { return __uint_as_float((__float_as_uint(s) & 0xffffff00u) | code); }
__device__ __forceinline__ void topk_load(u32x4 (&w)[8], const bf16_t* __restrict__ srow  ) {
#pragma unroll
    for (int i = 0; i < 8; ++i) w[i] = ((const u32x4*)srow)[i];
}
__device__ __forceinline__ void topk_half(float (&v)[16], u32x4 (&w)[8], const bf16_t* __restrict__ nxt, unsigned hx  ) {
    float k[64];
#pragma unroll
    for (int i = 0; i < 8; ++i)
#pragma unroll
        for (int q = 0; q < 4; ++q) { const unsigned x = w[i][q]; k[8 * i + 2 * q] = __uint_as_float((x << 16) | (unsigned)(8 * i + 2 * q)); k[8 * i + 2 * q + 1] = __uint_as_float((x & 0xffff0000u) | (unsigned)(8 * i + 2 * q + 1)); }
    if (nxt) topk_load(w, nxt);
    top16_of_64(k);
    float r0[16], r1[16];
#pragma unroll
    for (int i = 0; i < 16; ++i) { const unsigned ki = __float_as_uint(k[i]) | hx; const auto rr = __builtin_amdgcn_permlane32_swap(ki, ki, false, false); r0[i] = __uint_as_float(rr[0]); r1[i] = __uint_as_float(rr[1]); }
#pragma unroll
    for (int i = 0; i < 16; ++i) v[i] = __builtin_fmaxf(r0[i], r1[15 - i]);
    BMERGE16(v, 0);
}
__device__ __forceinline__ void topk_task(int tg, int hp, const bf16_t* __restrict__ qv  , LAS unsigned* lut, int* __restrict__ eidx, float* __restrict__ gate, int lane) {
    const int tl = lane & 31, hh = lane >> 5, t = tg * 32 + tl;
    const unsigned hx = (unsigned)hh << 6;
    float v1[16], v2[16];
    {
        const bf16_t* qrow = qv + (size_t)t * NQ + (2 * hp) * 256 + 64 * hh;
        float a[16], b_[16];
        u32x4 wa[8], wb[8];
        topk_load(wa, qrow); topk_load(wb, qrow + 256);
        topk_half(a, wa, qrow + 128, hx);
        __builtin_amdgcn_sched_barrier(0);
        topk_half(b_, wb, qrow + 384, hx);
#pragma unroll
        for (int i = 0; i < 16; ++i) v1[i] = hh ? b_[i] : a[i];
        __builtin_amdgcn_sched_barrier(0);
        topk_half(a, wa, nullptr, hx);
        __builtin_amdgcn_sched_barrier(0);
        topk_half(b_, wb, nullptr, hx);
#pragma unroll
        for (int i = 0; i < 16; ++i) v2[i] = hh ? b_[i] : a[i];
        __builtin_amdgcn_sched_barrier(0);
    }
    const int h = 2 * hp + hh;
    float f1[16], f2[16];
#pragma unroll
    for (int i = 0; i < 16; ++i) {
        const unsigned b1 = __float_as_uint(v1[i]), b2 = __float_as_uint(v2[i]);
        f1[i] = __uint_as_float(b1 & 0xffffff80u); f2[i] = __uint_as_float(b2 & 0xffffff80u);
        lut[i * 64 + lane] = (b1 & 127u) << 7; lut[(16 + i) * 64 + lane] = b2 & 127u;
    }
    float cand[64];
    cand[0] = ctag(f1[0] + f2[0], 255u);
    cand[1] = ctag(f1[0] + f2[1], 254u);
    cand[2] = ctag(f1[0] + f2[2], 253u);
    cand[3] = ctag(f1[0] + f2[3], 252u);
    cand[4] = ctag(f1[0] + f2[4], 251u);
    cand[5] = ctag(f1[0] + f2[5], 250u);
    cand[6] = ctag(f1[0] + f2[6], 249u);
    cand[7] = ctag(f1[0] + f2[7], 248u);
    cand[8] = ctag(f1[0] + f2[8], 247u);
    cand[9] = ctag(f1[0] + f2[9], 246u);
    cand[10] = ctag(f1[0] + f2[10], 245u);
    cand[11] = ctag(f1[0] + f2[11], 244u);
    cand[12] = ctag(f1[0] + f2[12], 243u);
    cand[13] = ctag(f1[0] + f2[13], 242u);
    cand[14] = ctag(f1[0] + f2[14], 241u);
    cand[15] = ctag(f1[0] + f2[15], 240u);
    cand[16] = ctag(f1[1] + f2[0], 239u);
    cand[17] = ctag(f1[1] + f2[1], 238u);
    cand[18] = ctag(f1[1] + f2[2], 237u);
    cand[19] = ctag(f1[1] + f2[3], 236u);
    cand[20] = ctag(f1[1] + f2[4], 235u);
    cand[21] = ctag(f1[1] + f2[5], 234u);
    cand[22] = ctag(f1[1] + f2[6], 233u);
    cand[23] = ctag(f1[1] + f2[7], 232u);
    cand[24] = ctag(f1[2] + f2[0], 223u);
    cand[25] = ctag(f1[2] + f2[1], 222u);
    cand[26] = ctag(f1[2] + f2[2], 221u);
    cand[27] = ctag(f1[2] + f2[3], 220u);
    cand[28] = ctag(f1[2] + f2[4], 219u);
    cand[29] = ctag(f1[3] + f2[0], 207u);
    cand[30] = ctag(f1[3] + f2[1], 206u);
    cand[31] = ctag(f1[3] + f2[2], 205u);
    cand[32] = ctag(f1[3] + f2[3], 204u);
    cand[33] = ctag(f1[4] + f2[0], 191u);
    cand[34] = ctag(f1[4] + f2[1], 190u);
    cand[35] = ctag(f1[4] + f2[2], 189u);
    cand[36] = ctag(f1[5] + f2[0], 175u);
    cand[37] = ctag(f1[5] + f2[1], 174u);
    cand[38] = ctag(f1[6] + f2[0], 159u);
    cand[39] = ctag(f1[6] + f2[1], 158u);
    cand[40] = ctag(f1[7] + f2[0], 143u);
    cand[41] = ctag(f1[7] + f2[1], 142u);
    cand[42] = ctag(f1[8] + f2[0], 127u);
    cand[43] = ctag(f1[9] + f2[0], 111u);
    cand[44] = ctag(f1[10] + f2[0], 95u);
    cand[45] = ctag(f1[11] + f2[0], 79u);
    cand[46] = ctag(f1[12] + f2[0], 63u);
    cand[47] = ctag(f1[13] + f2[0], 47u);
    cand[48] = ctag(f1[14] + f2[0], 31u);
    cand[49] = ctag(f1[15] + f2[0], 15u);
    top16_of_64_s0(cand);
    float sc[16]; unsigned ex[16];
#pragma unroll
    for (int w = 0; w < 16; ++w) {
        const unsigned b = __float_as_uint(cand[w]), code = 255u - (b & 255u);
        sc[w] = __uint_as_float(b & 0xffffff00u);
        ex[w] = lut[(code >> 4) * 64 + lane] + lut[(16 + (code & 15u)) * 64 + lane];
    }
    float mx = sc[0];
#pragma unroll
    for (int w = 1; w < 16; ++w) mx = __builtin_fmaxf(mx, sc[w]);
    float sum = 0.f;
#pragma unroll
    for (int w = 0; w < 16; ++w) { sc[w] = __expf(sc[w] - mx); sum += sc[w]; }
    const size_t o = ((size_t)t * 8 + h) * 16;
    const float inv = 1.f / sum;
#pragma unroll
    for (int i = 0; i < 4; ++i) { u32x4 w4 = {ex[4 * i], ex[4 * i + 1], ex[4 * i + 2], ex[4 * i + 3]}; *(u32x4*)(eidx + o + 4 * i) = w4; }
#pragma unroll
    for (int i = 0; i < 4; ++i) { f32x4 g4 = {sc[4 * i] * inv, sc[4 * i + 1] * inv, sc[4 * i + 2] * inv, sc[4 * i + 3] * inv}; *(f32x4*)(gate + o + 4 * i) = g4; }
}

typedef short v4i16_t __attribute__((ext_vector_type(4)));
constexpr int AT_K = 0, AT_V = 16384, AT_FK = 32768, AT_BIAS = AT_FK + 2 * 2048, AT_END = AT_BIAS + 4096,
              AT_FL = 73728, AT_DONE = AT_FL + 16, AT_QW = AT_FL + 48;
constexpr float AT_SKIP = 24.f;
__device__ __forceinline__ int crow(int r, int hh) { return (r & 3) + 8 * (r >> 2) + 4 * hh; }

__device__ __forceinline__ float at_max3(float a, float b, float c) { float r; asm("v_max3_f32 %0, %1, %2, %3" : "=v"(r) : "v"(a), "v"(b), "v"(c)); return r; }
__device__ __forceinline__ unsigned at_bf16(float x) { return cvt_pk_bf16(x, 0.f) & 0xffffu; }
__device__ __forceinline__ unsigned at_split3(float x, unsigned& d0) { const unsigned t1 = at_bf16(x); const float r1 = x - __uint_as_float(t1 << 16); const unsigned t2 = at_bf16(r1); const float r2 = r1 - __uint_as_float(t2 << 16); d0 = t1 | (t2 << 16); return at_bf16(r2); }
__device__ __forceinline__ bf16x8s at_mfrag(float m, int hh) { unsigned d0; const unsigned t3 = at_split3(-m, d0); u32x4 w = {0x3f803f80u, 0x3f80u | (d0 << 16), (d0 >> 16) | (t3 << 16), 0u}; if (hh) w = (u32x4){0u, 0u, 0u, 0u}; return __builtin_bit_cast(bf16x8s, w); }
constexpr float AT_THR = 6.f;
template <int MODE  >
__device__ __forceinline__ void attn_step(f32x16 (&o)[2], float& mhat, float& l, const bf16x8s (&qf)[4], const LAS unsigned char* Kt, const LAS unsigned char* Vt, const LAS unsigned char* AKt, bf16x8s& mfr,
                                          const LAS float* biasrow, int qg, int kv0, int lane, bool diag = false  ) {
    const int tl = lane & 31, hh = lane >> 5;
    const LAS unsigned char* kb = Kt + tl * 128; const int ksw = (tl >> 1) & 7;
    bf16x8s kf[2][4];
#pragma unroll
    for (int kvt = 0; kvt < 2; ++kvt)
#pragma unroll
        for (int ks = 0; ks < 4; ++ks) kf[kvt][ks] = *(const LAS bf16x8s*)(kb + kvt * 4096 + (((2 * ks + hh) ^ ksw) * 16));
    bf16x8s af[2];
    if (MODE < 2) {
#pragma unroll
        for (int kvt = 0; kvt < 2; ++kvt) af[kvt] = *(const LAS bf16x8s*)(AKt + (32 * kvt + tl) * 32 + hh * 16);
    } else {
        u32x4 w = {0u, 0x3f800000u, 0x3f803f80u, 0u}; if (hh) w = (u32x4){0u, 0u, 0u, 0u};
        af[0] = __builtin_bit_cast(bf16x8s, w); af[1] = af[0];
    }
    f32x16 p[2];
    const LAS unsigned char* vb = Vt + (4 * hh + ((lane & 15) >> 2)) * 64 + ((lane >> 4) & 1) * 32 + (lane & 3) * 8;
    bf16x8s vf[2][2][2];
#pragma unroll
    for (int kvt = 0; kvt < 2; ++kvt)
#pragma unroll
        for (int s = 0; s < 2; ++s)
#pragma unroll
            for (int d0 = 0; d0 < 2; ++d0) {
                const v4i16_t lo = __builtin_amdgcn_ds_read_tr16_b64_v4i16((LAS v4i16_t*)(vb + d0 * 4096 + kvt * 2048 + s * 1024));
                const v4i16_t hi = __builtin_amdgcn_ds_read_tr16_b64_v4i16((LAS v4i16_t*)(vb + d0 * 4096 + kvt * 2048 + s * 1024 + 512));
                vf[kvt][s][d0] = (bf16x8s){lo[0], lo[1], lo[2], lo[3], hi[0], hi[1], hi[2], hi[3]};
            }
    __builtin_amdgcn_sched_barrier(0);
    {
        const f32x16 z = {0.f, 0.f, 0.f, 0.f, 0.f, 0.f, 0.f, 0.f, 0.f, 0.f, 0.f, 0.f, 0.f, 0.f, 0.f, 0.f};
        p[0] = __builtin_amdgcn_mfma_f32_32x32x16_bf16(af[0], mfr, z, 0, 0, 0);
        p[1] = __builtin_amdgcn_mfma_f32_32x32x16_bf16(af[1], mfr, z, 0, 0, 0);
#pragma unroll
        for (int ks = 0; ks < 4; ++ks) {
            p[0] = __builtin_amdgcn_mfma_f32_32x32x16_bf16(kf[0][ks], qf[ks], p[0], 0, 0, 0);
            p[1] = __builtin_amdgcn_mfma_f32_32x32x16_bf16(kf[1][ks], qf[ks], p[1], 0, 0, 0);
        }
    }
    if (MODE == 1 || (MODE == 0 && diag)) {
#pragma unroll
        for (int kvt = 0; kvt < 2; ++kvt)
#pragma unroll
            for (int r = 0; r < 16; ++r) { const int kv = kv0 + 32 * kvt + crow(r, hh); p[kvt][r] = (kv > qg) ? -INFINITY : p[kvt][r]; }
    }
    if (MODE == 2) {
        const LAS float* bp = biasrow + (191 - qg + kv0 + 4 * hh);
#pragma unroll
        for (int kvt = 0; kvt < 2; ++kvt)
#pragma unroll
            for (int r = 0; r < 16; ++r) {
                p[kvt][r] += bp[32 * kvt + crow(r, 0)];
            }
    }
    float mx = at_max3(p[0][0], p[1][0], p[0][1]), mx2 = at_max3(p[1][1], p[0][2], p[1][2]);
#pragma unroll
    for (int r = 3; r < 15; r += 2) { mx = at_max3(mx, p[0][r], p[1][r]); mx2 = at_max3(mx2, p[0][r + 1], p[1][r + 1]); }
    mx = at_max3(mx, p[0][15], p[1][15]); mx = __builtin_fmaxf(mx, mx2);
    { const auto rr = __builtin_amdgcn_permlane32_swap(__float_as_uint(mx), __float_as_uint(mx), false, false); mx = __builtin_fmaxf(__uint_as_float(rr[0]), __uint_as_float(rr[1])); }
    if (MODE == 0 && __all(mx < -AT_SKIP)) return;
    if (__any(mx > AT_THR)) {
        const float dl = __builtin_fmaxf(mx, 0.f), f = __builtin_amdgcn_exp2f(-dl);
        mhat += dl; l *= f; mfr = at_mfrag(mhat, hh);
#pragma unroll
        for (int kvt = 0; kvt < 2; ++kvt)
#pragma unroll
            for (int r = 0; r < 16; ++r) p[kvt][r] -= dl;
#pragma unroll
        for (int d0 = 0; d0 < 2; ++d0)
#pragma unroll
            for (int r = 0; r < 16; ++r) o[d0][r] *= f;
    }
    float sum = 0.f;
#pragma unroll
    for (int kvt = 0; kvt < 2; ++kvt)
#pragma unroll
        for (int r = 0; r < 16; ++r) { const float e = __builtin_amdgcn_exp2f(p[kvt][r]); p[kvt][r] = e; sum += e; }
    l += sum;
#pragma unroll
    for (int kvt = 0; kvt < 2; ++kvt)
#pragma unroll
        for (int s = 0; s < 2; ++s) {
            u32x4 pw;
#pragma unroll
            for (int i = 0; i < 4; ++i) pw[i] = cvt_pk_bf16(p[kvt][8 * s + 2 * i], p[kvt][8 * s + 2 * i + 1]);
            const bf16x8s pf = __builtin_bit_cast(bf16x8s, pw);
#pragma unroll
            for (int d0 = 0; d0 < 2; ++d0) o[d0] = __builtin_amdgcn_mfma_f32_32x32x16_bf16(vf[kvt][s][d0], pf, o[d0], 0, 0, 0);
        }
}

__device__ __forceinline__ void at_store_out(const f32x16 (&o)[2], float inv, bf16_t* op) {
#pragma unroll
    for (int d0 = 0; d0 < 2; ++d0)
#pragma unroll
        for (int i = 0; i < 2; ++i) {
            const int ja = 8 * i, jb = 8 * i + 4;
            const unsigned ax = cvt_pk_bf16(o[d0][ja] * inv, o[d0][ja + 1] * inv), ay = cvt_pk_bf16(o[d0][ja + 2] * inv, o[d0][ja + 3] * inv);
            const unsigned bx = cvt_pk_bf16(o[d0][jb] * inv, o[d0][jb + 1] * inv), by = cvt_pk_bf16(o[d0][jb + 2] * inv, o[d0][jb + 3] * inv);
            const auto rx = __builtin_amdgcn_permlane32_swap(ax, bx, false, false); const auto ry = __builtin_amdgcn_permlane32_swap(ay, by, false, false);
            u32x4 w; w.x = rx[0]; w.y = ry[0]; w.z = rx[1]; w.w = ry[1];
            *(u32x4*)(op + 32 * d0 + 16 * i) = w;
        }
}
template <bool FOX>
__device__ __forceinline__ void attn_unit(LAS unsigned char* ldsl, int b, int hk, int qblk, const bf16_t* __restrict__ Q, const bf16_t* __restrict__ K, const bf16_t* __restrict__ V, int kvpitch,
                                          const float* __restrict__ F2, const float* __restrict__ sinks, bf16_t* __restrict__ MIX, int wave, int lane, unsigned serial, float sbound) {
    const int tid = threadIdx.x, tl = lane & 31, hh = lane >> 5;
    const size_t rowbase = (size_t)b * SEQ;
    int head, qw0, t_begin, t_end, wl;
    if (FOX) { head = hk; qw0 = qblk * 256 + 32 * wave; t_begin = 0; t_end = 4 * qblk + 4; wl = 4 * qblk + (wave >> 1); }
    else { head = hk * 4 + (wave >> 1); qw0 = qblk * 64 + 32 * (wave & 1); t_begin = qblk >= 2 ? qblk - 2 : 0; t_end = qblk + 1; wl = t_end; }
    const int qg = qw0 + tl;
    bf16x8s qf[4];
    { const bf16_t* qp = Q + (rowbase + qg) * 512 + head * 64 + 8 * hh;
#pragma unroll
      for (int ks = 0; ks < 4; ++ks) qf[ks] = *(const bf16x8s*)(qp + 16 * ks); }
    const float* Fr = F2 + ((size_t)b * 8 + head) * SEQ;
    float m, l;
    if (FOX) { m = 0.f; l = 0.f; } else { m = sinks[head] * LOG2E; l = hh == 0 ? 1.f : 0.f; }
    bf16x8s mfr = at_mfrag(m, hh);
    f32x16 o[2];
#pragma unroll
    for (int d0 = 0; d0 < 2; ++d0)
#pragma unroll
        for (int r = 0; r < 16; ++r) o[d0][r] = 0.f;
    const int skv = tid >> 3, sc = tid & 7;
    const bf16_t* kg = K + (rowbase + skv) * kvpitch + hk * 64 + sc * 8;
    const bf16_t* vg = V + (rowbase + skv) * kvpitch + hk * 64 + sc * 8;
    const int kwoff = skv * 128 + ((sc ^ ((skv >> 1) & 7)) * 16), vwoff = (sc >> 2) * 4096 + skv * 64 + (sc & 3) * 16;
    u32x4 kA, vA, kB, vB; float fA = 0.f, fB = 0.f;
#define AT_LOAD(t, KR, VR, FR) do { const int tt_ = (t) > t_begin ? (t) : t_begin; KR = *(const u32x4*)(kg + (size_t)tt_ * 64 * kvpitch); VR = *(const u32x4*)(vg + (size_t)tt_ * 64 * kvpitch); if (FOX) FR = Fr[tt_ * 64 + lane]; } while (0)
#define AT_WRITE(buf, KR, VR, FR) do { *(LAS u32x4*)(ldsl + AT_K + (buf) * 8192 + kwoff) = KR; *(LAS u32x4*)(ldsl + AT_V + (buf) * 8192 + vwoff) = VR; if (FOX && tid < 64) { unsigned d0_; const unsigned t3_ = at_split3(-FR, d0_); LAS u32x4* ak_ = (LAS u32x4*)(ldsl + AT_FK + (buf) * 2048 + tid * 32); ak_[0] = (u32x4){d0_, t3_ | 0x3f800000u, 0x3f803f80u, 0u}; ak_[1] = (u32x4){0u, 0u, 0u, 0u}; if (tid == 63) *(LAS float*)(ldsl + AT_FL + (buf) * 4) = -FR; } } while (0)
    AT_LOAD(t_end - 1, kA, vA, fA); AT_LOAD(t_end - 2, kB, vB, fB);
    AT_WRITE(0, kA, vA, fA);
    __syncthreads();
    const LAS float* biasrow = (const LAS float*)(ldsl + AT_BIAS) + head * 128;
#define AT_STEP(KL, VL, FL, KW, VW, FW) do { \
        const int cur = (t_end - 1 - t) & 1; \
        AT_LOAD(t - 2, KL, VL, FL); \
        const LAS unsigned char* Kt = ldsl + AT_K + cur * 8192; const LAS unsigned char* Vt = ldsl + AT_V + cur * 8192; const LAS unsigned char* Fk = ldsl + AT_FK + cur * 2048; \
        if (FOX) { \
            if (!wdone && t < wl) {     \
                const float fl_ = *(const LAS float*)(ldsl + AT_FL + cur * 4); \
                if (__any(m != mseen)) { mseen = m; mneg = wave_max_u(-m); }     \
                if (sbound + fl_ + mneg < -AT_SKIP) { wdone = true; if (lane == 0) *(LAS unsigned*)(ldsl + AT_DONE + wave * 4) = (serial << 8) | (unsigned)t; } \
            } \
            if (!wdone) { \
                if (t <= wl) attn_step<0>(o, m, l, qf, Kt, Vt, Fk, mfr, biasrow, qg, t * 64, lane, t == wl);     \
            } \
        } else attn_step<2>(o, m, l, qf, Kt, Vt, Fk, mfr, biasrow, qg, t * 64, lane); \
        if (t > t_begin) AT_WRITE(cur ^ 1, KW, VW, FW); \
        __syncthreads(); \
        if (FOX) { const unsigned mk_ = lane < 8 ? *(const LAS unsigned*)(ldsl + AT_DONE + lane * 4) : ((serial << 8) | 255u); bdone = __all((mk_ >> 8) == serial && (mk_ & 255u) >= (unsigned)t); }     \
    } while (0)
    bool wdone = false, bdone = false; float mseen = m, mneg = wave_max_u(-m);
    for (int t = t_end - 1;;) {
        AT_STEP(kA, vA, fA, kB, vB, fB); if (bdone || --t < t_begin) break;
        AT_STEP(kB, vB, fB, kA, vA, fA); if (bdone || --t < t_begin) break;
    }
#undef AT_STEP
#undef AT_LOAD
#undef AT_WRITE
    { const auto rr = __builtin_amdgcn_permlane32_swap(__float_as_uint(l), __float_as_uint(l), false, false); l = __uint_as_float(rr[0]) + __uint_as_float(rr[1]); }
    const float inv = 1.f / l;
    at_store_out(o, inv, MIX + (rowbase + qg) * D + (FOX ? 512 : 0) + head * 64 + 8 * hh);
}

constexpr int AT_SWA_V = 0, AT_SWA_K = 32768, AT_SWA_BIAS = 65536;
__device__ __forceinline__ void attn_swa_unit(LAS unsigned char* ldsl, int b, int kvh, int qb, const bf16_t* __restrict__ Q, const bf16_t* __restrict__ K, const bf16_t* __restrict__ V,
                                              const float* __restrict__ sinks, bf16_t* __restrict__ MIX, int wave, int lane) {
    const int tid = threadIdx.x, tl = lane & 31, hh = lane >> 5;
    const size_t rowbase = (size_t)b * SEQ;
    const int q0 = qb * 128, tbase = 2 * qb - 2;
    const int head = kvh * 4 + (wave >> 1);
    const int skv = tid >> 3, sc = tid & 7;
    const int kwoff = skv * 128 + ((sc ^ ((skv >> 1) & 7)) * 16), vwoff = (sc >> 2) * 4096 + skv * 64 + (sc & 3) * 16;
    u32x4 kr[4], vr[4];
#pragma unroll
    for (int sl = 0; sl < 4; ++sl) { const int tt = tbase + sl < 0 ? 0 : tbase + sl; const size_t off = (rowbase + (size_t)tt * 64 + skv) * 128 + kvh * 64 + sc * 8; kr[sl] = *(const u32x4*)(K + off); vr[sl] = *(const u32x4*)(V + off); }
#pragma unroll
    for (int sl = 0; sl < 4; ++sl) { *(LAS u32x4*)(ldsl + AT_SWA_K + sl * 8192 + kwoff) = kr[sl]; *(LAS u32x4*)(ldsl + AT_SWA_V + sl * 8192 + vwoff) = vr[sl]; }
    __syncthreads();
    const LAS float* biasrow = (const LAS float*)(ldsl + AT_SWA_BIAS) + head * 256;
    const float sink2 = sinks[head] * LOG2E;
#pragma unroll 1
    for (int ps = 0; ps < 2; ++ps) {
        const int qg = q0 + 64 * ps + 32 * (wave & 1) + tl;
        bf16x8s qf[4];
        { const bf16_t* qp = Q + (rowbase + qg) * 512 + head * 64 + 8 * hh;
#pragma unroll
          for (int ks = 0; ks < 4; ++ks) qf[ks] = *(const bf16x8s*)(qp + 16 * ks); }
        float m = sink2, l = hh == 0 ? 1.f : 0.f;
        bf16x8s mfr = at_mfrag(m, hh);
        f32x16 o[2];
#pragma unroll
        for (int d0 = 0; d0 < 2; ++d0)
#pragma unroll
            for (int r = 0; r < 16; ++r) o[d0][r] = 0.f;
#pragma unroll 1
        for (int j = 2; j >= 0; --j) {
            const int sl = ps + j, t = tbase + sl;
            if (t >= 0) attn_step<2>(o, m, l, qf, ldsl + AT_SWA_K + sl * 8192, ldsl + AT_SWA_V + sl * 8192, ldsl, mfr, biasrow, qg, t * 64, lane);
        }
        { const auto rr = __builtin_amdgcn_permlane32_swap(__float_as_uint(l), __float_as_uint(l), false, false); l = __uint_as_float(rr[0]) + __uint_as_float(rr[1]); }
        const float inv = 1.f / l;
        at_store_out(o, inv, MIX + (rowbase + qg) * D + head * 64 + 8 * hh);
    }
    __syncthreads();
}

__device__ __forceinline__ void attn_phase(LAS unsigned char* ldsl, const bf16_t* QA, const bf16_t* KA, const bf16_t* VA, const bf16_t* QB, const bf16_t* KB, const bf16_t* VB,
                                           const float* __restrict__ F2, const float* __restrict__ sinks, const float* __restrict__ relb, const float* __restrict__ gqb, const float* __restrict__ gkb,
                                           bf16_t* MIX, unsigned* qctr  , int G, int wave, int lane) {
    for (int i = threadIdx.x; i < 8 * 256; i += 512) { const int h = i >> 8, dist = 191 - (i & 255); ((LAS float*)(ldsl + AT_SWA_BIAS))[i] = (unsigned)dist < 128u ? relb[(int)T5B[dist & 127] * 8 + h] * LOG2E : -INFINITY; }
    if (threadIdx.x < 8) *(LAS unsigned*)(ldsl + AT_DONE + threadIdx.x * 4) = 0u;
    const float sbound = 64.f * C2 * 1.02f * wave_max_u(fabsf(gqb[lane])) * wave_max_u(fabsf(gkb[lane]));
    __syncthreads();
    unsigned serial = 0;
    for (;;) {
        if (threadIdx.x == 0) *(LAS unsigned*)(ldsl + AT_QW) = __hip_atomic_fetch_add(qctr, 1u, __ATOMIC_RELAXED, __HIP_MEMORY_SCOPE_AGENT);
        __syncthreads();
        const unsigned u = *(const LAS unsigned*)(ldsl + AT_QW);
        __syncthreads();
        if (u >= 768u) break;
        if (u < 512u) { const int bh = (int)(u & 31u), qb = 15 - (int)(u >> 5); ++serial;
            attn_unit<true>(ldsl, bh >> 3, bh & 7, qb, QB, KB, VB, 512, F2, sinks, MIX, wave, lane, serial, sbound); }
        else { const int us = (int)u - 512; attn_swa_unit(ldsl, us >> 6, (us >> 5) & 1, us & 31, QA, KA, VA, sinks, MIX, wave, lane); }
    }
}
#define RLX_AGENT __ATOMIC_RELAXED, __HIP_MEMORY_SCOPE_AGENT
#define XB_TMO      128
#define XB_XCNT(j)  (256  + 64 * (j))
#define XB_XSUB(j)  (1280 + 64 * (j))
#define XB_XGEN(j)  (2304 + 64 * (j))
#define XB_TOP      3328
#define XB_TOPGEN   3392
#define XCD_BAR_WORDS 3456
#define XB_SPIN_CAP (1u << 22)

__device__ __forceinline__ unsigned xb_ld(unsigned* p)              { return __hip_atomic_load(p, __ATOMIC_RELAXED, __HIP_MEMORY_SCOPE_AGENT); }
__device__ __forceinline__ unsigned xb_add(unsigned* p, unsigned v) { return __hip_atomic_fetch_add(p, v, __ATOMIC_RELAXED, __HIP_MEMORY_SCOPE_AGENT); }
__device__ __forceinline__ unsigned xb_xcc_id() { return (unsigned)__builtin_amdgcn_s_getreg((3 << 11) | 20) & 0xFu; }
#define XB_SPIN(cond, bar) do { unsigned _sp = 0; while (cond) { __builtin_amdgcn_s_sleep(1); \
    if ((++_sp & 255u) == 0u) { if (xb_ld(&(bar)[XB_TMO])) break; if (_sp > XB_SPIN_CAP) { atomicAdd(&(bar)[XB_TMO], 1u); break; } } } } while (0)

struct XcdBarrier {
    unsigned* bar; unsigned x;
    volatile LAS unsigned* st;
};

__device__ __forceinline__ XcdBarrier xcd_barrier_post(unsigned* bar, volatile LAS unsigned* st) {
    XcdBarrier b; b.bar = bar; b.x = xb_xcc_id(); b.st = st;
    if (threadIdx.x == 0) (void)xb_add(&bar[XB_XCNT(b.x)], 1u);
    return b;
}
__device__ __forceinline__ void xcd_barrier_complete(unsigned* bar, unsigned x, unsigned& nloc, unsigned& nx) {
    const unsigned G = gridDim.x * gridDim.y * gridDim.z;
    unsigned sum, cnt, mine, sp = 0u;
    for (;;) {
        sum = 0u; cnt = 0u; mine = 0u;
#pragma unroll
        for (unsigned j = 0; j < 16; ++j) { const unsigned c = xb_ld(&bar[XB_XCNT(j)]); sum += c; cnt += (c > 0u) ? 1u : 0u; mine = (j == x) ? c : mine; }
        if (sum == G) break;
        __builtin_amdgcn_s_sleep(1);
        if ((++sp & 255u) == 0u) { if (xb_ld(&bar[XB_TMO])) break; if (sp > XB_SPIN_CAP) { atomicAdd(&bar[XB_TMO], 1u); break; } }
    }
    nloc = mine > 0u ? mine : 1u; nx = cnt > 0u ? cnt : 1u;
}

__device__ __forceinline__ void xcd_barrier(const XcdBarrier& b) {
    asm volatile("s_waitcnt vmcnt(0)" ::: "memory");
    __syncthreads();
    if (threadIdx.x == 0) {
        unsigned* bar = b.bar;
        __builtin_amdgcn_s_waitcnt(0);
        unsigned nloc = b.st[0], nx = b.st[1];
        if (nloc == 0u) { xcd_barrier_complete(bar, b.x, nloc, nx); b.st[0] = nloc; b.st[1] = nx; }
        const unsigned old = xb_add(&bar[XB_XSUB(b.x)], 1u);
        const unsigned gen = old / nloc;
        if (old + 1u == (gen + 1u) * nloc) {
            __builtin_amdgcn_fence(__ATOMIC_RELEASE, "agent");
            asm volatile("s_waitcnt vmcnt(0)" ::: "memory");
            const unsigned og = xb_add(&bar[XB_TOP], 1u);
            const unsigned tg = og / nx;
            if (og + 1u == (tg + 1u) * nx) xb_add(&bar[XB_TOPGEN], 1u);
            else XB_SPIN(xb_ld(&bar[XB_TOPGEN]) == tg, bar);
            __builtin_amdgcn_fence(__ATOMIC_ACQUIRE, "agent");
            xb_add(&bar[XB_XGEN(b.x)], 1u);
            asm volatile("s_waitcnt vmcnt(0)" ::: "memory");
        } else {
            XB_SPIN(xb_ld(&bar[XB_XGEN(b.x)]) == gen, bar);
            __builtin_amdgcn_fence(__ATOMIC_ACQUIRE, "agent");
            asm volatile("s_waitcnt vmcnt(0)" ::: "memory");
        }
    }
    __syncthreads();
}
constexpr int LDS_BYTES = 147456;
struct Params { const float* in[17]; float* out; unsigned char* ws; };

__global__ void __launch_bounds__(512, 2) mega(Params p) {
    extern __shared__ __attribute__((aligned(16))) unsigned char lds[];
    const float* x = p.in[0]; const float* relb = p.in[1]; const float* norm_mix = p.in[2]; const float* w_in = p.in[3];
    const float* gqa = p.in[4]; const float* gka = p.in[5]; const float* gqb = p.in[6]; const float* gkb = p.in[7];
    const float* bforget = p.in[8]; const float* sinks = p.in[9]; const float* w_out = p.in[10]; const float* norm_ffn = p.in[11];
    const float* w_query = p.in[12]; const float* sk1 = p.in[13]; const float* sk2 = p.in[14]; const float* eu = p.in[15]; const float* ev = p.in[16];
    float* out = p.out; unsigned char* ws = p.ws;
    bf16_t* WTIN = (bf16_t*)(ws + WS_WTIN); bf16_t* WTOUT = (bf16_t*)(ws + WS_WTOUT); bf16_t* WTQ = (bf16_t*)(ws + WS_WTQ);
    float* LOGF = (float*)(ws + WS_LOGF); float* F2 = (float*)(ws + WS_F2); float* SSQ = (float*)(ws + WS_SSQ);
    int* EIDX = (int*)(ws + WS_EIDX); float* GATE = (float*)(ws + WS_GATE);
    bf16_t* XN = (bf16_t*)(ws + WS_XN); bf16_t* AP = XN;
    bf16_t* QA = (bf16_t*)(ws + WS_QA); bf16_t* KA = (bf16_t*)(ws + WS_KA); bf16_t* VA = (bf16_t*)(ws + WS_VA);
    bf16_t* QB = (bf16_t*)(ws + WS_QB); bf16_t* KB = (bf16_t*)(ws + WS_KB); bf16_t* VB = (bf16_t*)(ws + WS_VB);
    bf16_t* MIX = (bf16_t*)(ws + WS_MIX); bf16_t* QV = (bf16_t*)(ws + WS_QV);

    unsigned char* EU8 = ws + WS_EU8; unsigned char* EV8 = ws + WS_EV8; float* SU = (float*)(ws + WS_SU); float* SV = (float*)(ws + WS_SV); float* RR = (float*)(ws + WS_RR);
    const int tid = threadIdx.x, lane = tid & 63, wave = __builtin_amdgcn_readfirstlane(tid >> 6);
    const int G = gridDim.x, gw = blockIdx.x * 8 + wave, NGW = G * 8;
    LAS unsigned char* ldsl = (LAS unsigned char*)lds;
    if (tid < 4) ((LAS unsigned*)(ldsl + LDS_BYTES - 16))[tid] = 0u;
    __syncthreads();
    const XcdBarrier xbar = xcd_barrier_post((unsigned*)(ws + WS_CTL), (volatile LAS unsigned*)(ldsl + LDS_BYTES - 16));

    {
        LAS float* scr = (LAS float*)(ldsl + wave * 16384);
        constexpr int I_IN = 16 * (NQKV / 32), I_OUT = 16 * (D / 32), I_Q = 16 * 32 * 4;
        for (int it = gw; it < I_IN + I_OUT + I_Q; it += NGW) {
            int r = it;
            if (r < I_Q) { p0_keyfold_item(w_query, sk1, sk2, norm_ffn, WTQ, r, lane); continue; } r -= I_Q;
            if (r < I_IN) { p0_transpose_item<true, true>(w_in, INW, D, NQKV / 32, WTIN, scr, r, lane, norm_mix); continue; } r -= I_IN;
            p0_transpose_item<false>(w_out, D, D, D / 32, WTOUT, scr, r, lane);
        }
        __syncthreads();
        p0_rows(x, norm_mix, w_in, bforget, XN, RR, LOGF, gw, NGW, lane, ldsl);
    }
    xcd_barrier(xbar);
    {
        { const int cb = G >= 128 ? (int)blockIdx.x - (G - 32) : (int)blockIdx.x;
          if (cb >= 0 && cb < 32) p1_cumsum(cb, (LAS float*)ldsl, LOGF, F2); }
        pg8::Gemm g{XN, WTIN, M, NQKV, D}; pg8::StaticOrder S; S.init(M, NQKV, G, (int)blockIdx.x);
        EpiQKV E{QA, KA, VA, QB, KB, VB, gqa, gka, gqb, gkb, RR};
        pg8::gemm_phase<EpiQKV, pg8::StaticOrder, true, true>(ldsl, g, S, E);
        { const int nfull = (M / 256) * (NQKV / 256) - 2 * G;
          if (nfull > 0 && nfull < G) { if ((int)blockIdx.x >= nfull) { const int qw = ((int)blockIdx.x - nfull) * 8 + wave, NQW = (G - nfull) * 8; p0_quant4_rows<1>(eu, EU8, SU, qw, NQW, lane); p0_quant4_rows<2>(ev, EV8, SV, qw, NQW, lane); } }
          else { p0_quant4_rows<1>(eu, EU8, SU, gw, NGW, lane); p0_quant4_rows<2>(ev, EV8, SV, gw, NGW, lane); } }
    }
    xcd_barrier(xbar);
    attn_phase(ldsl, QA, KA, VA, QB, KB, VB, F2, sinks, relb, gqb, gkb, MIX, (unsigned*)(ws + WS_CTL) + 3584, G, wave, lane);
    xcd_barrier(xbar);
    {
        pg8::Gemm g{MIX, WTOUT, M, D, D}; pg8::StaticOrder S; S.init(M, D, G, (int)blockIdx.x);
        EpiOut E{AP, SSQ};
        pg8::gemm_phase<EpiOut, pg8::StaticOrder, true, true>(ldsl, g, S, E);
    }
    xcd_barrier(xbar);
    {
        pg8::Gemm g{AP, WTQ, M, NQ, D}; pg8::StaticOrder S; S.init(M, NQ, G, (int)blockIdx.x);
        EpiQV E{QV, SSQ};
        pg8::gemm_phase<EpiQV, pg8::StaticOrder, true, true>(ldsl, g, S, E);
    }
    xcd_barrier(xbar);
    {
        LAS unsigned* lut = (LAS unsigned*)(ldsl + TK_LUT_OFF + wave * 8192);
        for (int task = gw; task < (M / 32) * 4; task += NGW) topk_task(task >> 2, task & 3, QV, lut, EIDX, GATE, lane);
    }
    const bool p6local = NGW == (M / 32) * 4 && NGW * 8 == M;
    if (p6local) { __builtin_amdgcn_fence(__ATOMIC_RELEASE, "workgroup"); __syncthreads(); __builtin_amdgcn_fence(__ATOMIC_ACQUIRE, "workgroup"); }
    else xcd_barrier(xbar);
    { auto gbar = [&]() { xcd_barrier(xbar); };
      const int tfirst = p6local ? 64 * (int)blockIdx.x + 8 * wave : gw, tstep = 8 * NGW, tstride = p6local ? 1 : NGW, ntb = p6local ? 1 : (M + 8 * NGW - 1) / (8 * NGW);
      gather_chunked(AP, SSQ, norm_ffn, EIDX, GATE, EU8, EV8, SU, SV, out, ldsl + wave * GQ_WAVE, tfirst, tstep, tstride, ntb, lane, gbar); }
}
}

extern "C" void kernel_launch(void* const* d_in, const int* in_sizes, int n_in, void* d_out, int out_size, void* d_ws, size_t ws_size, hipStream_t stream) {
    static int grid_blocks = 0;
    if (!grid_blocks) {
        int dev = 0, cus = 0, per_cu = 0;
        (void)hipGetDevice(&dev);
        (void)hipDeviceGetAttribute(&cus, hipDeviceAttributeMultiprocessorCount, dev);
        (void)hipFuncSetAttribute((const void*)mk::mega, hipFuncAttributeMaxDynamicSharedMemorySize, mk::LDS_BYTES);
        (void)hipOccupancyMaxActiveBlocksPerMultiprocessor(&per_cu, (const void*)mk::mega, 512, (size_t)mk::LDS_BYTES);
        if (per_cu < 1) fprintf(stderr, "occupancy query says %d blocks/CU\n", per_cu);
        grid_blocks = cus;
    }
    (void)hipMemsetAsync(d_ws, 0, 16384, stream);
    mk::Params p{};
    for (int i = 0; i < 17; ++i) p.in[i] = (const float*)d_in[i];
    p.out = (float*)d_out; p.ws = (unsigned char*)d_ws;
    void* args[] = {&p};
    hipError_t e = hipLaunchCooperativeKernel((void*)mk::mega, dim3(grid_blocks), dim3(512), args, (size_t)mk::LDS_BYTES, stream);
    if (e != hipSuccess) fprintf(stderr, "cooperative launch failed: %s (grid %d)\n", hipGetErrorString(e), grid_blocks);
}
```
